# Optimizing an MI355X kernel written in HIP

```python
import math
import jax, jax.numpy as jnp
from jax import lax
import numpy as np

D_MODEL = 2048
BATCH = 8
SEQ = 2048
DEPTH = 1
DEC_BATCH = 128
DEC_SEQ = 8
PAST_LEN = 2048
PAGE_SIZE = 128

MIX_W = D_MODEL
NSA_W = MIX_W // 2
POOL_W = MIX_W - NSA_W
HEAD_DIM = 64
N_HEADS = NSA_W // HEAD_DIM
N_KV = 4
GROUP = N_HEADS // N_KV
KV_W = N_KV * HEAD_DIM
CMP_BLOCK = 32
CMP_STRIDE = 16
SEL_BLOCK = 64
SEL_TOP = 16
WINDOW = 512
Q_BLOCK = 64
POOL_SIZES = (2, 4, 8, 16)
N_POOL = len(POOL_SIZES)
POOL_GW = POOL_W // N_POOL
POOL_BUF = max(POOL_SIZES) - 1
PEER_HEADS = 8
PEER_QDIM = 256
N_KEYS = 128
N_EXPERTS = N_KEYS * N_KEYS
PEER_TOPK = 16
PEER_TBLOCK = 128
IN_COLS = NSA_W + 3 * 2 * KV_W + 3 * N_HEADS + POOL_W
EPS = 1e-6
NEG = -1e30
FORCE_BONUS = 1e4

kernel_name = 'hymba_nsa_pool_peer_step'


def rms_norm(x, g):
    xf = x.astype(jnp.float32)
    y = xf * lax.rsqrt(jnp.mean(xf * xf, axis=-1, keepdims=True) + EPS)
    return (y * g.astype(jnp.float32)).astype(x.dtype)


def masked_softmax(s, mask, axis):
    s = jnp.where(mask, s, NEG)
    e = jnp.where(mask, jnp.exp(s - jnp.max(s, axis=axis, keepdims=True)), 0.0)
    return e / jnp.maximum(jnp.sum(e, axis=axis, keepdims=True), 1e-30)


def alibi_slopes():
    h = np.arange(1, N_HEADS + 1, dtype=np.float32)
    return jnp.asarray((2.0 ** (-8.0 * h / N_HEADS)).reshape(N_KV, GROUP), jnp.float32)


def adaln(c, w_ada, b_ada):
    m = jax.nn.silu(c) @ w_ada + b_ada
    return m.reshape(c.shape[0], 6, D_MODEL)


def modulate(x, shift, scale, g):
    return rms_norm(x, g) * (1.0 + scale[:, None, :]) + shift[:, None, :]


def mix_inputs(h, w_in, g_qnorm, g_knorm):
    B, T, _ = h.shape
    z = h @ w_in
    offs = [NSA_W, NSA_W + 2 * KV_W, NSA_W + 4 * KV_W, NSA_W + 6 * KV_W, NSA_W + 6 * KV_W + 3 * N_HEADS]
    q, kvc, kvs, kvw, gl, u = jnp.split(z, offs, axis=-1)
    q = rms_norm(q.reshape(B, T, N_KV, GROUP, HEAD_DIM), g_qnorm)
    kvc = kvc.reshape(B, T, 2, N_KV, HEAD_DIM)
    kvs = kvs.reshape(B, T, 2, N_KV, HEAD_DIM)
    kvw = kvw.reshape(B, T, 2, N_KV, HEAD_DIM)
    kvs = jnp.stack([rms_norm(kvs[:, :, 0], g_knorm[1]), kvs[:, :, 1]], axis=2)
    kvw = jnp.stack([rms_norm(kvw[:, :, 0], g_knorm[2]), kvw[:, :, 1]], axis=2)
    gates = jax.nn.sigmoid(gl.reshape(B, T, N_KV, GROUP, 3))
    return q, kvc, kvs, kvw, gates, u


def compressed_kv(kv_rows, cmp_pe, w_cmp, g_k):
    T = kv_rows.shape[1]
    nc = (T - CMP_BLOCK) // CMP_STRIDE + 1
    idx = np.arange(nc)[:, None] * CMP_STRIDE + np.arange(CMP_BLOCK)[None, :]
    blk = kv_rows[:, idx] + jnp.swapaxes(cmp_pe, 0, 1)
    comp = jnp.einsum('bnlcgd,cglde->bncge', blk, w_cmp)
    kc = rms_norm(comp[:, :, 0], g_k)
    vc = comp[:, :, 1]
    pos_c = jnp.asarray(np.arange(nc) * CMP_STRIDE + CMP_BLOCK - 1, jnp.int32)
    return kc, vc, pos_c


def select_blocks(kv_rows):
    B, T = kv_rows.shape[:2]
    ns = -(-T // SEL_BLOCK)
    kv = jnp.pad(kv_rows, ((0, 0), (0, ns * SEL_BLOCK - T), (0, 0), (0, 0), (0, 0)))
    kv = kv.reshape(B, ns, SEL_BLOCK, 2, N_KV, HEAD_DIM)
    return kv[:, :, :, 0], kv[:, :, :, 1]


def cmp_to_sel(nc, ns):
    pos = np.arange(nc)[:, None] * CMP_STRIDE + np.arange(CMP_BLOCK)[None, :]
    sel = pos // SEL_BLOCK
    return jnp.asarray((sel[:, :, None] == np.arange(ns)[None, None, :]).mean(axis=1), jnp.float32)


def nsa_block(q, pos_q, gates, kc, vc, pos_c, ks_blk, vs_blk, kw, vw, pos_w, slopes):
    B, Tq = q.shape[:2]
    scale = HEAD_DIM ** -0.5
    f32 = jnp.float32
    dist_c = (pos_q[:, None] - pos_c[None, :]).astype(f32)
    s_c = jnp.einsum('bqgrd,bngd->bgrqn', q, kc, preferred_element_type=f32) * scale \
        - slopes[None, :, :, None, None] * dist_c
    p_c = masked_softmax(s_c, dist_c >= 0, -1)
    o_c = jnp.einsum('bgrqn,bngd->bqgrd', p_c, vc.astype(f32))
    ns = ks_blk.shape[1]
    imp = jnp.einsum('bgrqn,ns->bqgs', p_c, cmp_to_sel(kc.shape[1], ns))
    sel_ids = jnp.arange(ns)
    blk_q = pos_q // SEL_BLOCK
    forced = (sel_ids[None, :] == 0) | (sel_ids[None, :] == blk_q[:, None]) | (sel_ids[None, :] == blk_q[:, None] - 1)
    valid = sel_ids[None, :] * SEL_BLOCK <= pos_q[:, None]
    imp = jnp.where(valid[None, :, None, :], imp + FORCE_BONUS * forced[None, :, None, :].astype(f32), NEG)
    _, idx = lax.top_k(imp, min(SEL_TOP, ns))
    b_i = jnp.arange(B)[:, None, None, None]
    g_i = jnp.arange(N_KV)[None, None, :, None]
    kg = ks_blk[b_i, idx, :, g_i]
    vg = vs_blk[b_i, idx, :, g_i]
    pos_s = idx[..., None] * SEL_BLOCK + jnp.arange(SEL_BLOCK)
    dist_s = (pos_q[None, :, None, None, None] - pos_s).astype(f32)[:, :, :, None]
    s_s = jnp.einsum('bqgrd,bqgnkd->bqgrnk', q, kg, preferred_element_type=f32) * scale \
        - slopes[None, None, :, :, None, None] * dist_s
    p_s = masked_softmax(s_s, dist_s >= 0, (-2, -1))
    o_s = jnp.einsum('bqgrnk,bqgnkd->bqgrd', p_s, vg.astype(f32))
    dist_w = (pos_q[:, None] - pos_w[None, :])
    mask_w = (dist_w >= 0) & (dist_w <= WINDOW) & (pos_w[None, :] >= 0)
    s_w = jnp.einsum('bqgrd,bkgd->bgrqk', q, kw, preferred_element_type=f32) * scale \
        - slopes[None, :, :, None, None] * dist_w.astype(f32)
    p_w = masked_softmax(s_w, mask_w, -1)
    o_w = jnp.einsum('bgrqk,bkgd->bqgrd', p_w, vw.astype(f32))
    g = gates.astype(f32)
    out = g[..., 0:1] * o_c + g[..., 1:2] * o_s + g[..., 2:3] * o_w
    return out.astype(q.dtype)


def nsa_prompt(q, gates, kvc, kvs, kvw, cmp_pe, w_cmp, g_knorm, slopes):
    B, T = q.shape[:2]
    kc, vc, pos_c = compressed_kv(kvc, cmp_pe, w_cmp, g_knorm[0])
    ks_blk, vs_blk = select_blocks(kvs)
    kvw_pad = jnp.pad(kvw, ((0, 0), (WINDOW, 0), (0, 0), (0, 0), (0, 0)))
    qb = min(Q_BLOCK, T)

    def body(i):
        s = i * qb
        qi = lax.dynamic_slice_in_dim(q, s, qb, axis=1)
        gi = lax.dynamic_slice_in_dim(gates, s, qb, axis=1)
        wi = lax.dynamic_slice_in_dim(kvw_pad, s, qb + WINDOW, axis=1)
        pos_q = s + jnp.arange(qb)
        pos_w = s - WINDOW + jnp.arange(qb + WINDOW)
        return nsa_block(qi, pos_q, gi, kc, vc, pos_c, ks_blk, vs_blk, wi[:, :, 0], wi[:, :, 1], pos_w, slopes)

    out = lax.map(body, jnp.arange(T // qb))
    return jnp.moveaxis(out, 0, 1).reshape(B, T, N_KV, GROUP, HEAD_DIM)


def nsa_sample(q, gates, kvc, kvs, kvw, cache_kv_cmp, cache_kv_slc, cache_kv_win, page_table,
               cmp_pe, w_cmp, g_knorm, slopes):
    B, T = q.shape[:2]
    past_len = page_table.shape[1] * PAGE_SIZE
    full_c = jnp.concatenate([cache_kv_cmp[page_table].reshape((B, past_len) + cache_kv_cmp.shape[2:]), kvc], axis=1)
    full_s = jnp.concatenate([cache_kv_slc[page_table].reshape((B, past_len) + cache_kv_slc.shape[2:]), kvs], axis=1)
    kc, vc, pos_c = compressed_kv(full_c, cmp_pe, w_cmp, g_knorm[0])
    ks_blk, vs_blk = select_blocks(full_s)
    w_buf = cache_kv_win.shape[1]
    w_ctx = jnp.concatenate([cache_kv_win, kvw], axis=1)
    pos_q = past_len + jnp.arange(T)
    pos_w = past_len - w_buf + jnp.arange(w_buf + T)
    out = nsa_block(q, pos_q, gates, kc, vc, pos_c, ks_blk, vs_blk, w_ctx[:, :, 0], w_ctx[:, :, 1], pos_w, slopes)
    return out, w_ctx[:, -w_buf:]


def pool_mix(u, prefix, pos, w_pool, pool_scale):
    B, T, _ = u.shape
    ext = jnp.concatenate([prefix, u], axis=1).astype(jnp.float32)
    cs = jnp.concatenate([jnp.zeros((B, 1, POOL_W), jnp.float32), jnp.cumsum(ext, axis=1)], axis=1)
    outs = []
    for gi, w in enumerate(POOL_SIZES):
        c0, c1 = gi * POOL_GW, (gi + 1) * POOL_GW
        hi = cs[:, POOL_BUF + 1:POOL_BUF + 1 + T, c0:c1]
        lo = cs[:, POOL_BUF + 1 - w:POOL_BUF + 1 - w + T, c0:c1]
        cnt = jnp.minimum(w, pos + 1).astype(jnp.float32)[None, :, None]
        outs.append((hi - lo) / cnt - ext[:, POOL_BUF:, c0:c1])
    d = jnp.stack(outs, axis=2)
    y = jnp.einsum('btgc,gce->btge', d, w_pool.astype(jnp.float32)).reshape(B, T, POOL_W)
    return (y * pool_scale.astype(jnp.float32)).astype(u.dtype)


def peer(h, peer_wq, peer_subkeys, peer_u, peer_v):
    B, T, D = h.shape
    n = B * T
    nb = -(-n // PEER_TBLOCK)
    xt = jnp.pad(h.reshape(n, D), ((0, nb * PEER_TBLOCK - n), (0, 0))).reshape(nb, PEER_TBLOCK, D)

    def body(xb):
        q = (xb @ peer_wq).reshape(PEER_TBLOCK, PEER_HEADS, 2, PEER_QDIM // 2)
        s = jnp.einsum('thpd,phkd->thpk', q, peer_subkeys, preferred_element_type=jnp.float32)
        s1, i1 = lax.top_k(s[:, :, 0], PEER_TOPK)
        s2, i2 = lax.top_k(s[:, :, 1], PEER_TOPK)
        cand = (s1[..., :, None] + s2[..., None, :]).reshape(PEER_TBLOCK, PEER_HEADS, PEER_TOPK * PEER_TOPK)
        cid = (i1[..., :, None] * N_KEYS + i2[..., None, :]).reshape(PEER_TBLOCK, PEER_HEADS, PEER_TOPK * PEER_TOPK)
        sc, j = lax.top_k(cand, PEER_TOPK)
        eid = jnp.take_along_axis(cid, j, axis=-1)
        g = jax.nn.softmax(sc, axis=-1)
        a = jax.nn.gelu(jnp.einsum('td,thkd->thk', xb, peer_u[eid], preferred_element_type=jnp.float32),
                        approximate=False)
        return jnp.einsum('thk,thkd->td', (g * a).astype(peer_v.dtype), peer_v[eid])

    y = lax.map(body, xt).reshape(nb * PEER_TBLOCK, D)[:n]
    return y.reshape(B, T, D).astype(h.dtype)


def mix_out(o_nsa, o_pool, w_out):
    B, T = o_pool.shape[:2]
    return jnp.concatenate([o_nsa.reshape(B, T, NSA_W), o_pool], axis=-1) @ w_out


def setup_inputs(seed: int = 0) -> dict:
    key = jax.random.key(seed)
    ks = jax.random.split(key, 26)
    n_pages = PAST_LEN // PAGE_SIZE
    n_phys = (DEC_BATCH * n_pages * 5) // 4
    w_buf = min(WINDOW, PAST_LEN)
    nrm = jax.random.normal
    page_table = jax.random.permutation(ks[6], n_phys)[:DEC_BATCH * n_pages].reshape(DEC_BATCH, n_pages).astype(jnp.int32)
    return {
        'x_prompt': nrm(ks[0], (BATCH, SEQ, D_MODEL), jnp.float32),
        'x_sample': nrm(ks[1], (DEC_BATCH, DEC_SEQ, D_MODEL), jnp.float32),
        'cache_kv_cmp': nrm(ks[2], (n_phys, PAGE_SIZE, 2, N_KV, HEAD_DIM), jnp.float32),
        'cache_kv_slc': nrm(ks[3], (n_phys, PAGE_SIZE, 2, N_KV, HEAD_DIM), jnp.float32),
        'cache_kv_win': nrm(ks[4], (DEC_BATCH, w_buf, 2, N_KV, HEAD_DIM), jnp.float32),
        'state_pool': nrm(ks[5], (DEC_BATCH, POOL_BUF, POOL_W), jnp.float32),
        'page_table': page_table,
        'c_prompt': nrm(ks[7], (BATCH, D_MODEL), jnp.float32),
        'c_sample': nrm(ks[8], (DEC_BATCH, D_MODEL), jnp.float32),
        'w_ada': nrm(ks[9], (D_MODEL, 6 * D_MODEL), jnp.float32) * (0.5 * D_MODEL ** -0.5),
        'b_ada': nrm(ks[10], (6 * D_MODEL,), jnp.float32) * 0.01,
        'g_norm1': 1.0 + 0.1 * nrm(ks[11], (D_MODEL,), jnp.float32),
        'g_norm2': 1.0 + 0.1 * nrm(ks[12], (D_MODEL,), jnp.float32),
        'w_in': nrm(ks[13], (D_MODEL, IN_COLS), jnp.float32) * D_MODEL ** -0.5,
        'w_out': nrm(ks[14], (MIX_W, D_MODEL), jnp.float32) * MIX_W ** -0.5,
        'g_qnorm': 1.0 + 0.1 * nrm(ks[15], (HEAD_DIM,), jnp.float32),
        'g_knorm': 1.0 + 0.1 * nrm(ks[16], (3, HEAD_DIM), jnp.float32),
        'cmp_pe': 0.5 * nrm(ks[17], (2, CMP_BLOCK, N_KV, HEAD_DIM), jnp.float32),
        'w_cmp': nrm(ks[18], (2, N_KV, CMP_BLOCK, HEAD_DIM, HEAD_DIM), jnp.float32) * (CMP_BLOCK * HEAD_DIM) ** -0.5,
        'w_pool': nrm(ks[19], (N_POOL, POOL_GW, POOL_GW), jnp.float32) * POOL_GW ** -0.5,
        'pool_scale': 1.0 + 0.1 * nrm(ks[20], (POOL_W,), jnp.float32),
        'peer_wq': nrm(ks[21], (D_MODEL, PEER_HEADS * PEER_QDIM), jnp.float32) * D_MODEL ** -0.5,
        'peer_subkeys': nrm(ks[22], (2, PEER_HEADS, N_KEYS, PEER_QDIM // 2), jnp.float32) * (PEER_QDIM // 2) ** -0.5,
        'peer_u': nrm(ks[23], (N_EXPERTS, D_MODEL), jnp.float32) * D_MODEL ** -0.5,
        'peer_v': nrm(ks[24], (N_EXPERTS, D_MODEL), jnp.float32) * (PEER_HEADS * PEER_TOPK) ** -0.5,
    }


def reference(x_prompt, x_sample, cache_kv_cmp, cache_kv_slc, cache_kv_win, state_pool, page_table,
              c_prompt, c_sample, w_ada, b_ada, g_norm1, g_norm2, w_in, w_out, g_qnorm, g_knorm,
              cmp_pe, w_cmp, w_pool, pool_scale, peer_wq, peer_subkeys, peer_u, peer_v):
    slopes = alibi_slopes()

    Bp, Tp = x_prompt.shape[:2]
    mod_p = adaln(c_prompt, w_ada, b_ada)
    h = modulate(x_prompt, mod_p[:, 0], mod_p[:, 1], g_norm1)
    q, kvc_p, kvs_p, kvw_p, gates, u_p = mix_inputs(h, w_in, g_qnorm, g_knorm)
    o_nsa = nsa_prompt(q, gates, kvc_p, kvs_p, kvw_p, cmp_pe, w_cmp, g_knorm, slopes)
    o_pool = pool_mix(u_p, jnp.zeros((Bp, POOL_BUF, POOL_W), u_p.dtype), jnp.arange(Tp), w_pool, pool_scale)
    x1 = x_prompt + mod_p[:, 2][:, None, :] * mix_out(o_nsa, o_pool, w_out)
    h2 = modulate(x1, mod_p[:, 3], mod_p[:, 4], g_norm2)
    y_prompt = x1 + mod_p[:, 5][:, None, :] * peer(h2, peer_wq, peer_subkeys, peer_u, peer_v)
    win_p = kvw_p[:, -min(WINDOW, Tp):]
    pool_p = u_p[:, -POOL_BUF:]

    Ts = x_sample.shape[1]
    past_len = page_table.shape[1] * PAGE_SIZE
    mod_s = adaln(c_sample, w_ada, b_ada)
    h = modulate(x_sample, mod_s[:, 0], mod_s[:, 1], g_norm1)
    q, kvc_s, kvs_s, kvw_s, gates, u_s = mix_inputs(h, w_in, g_qnorm, g_knorm)
    o_nsa, win_s = nsa_sample(q, gates, kvc_s, kvs_s, kvw_s, cache_kv_cmp, cache_kv_slc, cache_kv_win,
                              page_table, cmp_pe, w_cmp, g_knorm, slopes)
    o_pool = pool_mix(u_s, state_pool, past_len + jnp.arange(Ts), w_pool, pool_scale)
    x1 = x_sample + mod_s[:, 2][:, None, :] * mix_out(o_nsa, o_pool, w_out)
    h2 = modulate(x1, mod_s[:, 3], mod_s[:, 4], g_norm2)
    y_sample = x1 + mod_s[:, 5][:, None, :] * peer(h2, peer_wq, peer_subkeys, peer_u, peer_v)
    pool_s = jnp.concatenate([state_pool, u_s], axis=1)[:, -POOL_BUF:]

    return (y_prompt, y_sample, kvc_p, kvs_p, win_p, pool_p, kvc_s, kvs_s, win_s, pool_s)
```

```cpp
#include <hip/hip_runtime.h>
#include <stdint.h>
#include <stdio.h>

#define DI __device__ __forceinline__
#define LAS __attribute__((address_space(3)))
typedef unsigned short bf16_t;
typedef short bf16x8 __attribute__((ext_vector_type(8)));
typedef short s16x4 __attribute__((ext_vector_type(4)));
typedef float f32x2 __attribute__((ext_vector_type(2)));
typedef float f32x4 __attribute__((ext_vector_type(4)));
typedef float f32x16 __attribute__((ext_vector_type(16)));
typedef unsigned u32x2 __attribute__((ext_vector_type(2)));
typedef unsigned u32x4 __attribute__((ext_vector_type(4)));
typedef __bf16 bf16v2 __attribute__((ext_vector_type(2)));

constexpr int DM = 2048;
constexpr int NP = 16384;
constexpr int NSM = 1024;
constexpr int NTOK = NP + NSM;
constexpr int SEQ = 2048, NB_P = 8, NB_S = 128, TS = 8, PAST = 2048;
constexpr int NIN_PAD = 3840;
constexpr int NEXP = 16384;
constexpr float LOG2E = 1.4426950408889634f;
constexpr float NEGBIG = -1.0e30f;

constexpr size_t O_Y = 0;
constexpr size_t O_CMP_P = 35651584, O_SLC_P = 44040192, O_WIN_P = 52428800, O_POOL_P = 54525952;
constexpr size_t O_CMP_S = 54648832, O_SLC_S = 55173120, O_WIN_S = 55697408, O_POOL_S = 89251840;

constexpr size_t al256(size_t x) { return (x + 255) & ~(size_t)255; }
constexpr size_t WS_BAR = 0;
constexpr size_t WS_WIN_T = 16384;
constexpr size_t WS_WOUT_T = WS_WIN_T + (size_t)NIN_PAD * DM * 2;
constexpr size_t WS_WQ_T = WS_WOUT_T + (size_t)DM * DM * 2;
constexpr size_t WS_WADA_T = WS_WQ_T + (size_t)DM * DM * 2;
constexpr size_t WS_WCMP_T = WS_WADA_T + (size_t)12288 * DM * 2;
constexpr size_t WS_WPOOL_T = WS_WCMP_T + (size_t)8 * 128 * 1024 * 2;
constexpr size_t WS_SUBK = WS_WPOOL_T + (size_t)4 * 256 * 256 * 2;
constexpr size_t WS_U = WS_SUBK + (size_t)2 * 8 * 128 * 128 * 2;
constexpr size_t WS_V = WS_U + (size_t)NEXP * DM * 2;
constexpr size_t WS_PEBIAS = WS_V + (size_t)NEXP * DM * 2;
constexpr size_t WS_SILUC = WS_PEBIAS + 4096;
constexpr size_t WS_MOD = WS_SILUC + (size_t)256 * DM * 2;
constexpr size_t WS_H = WS_MOD + (size_t)256 * 12288 * 4;
constexpr size_t WS_Q = WS_H + (size_t)NTOK * DM * 2;
constexpr size_t WS_KVS = WS_Q + (size_t)NTOK * 1024 * 2;
constexpr size_t WS_KVW = WS_KVS + (size_t)NP * 512 * 2;
constexpr size_t WS_GATES = WS_KVW + (size_t)NP * 512 * 2;
constexpr size_t WS_UBF = WS_GATES + (size_t)NTOK * 48 * 4;
constexpr size_t WS_PART_S = WS_UBF + (size_t)NTOK * 1024 * 2;
constexpr size_t WS_PART_P = WS_PART_S + (size_t)NB_S * 128 * 8 * 128 * 4;
constexpr size_t WS_OCAT = WS_PART_P + (size_t)NB_P * 128 * 8 * 128 * 4;
constexpr size_t WS_PQ = WS_OCAT + (size_t)NTOK * DM * 2;
constexpr size_t WS_TOPV = WS_PQ + (size_t)NTOK * DM * 2;
constexpr size_t WS_TOPI = WS_TOPV + (size_t)NTOK * 256 * 4;
constexpr size_t WS_END = WS_TOPI + (size_t)NTOK * 256 * 4;

struct Params {
    const float *x_prompt, *x_sample, *cache_cmp, *cache_slc, *cache_win, *state_pool;
    const int* page_table;
    const float *c_prompt, *c_sample, *w_ada, *b_ada, *g_norm1, *g_norm2, *w_in, *w_out, *g_qnorm, *g_knorm, *cmp_pe, *w_cmp, *w_pool, *pool_scale,
        *peer_wq, *peer_subkeys, *peer_u, *peer_v;
    float* out;
    unsigned char* ws;
    int ph_lo, ph_hi;
};

DI unsigned pack_bf2(float lo, float hi) {
    f32x2 v = {lo, hi};
    bf16v2 r = __builtin_convertvector(v, bf16v2);
    return __builtin_bit_cast(unsigned, r);
}
DI float bf_lo(unsigned u) { return __uint_as_float(u << 16); }
DI float bf_hi(unsigned u) { return __uint_as_float(u & 0xffff0000u); }
DI float fast_exp2(float x) { return __builtin_amdgcn_exp2f(x); }
DI float fast_rcp(float x) { return __builtin_amdgcn_rcpf(x); }
DI int crow(int reg, int h) { return (reg & 3) + 8 * (reg >> 2) + 4 * h; }
#define MFMA32(a, b, c) __builtin_amdgcn_mfma_f32_32x32x16_bf16((a), (b), (c), 0, 0, 0)
DI f32x16 zero16() { f32x16 z; for (int i = 0; i < 16; ++i) z[i] = 0.f; return z; }
DI bf16x8 pack_step(const f32x16& x, int s) {
    u32x4 p;
    p[0] = pack_bf2(x[8 * s + 0], x[8 * s + 1]); p[1] = pack_bf2(x[8 * s + 2], x[8 * s + 3]);
    p[2] = pack_bf2(x[8 * s + 4], x[8 * s + 5]); p[3] = pack_bf2(x[8 * s + 6], x[8 * s + 7]);
    return __builtin_bit_cast(bf16x8, p);
}
#define XB_TMO      128
#define XB_XCNT(j)  (256  + 64 * (j))
#define XB_XSUB(j)  (1280 + 64 * (j))
#define XB_XGEN(j)  (2304 + 64 * (j))
#define XB_TOP      3328
#define XB_TOPGEN   3392
#define XCD_BAR_WORDS 3456
#define XB_SPIN_CAP (1u << 22)

__device__ __forceinline__ unsigned xb_ld(unsigned* p)              { return __hip_atomic_load(p, __ATOMIC_RELAXED, __HIP_MEMORY_SCOPE_AGENT); }
__device__ __forceinline__ unsigned xb_add(unsigned* p, unsigned v) { return __hip_atomic_fetch_add(p, v, __ATOMIC_RELAXED, __HIP_MEMORY_SCOPE_AGENT); }
__device__ __forceinline__ unsigned xb_xcc_id() { return (unsigned)__builtin_amdgcn_s_getreg((3 << 11) | 20) & 0xFu; }
#define XB_SPIN(cond, bar) do { unsigned _sp = 0; while (cond) { __builtin_amdgcn_s_sleep(1); \
    if ((++_sp & 255u) == 0u) { if (xb_ld(&(bar)[XB_TMO])) break; if (_sp > XB_SPIN_CAP) { atomicAdd(&(bar)[XB_TMO], 1u); break; } } } } while (0)

struct XcdBarrier {
    unsigned* bar; unsigned x;
    volatile LAS unsigned* st;
};

__device__ __forceinline__ XcdBarrier xcd_barrier_post(unsigned* bar, volatile LAS unsigned* st) {
    XcdBarrier b; b.bar = bar; b.x = xb_xcc_id(); b.st = st;
    if (threadIdx.x == 0) (void)xb_add(&bar[XB_XCNT(b.x)], 1u);
    return b;
}
__device__ __forceinline__ void xcd_barrier_complete(unsigned* bar, unsigned x, unsigned& nloc, unsigned& nx) {
    const unsigned G = gridDim.x * gridDim.y * gridDim.z;
    unsigned sum, cnt, mine, sp = 0u;
    for (;;) {
        sum = 0u; cnt = 0u; mine = 0u;
#pragma unroll
        for (unsigned j = 0; j < 16; ++j) { const unsigned c = xb_ld(&bar[XB_XCNT(j)]); sum += c; cnt += (c > 0u) ? 1u : 0u; mine = (j == x) ? c : mine; }
        if (sum == G) break;
        __builtin_amdgcn_s_sleep(1);
        if ((++sp & 255u) == 0u) { if (xb_ld(&bar[XB_TMO])) break; if (sp > XB_SPIN_CAP) { atomicAdd(&bar[XB_TMO], 1u); break; } }
    }
    nloc = mine > 0u ? mine : 1u; nx = cnt > 0u ? cnt : 1u;
}

__device__ __forceinline__ void xcd_barrier(const XcdBarrier& b) {
    asm volatile("s_waitcnt vmcnt(0)" ::: "memory");
    __syncthreads();
    if (threadIdx.x == 0) {
        unsigned* bar = b.bar;
        __builtin_amdgcn_s_waitcnt(0);
        unsigned nloc = b.st[0], nx = b.st[1];
        if (nloc == 0u) { xcd_barrier_complete(bar, b.x, nloc, nx); b.st[0] = nloc; b.st[1] = nx; }
        const unsigned old = xb_add(&bar[XB_XSUB(b.x)], 1u);
        const unsigned gen = old / nloc;
        if (old + 1u == (gen + 1u) * nloc) {
            __builtin_amdgcn_fence(__ATOMIC_RELEASE, "agent");
            asm volatile("s_waitcnt vmcnt(0)" ::: "memory");
            const unsigned og = xb_add(&bar[XB_TOP], 1u);
            const unsigned tg = og / nx;
            if (og + 1u == (tg + 1u) * nx) xb_add(&bar[XB_TOPGEN], 1u);
            else XB_SPIN(xb_ld(&bar[XB_TOPGEN]) == tg, bar);
            __builtin_amdgcn_fence(__ATOMIC_ACQUIRE, "agent");
            xb_add(&bar[XB_XGEN(b.x)], 1u);
            asm volatile("s_waitcnt vmcnt(0)" ::: "memory");
        } else {
            XB_SPIN(xb_ld(&bar[XB_XGEN(b.x)]) == gen, bar);
            __builtin_amdgcn_fence(__ATOMIC_ACQUIRE, "agent");
            asm volatile("s_waitcnt vmcnt(0)" ::: "memory");
        }
    }
    __syncthreads();
}

namespace pg8 {
#define PG8_LAS __attribute__((address_space(3)))
constexpr int BM = 256, BK = 64, HALF = 128, HTB = HALF * BK * 2  , STAGE_BYTES = 8 * HTB, NXCD = 8, WGM = 8;

__host__ __device__ __forceinline__ int lds_byte(int r, int c) { const int st = (r >> 4) * 2 + (c >> 5), rr = r & 15, cc = c & 31, ob = rr * 64 + cc * 2; return st * 1024 + (ob ^ (((ob >> 9) & 1) << 5)); }
__host__ __device__ __forceinline__ void stage_rc(int b, int& R, int& C) { const int st = b / 1024, sb = b % 1024, swz = sb ^ (((sb >> 9) & 1) << 5); R = (st >> 1) * 16 + swz / 64; C = (st & 1) * 32 + (swz % 64) / 2; }
__host__ __device__ __forceinline__ int perm32(int rho) { const int n = rho >> 4, i = rho & 15; return 8 * (i >> 2) + 4 * n + (i & 3); }

struct Unit { int pm, pn; };
struct Gemm { const bf16_t* A; const bf16_t* Bt; int M, N, K; };

struct StaticOrder {
    int nM, nN, nwg, G, c;
    __host__ __device__ void init(int M, int N, int G_, int c_) { nM = M / BM; nN = N / BM; nwg = nM * nN; G = G_; c = c_; }
    __host__ __device__ bool next(int i, Unit& u) const {
        const long L = (long)i * G + c; if (L >= nwg) return false;
        int wgid = (int)L; { const int q = nwg / NXCD, r = nwg % NXCD, xcd = wgid % NXCD, off = wgid / NXCD; wgid = (xcd < r ? xcd * (q + 1) : r * (q + 1) + (xcd - r) * q) + off; }
        const int nig = WGM * nN, gid = wgid / nig, fm = gid * WGM, gsz = (nM - fm) < WGM ? (nM - fm) : WGM;
        u.pm = fm + ((wgid % nig) % gsz); u.pn = (wgid % nig) / gsz; return true;
    }
    __device__ __forceinline__ void a_ready(const Unit&) const {}
    __device__ __forceinline__ void done(const Unit&) const {}
};
template <class Epi, class Sched, bool STAMP = false>
__device__ __forceinline__ void gemm_phase(PG8_LAS unsigned char* lds, const Gemm g, const Sched& S, const Epi& E, unsigned long long* stamps) {
    const int tid = threadIdx.x, wid = __builtin_amdgcn_readfirstlane(tid >> 6), lane = tid & 63, wr = wid >> 2, wc = wid & 3, fr = lane & 15, fq = lane >> 4;
    const int K = g.K, nt = K / BK;
    int ts_lo = 0, ts_hi = 0, nts = 0; const unsigned long long rt_entry = STAMP ? (unsigned long long)wall_clock64() : 0ull;
#define PG8_STAMP() do { if (STAMP && wid == 0 && nts < 64) { const unsigned long long _c = (unsigned long long)clock64(); \
        ts_lo = (lane == nts) ? (int)(unsigned)_c : ts_lo; ts_hi = (lane == nts) ? (int)(unsigned)(_c >> 32) : ts_hi; ++nts; } } while (0)
    PG8_STAMP();
    unsigned voffA[2], voffB[2];
#pragma unroll
    for (int i = 0; i < 2; ++i) { int R, C; stage_rc(tid * 16 + i * 8192, R, C); const int Rb = Epi::PERM ? ((R & ~31) + perm32(R & 31)) : R;
        voffA[i] = (unsigned)(R * K + C) * 2u; voffB[i] = (unsigned)(Rb * K + C) * 2u; }
    const size_t kstep = (size_t)(BK * 2);
    const size_t hstep = (size_t)HALF * K * 2;
    const size_t tstep = 2 * hstep;
    const unsigned ldsw = (unsigned)wid * 1024u;
    const int aoff = lds_byte(wr * 64 + fr, fq * 8), boff = lds_byte(wc * 32 + fr, fq * 8);
#define PG8_SA(b, h) (((b) * 2 + (h)) * HTB)
#define PG8_SB(b, h) ((4 + (b) * 2 + (h)) * HTB)
#define PG8_STAGE(bufoff, gbase, voff) do { _Pragma("unroll") for (int _i = 0; _i < 2; ++_i) \
        __builtin_amdgcn_global_load_lds((const unsigned*)((const char*)(gbase) + (voff)[_i]), (PG8_LAS unsigned*)(lds + (bufoff) + ldsw + _i * 8192), 16, 0, 0); } while (0)
#define PG8_LDA(dst, b, h) do { _Pragma("unroll") for (int m = 0; m < 4; ++m) _Pragma("unroll") for (int k = 0; k < 2; ++k) dst[m][k] = *(const PG8_LAS bf16x8*)(lds + PG8_SA(b, h) + aoff + m * 2048 + k * 1024); } while (0)
#define PG8_LDB(dst, b, h) do { _Pragma("unroll") for (int n = 0; n < 2; ++n) _Pragma("unroll") for (int k = 0; k < 2; ++k) dst[n][k] = *(const PG8_LAS bf16x8*)(lds + PG8_SB(b, h) + boff + n * 2048 + k * 1024); } while (0)
#define PG8_MMA(ai, bj, At, Bt) do { __builtin_amdgcn_s_setprio(1); _Pragma("unroll") for (int m = 0; m < 4; ++m) _Pragma("unroll") for (int n = 0; n < 2; ++n) _Pragma("unroll") for (int k = 0; k < 2; ++k) \
        acc[ai][bj][m][n] = __builtin_amdgcn_mfma_f32_16x16x32_bf16(Bt[n][k], At[m][k], acc[ai][bj][m][n], 0, 0, 0); __builtin_amdgcn_s_setprio(0); } while (0)
#define PG8_WAIT_V(n) asm volatile("s_waitcnt vmcnt(" #n ")" ::: "memory")
#define PG8_WAIT_L(n) asm volatile("s_waitcnt lgkmcnt(" #n ")" ::: "memory")
#define PG8_BAR __builtin_amdgcn_s_barrier()
#define PG8_SCHED __builtin_amdgcn_sched_barrier(0)
    Unit cur, nxt; int ui = 0;
    if (!S.next(0, cur)) return;
    f32x4 acc[2][2][4][2];
#pragma unroll
    for (int a = 0; a < 2; ++a)
#pragma unroll
        for (int b = 0; b < 2; ++b)
#pragma unroll
            for (int m = 0; m < 4; ++m)
#pragma unroll
                for (int n = 0; n < 2; ++n) acc[a][b][m][n] = (f32x4){0.f, 0.f, 0.f, 0.f};
    bf16x8 At[4][2], B0[2][2], B1[2][2];
    const char* cA = (const char*)g.A + (size_t)cur.pm * tstep; const char* cB = (const char*)g.Bt + (size_t)cur.pn * tstep;
    S.a_ready(cur);
    PG8_STAGE(PG8_SB(0, 0), cB, voffB); PG8_STAGE(PG8_SA(0, 0), cA, voffA); PG8_STAGE(PG8_SB(0, 1), cB + hstep, voffB); PG8_STAGE(PG8_SA(0, 1), cA + hstep, voffA);
    if (wr == 1) PG8_BAR;
    PG8_WAIT_V(4); PG8_BAR;
    PG8_STAGE(PG8_SB(1, 0), cB + kstep, voffB); PG8_STAGE(PG8_SA(1, 0), cA + kstep, voffA); PG8_STAGE(PG8_SB(1, 1), cB + hstep + kstep, voffB);
    PG8_WAIT_V(6); PG8_BAR;
    PG8_STAMP();
    for (;;) {
        const bool has_next = S.next(ui + 1, nxt);
        const char* nA = has_next ? (const char*)g.A + (size_t)nxt.pm * tstep : cA; const char* nB = has_next ? (const char*)g.Bt + (size_t)nxt.pn * tstep : cB;
        for (int t = 0; t < nt; t += 2) {
            const bool last = (t == nt - 2);
            const char* a1 = cA + (size_t)(t + 1) * kstep;
            const char* a2 = last ? nA : cA + (size_t)(t + 2) * kstep; const char* b2 = last ? nB : cB + (size_t)(t + 2) * kstep;
            const char* a3 = a2 + kstep; const char* b3 = b2 + kstep;
            if (last && has_next) S.a_ready(nxt);
            PG8_LDB(B0, 0, 0); PG8_SCHED; PG8_LDA(At, 0, 0); PG8_STAGE(PG8_SA(1, 1), a1 + hstep, voffA);
            PG8_WAIT_L(8); PG8_BAR; PG8_WAIT_L(0); PG8_MMA(0, 0, At, B0); PG8_BAR; PG8_SCHED;
            PG8_LDB(B1, 0, 1); PG8_STAGE(PG8_SB(0, 0), b2, voffB);
            PG8_BAR; PG8_WAIT_L(0); PG8_MMA(0, 1, At, B1); PG8_BAR;
            PG8_LDA(At, 0, 1); PG8_STAGE(PG8_SA(0, 0), a2, voffA);
            PG8_BAR; PG8_WAIT_L(0); PG8_MMA(1, 0, At, B0); PG8_BAR; PG8_SCHED;
            PG8_STAGE(PG8_SB(0, 1), b2 + hstep, voffB);
            PG8_WAIT_V(6); PG8_BAR; PG8_MMA(1, 1, At, B1); PG8_BAR;
            PG8_LDB(B0, 1, 0); PG8_SCHED; PG8_LDA(At, 1, 0); PG8_STAGE(PG8_SA(0, 1), a2 + hstep, voffA);
            PG8_WAIT_L(8); PG8_BAR; PG8_WAIT_L(0); PG8_MMA(0, 0, At, B0); PG8_BAR; PG8_SCHED;
            PG8_LDB(B1, 1, 1); PG8_STAGE(PG8_SB(1, 0), b3, voffB);
            PG8_BAR; PG8_WAIT_L(0); PG8_MMA(0, 1, At, B1); PG8_BAR;
            PG8_LDA(At, 1, 1); PG8_STAGE(PG8_SA(1, 0), a3, voffA);
            PG8_BAR; PG8_WAIT_L(0); PG8_MMA(1, 0, At, B0); PG8_BAR; PG8_SCHED;
            PG8_STAGE(PG8_SB(1, 1), b3 + hstep, voffB);
            PG8_WAIT_V(6); PG8_BAR; PG8_MMA(1, 1, At, B1); PG8_BAR;
        }
        PG8_STAMP();
        if constexpr (!Epi::AFTER_DRAIN) { E(acc, cur, wr, wc, fr, fq); S.done(cur); }
        PG8_STAMP();
        if (!has_next) break;
#pragma unroll
        for (int a = 0; a < 2; ++a)
#pragma unroll
            for (int b = 0; b < 2; ++b)
#pragma unroll
                for (int m = 0; m < 4; ++m)
#pragma unroll
                    for (int n = 0; n < 2; ++n) acc[a][b][m][n] = (f32x4){0.f, 0.f, 0.f, 0.f};
        cur = nxt; cA = nA; cB = nB; ++ui;
    }
    PG8_WAIT_V(0);
    if (wr == 0) PG8_BAR;
    PG8_BAR;
    if constexpr (Epi::AFTER_DRAIN) { E.fused(acc, cur, wr, wc, fr, fq, lds, wid, lane); S.done(cur); }
    PG8_STAMP();
    if (STAMP && wid == 0) { stamps[lane] = lane < nts ? (((unsigned long long)(unsigned)ts_hi << 32) | (unsigned)ts_lo) : 0ull;
        if (lane == 62) stamps[62] = rt_entry; if (lane == 63) stamps[63] = (unsigned long long)wall_clock64(); }
#undef PG8_STAMP
#undef PG8_SA
#undef PG8_SB
#undef PG8_STAGE
#undef PG8_LDA
#undef PG8_LDB
#undef PG8_MMA
#undef PG8_WAIT_V
#undef PG8_WAIT_L
#undef PG8_BAR
#undef PG8_SCHED
}
}
DI f32x4 ld4(const float* p) { return *(const f32x4*)p; }
DI void st4(float* p, f32x4 v) { *(f32x4*)p = v; }
DI void st_bf4(bf16_t* p, f32x4 v) { u32x2 w; w[0] = pack_bf2(v[0], v[1]); w[1] = pack_bf2(v[2], v[3]); *(u32x2*)p = w; }

struct EpiAda {
    static constexpr bool PERM = false, AFTER_DRAIN = false;
    float* C; const float* bias;
    DI void operator()(const f32x4 (&acc)[2][2][4][2], const pg8::Unit& u, int wr, int wc, int fr, int fq) const {
        const int row0 = u.pm * 256 + wr * 64 + fr, col0 = u.pn * 256 + wc * 32 + 4 * fq;
#pragma unroll
        for (int ai = 0; ai < 2; ++ai)
#pragma unroll
            for (int m = 0; m < 4; ++m) { float* rowp = C + (size_t)(row0 + ai * 128 + m * 16) * 12288 + col0;
#pragma unroll
                for (int bj = 0; bj < 2; ++bj)
#pragma unroll
                    for (int n = 0; n < 2; ++n) st4(rowp + bj * 128 + n * 16, acc[ai][bj][m][n] + ld4(bias + col0 + bj * 128 + n * 16)); }
    }
};

struct EpiIn {
    static constexpr bool PERM = false, AFTER_DRAIN = false;
    bf16_t *q_bf, *kvs_bf, *kvw_bf, *u_bf; float *out, *gates; const float *g_qnorm, *g_knorm;
    DI void operator()(const f32x4 (&acc)[2][2][4][2], const pg8::Unit& u, int wr, int wc, int fr, int fq) const {
        const int pn = u.pn; const bool isS = u.pm >= 64;
#pragma unroll
        for (int ai = 0; ai < 2; ++ai)
#pragma unroll
            for (int m = 0; m < 4; ++m) {
                const int row = u.pm * 256 + ai * 128 + wr * 64 + m * 16 + fr;
                f32x4 v[2][2];
#pragma unroll
                for (int bj = 0; bj < 2; ++bj)
#pragma unroll
                    for (int n = 0; n < 2; ++n) v[bj][n] = acc[ai][bj][m][n];
                float ss = 0.f;
#pragma unroll
                for (int bj = 0; bj < 2; ++bj)
#pragma unroll
                    for (int n = 0; n < 2; ++n)
#pragma unroll
                        for (int i = 0; i < 4; ++i) ss += v[bj][n][i] * v[bj][n][i];
                ss += __shfl_xor(ss, 16); ss += __shfl_xor(ss, 32);
                const float rstd = __builtin_amdgcn_rsqf(ss * (1.0f / 64.0f) + 1e-6f);
                int sb, st;
                if (isS) { const int sr = row - NP; sb = sr >> 3; st = sr & 7; } else { sb = row >> 11; st = row & 2047; }
                if (pn < 4) {
                    const int head = pn * 4 + wc;
#pragma unroll
                    for (int bj = 0; bj < 2; ++bj)
#pragma unroll
                        for (int n = 0; n < 2; ++n) { const int e0 = 32 * bj + 16 * n + 4 * fq;
                            st_bf4(q_bf + (size_t)row * 1024 + head * 64 + e0, v[bj][n] * rstd * ld4(g_qnorm + e0)); }
                } else if (pn < 10) {
                    const int sec = (pn - 4) >> 1, c = (pn - 4) & 1, g = wc; const bool nrm = (c == 0) && (sec > 0);
#pragma unroll
                    for (int bj = 0; bj < 2; ++bj)
#pragma unroll
                        for (int n = 0; n < 2; ++n) { const int e0 = 32 * bj + 16 * n + 4 * fq; const int cg = c * 256 + g * 64 + e0;
                            f32x4 y = v[bj][n];
                            if (nrm) y = y * rstd * ld4(g_knorm + sec * 64 + e0);
                            if (sec == 0) { st4(out + (isS ? O_CMP_S + (size_t)(row - NP) * 512 : O_CMP_P + (size_t)row * 512) + cg, y); }
                            else if (sec == 1) { st4(out + (isS ? O_SLC_S + (size_t)(row - NP) * 512 : O_SLC_P + (size_t)row * 512) + cg, y);
                                if (!isS) st_bf4(kvs_bf + (size_t)row * 512 + cg, y); }
                            else { if (isS) st4(out + O_WIN_S + ((size_t)sb * 512 + 504 + st) * 512 + cg, y);
                                else { st_bf4(kvw_bf + (size_t)row * 512 + cg, y); if (st >= 1536) st4(out + O_WIN_P + ((size_t)sb * 512 + st - 1536) * 512 + cg, y); } }
                        }
                } else if (pn == 10) {
                    if (wc == 0) {
#pragma unroll
                        for (int bj = 0; bj < 2; ++bj)
#pragma unroll
                            for (int n = 0; n < 2; ++n) { const int e0 = 32 * bj + 16 * n + 4 * fq;
                                if (e0 < 48) { f32x4 y; for (int i = 0; i < 4; ++i) y[i] = fast_rcp(1.0f + fast_exp2(-LOG2E * v[bj][n][i])); st4(gates + (size_t)row * 48 + e0, y); } }
                    }
                } else {
#pragma unroll
                    for (int bj = 0; bj < 2; ++bj)
#pragma unroll
                        for (int n = 0; n < 2; ++n) { const int col = (pn - 11) * 256 + 64 * wc + 32 * bj + 16 * n + 4 * fq;
                            st_bf4(u_bf + (size_t)row * 1024 + col, v[bj][n]);
                            if (isS) st4(out + O_POOL_S + ((size_t)sb * 15 + 7 + st) * 1024 + col, v[bj][n]);
                            else if (st >= 2033) st4(out + O_POOL_P + ((size_t)sb * 15 + st - 2033) * 1024 + col, v[bj][n]); }
                }
            }
    }
};

struct EpiOut {
    static constexpr bool PERM = false, AFTER_DRAIN = false;
    const float *x_prompt, *x_sample, *mod; float* out;
    DI void operator()(const f32x4 (&acc)[2][2][4][2], const pg8::Unit& u, int wr, int wc, int fr, int fq) const {
        const int col0 = u.pn * 256 + wc * 32 + 4 * fq;
#pragma unroll
        for (int ai = 0; ai < 2; ++ai)
#pragma unroll
            for (int m = 0; m < 4; ++m) {
                const int row = u.pm * 256 + ai * 128 + wr * 64 + m * 16 + fr;
                const float* xr = row < NP ? x_prompt + (size_t)row * DM : x_sample + (size_t)(row - NP) * DM;
                const int mrow = row < NP ? (row >> 11) : 8 + ((row - NP) >> 3);
                const float* gate = mod + (size_t)mrow * 12288 + 2 * DM;
#pragma unroll
                for (int bj = 0; bj < 2; ++bj)
#pragma unroll
                    for (int n = 0; n < 2; ++n) { const int col = col0 + bj * 128 + n * 16;
                        st4(out + (size_t)row * DM + col, ld4(xr + col) + ld4(gate + col) * acc[ai][bj][m][n]); }
            }
    }
};

struct EpiPq {
    static constexpr bool PERM = false, AFTER_DRAIN = false;
    bf16_t* pq;
    DI void operator()(const f32x4 (&acc)[2][2][4][2], const pg8::Unit& u, int wr, int wc, int fr, int fq) const {
        const int col0 = u.pn * 256 + wc * 32 + 4 * fq;
#pragma unroll
        for (int ai = 0; ai < 2; ++ai)
#pragma unroll
            for (int m = 0; m < 4; ++m) {
                const int row = u.pm * 256 + ai * 128 + wr * 64 + m * 16 + fr;
#pragma unroll
                for (int bj = 0; bj < 2; ++bj)
#pragma unroll
                    for (int n = 0; n < 2; ++n) st_bf4(pq + (size_t)row * DM + col0 + bj * 128 + n * 16, acc[ai][bj][m][n]);
            }
    }
};
DI int win_logical(int p) {
    const int pn = p >> 8, pp = p & 255, bj = pp >> 7, wc = (pp >> 5) & 3, r = pp & 31;
    const int lu = 64 * wc + 32 * bj + r;
    if (pn < 10) return 256 * pn + lu;
    if (pn == 10) return lu < 48 ? 2560 + lu : -1;
    return 2608 + 256 * (pn - 11) + lu;
}
DI void transpose_tile(const float* src, int ldsrc, int k0, int c0, int nvalid, bf16_t* dst, int lddst, int p0, LAS unsigned char* lds) {
    const int tid = threadIdx.x;
    LAS bf16_t* T = (LAS bf16_t*)lds;
#pragma unroll
    for (int i = 0; i < 2; ++i) {
        const int kk = (tid >> 3) + 64 * i, c4 = (tid & 7) * 4;
        f32x4 v = {0.f, 0.f, 0.f, 0.f};
        if (c0 >= 0 && c4 < nvalid) v = ld4(src + (size_t)(k0 + kk) * ldsrc + c0 + c4);
#pragma unroll
        for (int j = 0; j < 4; ++j) T[(c4 + j) * 136 + kk] = (bf16_t)(pack_bf2(v[j], 0.f) & 0xffffu);
    }
    __syncthreads();
    { const int col = tid >> 4, kc = tid & 15;
      const u32x4 w = *(const LAS u32x4*)(T + col * 136 + kc * 8);
      *(u32x4*)(dst + (size_t)(p0 + col) * lddst + k0 + kc * 8) = w; }
    __syncthreads();
}

DI void phase_A(const Params& p, LAS unsigned char* lds) {
    bf16_t* win_t = (bf16_t*)(p.ws + WS_WIN_T); bf16_t* wout_t = (bf16_t*)(p.ws + WS_WOUT_T); bf16_t* wq_t = (bf16_t*)(p.ws + WS_WQ_T);
    bf16_t* wada_t = (bf16_t*)(p.ws + WS_WADA_T); bf16_t* wcmp_t = (bf16_t*)(p.ws + WS_WCMP_T); bf16_t* wpool_t = (bf16_t*)(p.ws + WS_WPOOL_T);
    constexpr int T_IN = 16 * 120, T_OUT = 16 * 64, T_Q = 16 * 64, T_ADA = 16 * 384, T_POOL = 4 * 2 * 8, T_CMP = 16 * 8 * 2, T_MISC = 256 + 1 + 112;
    constexpr int E0 = T_IN, E1 = E0 + T_OUT, E2 = E1 + T_Q, E3 = E2 + T_ADA, E4 = E3 + T_POOL, E5 = E4 + T_CMP, E6 = E5 + T_MISC;
    const int tid = threadIdx.x;
    for (int it = blockIdx.x; it < E6; it += gridDim.x) {
        if (it < E0) { const int kt = it & 15, pt = it >> 4; const int p0 = pt * 32; const int c0 = win_logical(p0);
            int nv = 32; if (c0 >= 0 && win_logical(p0 + 31) < 0) nv = 16;
            transpose_tile(p.w_in, 3632, kt * 128, c0, nv, win_t, DM, p0, lds); }
        else if (it < E1) { const int j = it - E0, kt = j & 15, pt = j >> 4; transpose_tile(p.w_out, DM, kt * 128, pt * 32, 32, wout_t, DM, pt * 32, lds); }
        else if (it < E2) { const int j = it - E1, kt = j & 15, pt = j >> 4; transpose_tile(p.peer_wq, DM, kt * 128, pt * 32, 32, wq_t, DM, pt * 32, lds); }
        else if (it < E3) { const int j = it - E2, kt = j & 15, pt = j >> 4; transpose_tile(p.w_ada, 12288, kt * 128, pt * 32, 32, wada_t, DM, pt * 32, lds); }
        else if (it < E4) { const int j = it - E3, gi = j >> 4, kt = (j >> 3) & 1, pt = j & 7;
            transpose_tile(p.w_pool + (size_t)gi * 65536, 256, kt * 128, pt * 32, 32, wpool_t + (size_t)gi * 65536, 256, pt * 32, lds); }
        else if (it < E5) { const int j = it - E4, cg = j >> 5, lohi = (j >> 4) & 1, kt = (j >> 1) & 7, pt = j & 1;
            transpose_tile(p.w_cmp + ((size_t)cg * 32 + lohi * 16) * 4096, 64, kt * 128, pt * 32, 32, wcmp_t + (size_t)cg * 131072, 1024, lohi * 64 + pt * 32, lds); }
        else {
            const int j = it - E5;
            if (j < 256) {
                const float* src = j < 8 ? p.c_prompt + (size_t)j * DM : (j < 136 ? p.c_sample + (size_t)(j - 8) * DM : nullptr);
                f32x4 v = {0.f, 0.f, 0.f, 0.f};
                if (src) { v = ld4(src + tid * 4); for (int i = 0; i < 4; ++i) v[i] = v[i] * fast_rcp(1.0f + fast_exp2(-LOG2E * v[i])); }
                st_bf4((bf16_t*)(p.ws + WS_SILUC) + (size_t)j * DM + tid * 4, v);
            } else if (j == 256) {
                const int cg = tid >> 6, e = tid & 63, c = cg >> 2, g = cg & 3; float s = 0.f;
                for (int l = 0; l < 32; ++l) for (int d = 0; d < 64; ++d)
                    s += p.cmp_pe[((c * 32 + l) * 4 + g) * 64 + d] * p.w_cmp[(((size_t)cg * 32 + l) * 64 + d) * 64 + e];
                ((float*)(p.ws + WS_PEBIAS))[tid] = s;
            } else {
                const int q = j - 257;
                for (int i = 0; i < 4; ++i) { const size_t f = (size_t)q * 8192 + (size_t)(i * 512 + tid) * 4; const size_t b = f / 7168, rem = f % 7168;
                    st4(p.out + O_POOL_S + b * 15360 + rem, ld4(p.state_pool + b * 15360 + 8 * 1024 + rem)); }
            }
        }
    }
}

DI void phase_B_stream(const Params& p, int first_blk) {
    const int nb = gridDim.x - first_blk, bi = blockIdx.x - first_blk, tid = threadIdx.x;
    constexpr int C_U = 16384, C_V = 16384, C_SK = 128, C_WIN = 128 * 126, C_END = C_U + C_V + C_SK + C_WIN;
    bf16_t* ub = (bf16_t*)(p.ws + WS_U); bf16_t* vb = (bf16_t*)(p.ws + WS_V); bf16_t* sk = (bf16_t*)(p.ws + WS_SUBK);
    for (int c = bi; c < C_END; c += nb) {
        if (c < C_U) st_bf4(ub + (size_t)c * 2048 + tid * 4, ld4(p.peer_u + (size_t)c * 2048 + tid * 4));
        else if (c < C_U + C_V) { const int r = c - C_U; st_bf4(vb + (size_t)r * 2048 + tid * 4, ld4(p.peer_v + (size_t)r * 2048 + tid * 4)); }
        else if (c < C_U + C_V + C_SK) { const int r = c - C_U - C_V; st_bf4(sk + (size_t)r * 2048 + tid * 4, ld4(p.peer_subkeys + (size_t)r * 2048 + tid * 4)); }
        else { const int r = c - C_U - C_V - C_SK, b = r / 126, q = r % 126;
            st4(p.out + O_WIN_S + (size_t)b * 262144 + (size_t)q * 2048 + tid * 4, ld4(p.cache_win + (size_t)b * 262144 + 4096 + (size_t)q * 2048 + tid * 4)); }
    }
}

DI void phase_modulate(const Params& p, int which) {
    const int tid = threadIdx.x, wid = tid >> 6, lane = tid & 63;
    const float* mod = (const float*)(p.ws + WS_MOD); bf16_t* h = (bf16_t*)(p.ws + WS_H);
    const float* gn = which ? p.g_norm2 : p.g_norm1;
    for (int row = blockIdx.x * 8 + wid; row < NTOK; row += gridDim.x * 8) {
        const float* src = which ? p.out + (size_t)row * DM : (row < NP ? p.x_prompt + (size_t)row * DM : p.x_sample + (size_t)(row - NP) * DM);
        const int mrow = row < NP ? (row >> 11) : 8 + ((row - NP) >> 3);
        const float* shift = mod + (size_t)mrow * 12288 + (which ? 3 : 0) * DM; const float* scale = shift + DM;
        f32x4 v[8]; float ss = 0.f;
#pragma unroll
        for (int j = 0; j < 4; ++j) { v[2 * j] = ld4(src + j * 512 + lane * 8); v[2 * j + 1] = ld4(src + j * 512 + lane * 8 + 4); }
#pragma unroll
        for (int j = 0; j < 8; ++j) for (int i = 0; i < 4; ++i) ss += v[j][i] * v[j][i];
#pragma unroll
        for (int o = 32; o >= 1; o >>= 1) ss += __shfl_xor(ss, o);
        const float rstd = __builtin_amdgcn_rsqf(ss * (1.0f / 2048.0f) + 1e-6f);
#pragma unroll
        for (int j = 0; j < 4; ++j) {
            const int c = j * 512 + lane * 8;
            f32x4 a = v[2 * j] * rstd * ld4(gn + c) * (ld4(scale + c) + 1.0f) + ld4(shift + c);
            f32x4 b = v[2 * j + 1] * rstd * ld4(gn + c + 4) * (ld4(scale + c + 4) + 1.0f) + ld4(shift + c + 4);
            u32x4 w; w[0] = pack_bf2(a[0], a[1]); w[1] = pack_bf2(a[2], a[3]); w[2] = pack_bf2(b[0], b[1]); w[3] = pack_bf2(b[2], b[3]);
            *(u32x4*)(h + (size_t)row * DM + c) = w;
        }
    }
}
DI void cmp_unit(const Params& p, int unit, LAS unsigned char* lds) {
    const int tid = threadIdx.x, wid = tid >> 6, lane = tid & 63;
    const bool isP = unit >= 2048;
    int b, q4, cgp;
    if (isP) { const int u = unit - 2048; b = u >> 4; q4 = (u >> 2) & 3; cgp = u & 3; } else { b = unit >> 4; q4 = (unit >> 2) & 3; cgp = unit & 3; }
    constexpr int CH_STRIDE = 2064;
    const int f4 = tid & 31, cgl_ld = f4 >> 4, d0 = (f4 & 15) * 4;
#pragma unroll 4
    for (int it = 0; it < 32; ++it) {
        const int rowi = it * 16 + (tid >> 5);
        const int R = q4 * 512 + rowi;
        const float* src;
        if (isP) src = p.out + O_CMP_P + ((size_t)b * 2048 + R) * 512 + cgp * 128 + f4 * 4;
        else { const int page = p.page_table[b * 16 + (R >> 7)]; src = p.cache_cmp + ((size_t)page * 128 + (R & 127)) * 512 + cgp * 128 + f4 * 4; }
        const f32x4 v = ld4(src);
        u32x2 w; w[0] = pack_bf2(v[0], v[1]); w[1] = pack_bf2(v[2], v[3]);
        const int ch = rowi >> 4, l16 = rowi & 15;
        *(LAS u32x2*)(lds + (cgl_ld * 32 + ch) * CH_STRIDE + (l16 * 64 + d0) * 2) = w;
    }
    __syncthreads();
    const int cgl = wid >> 2, nt = wid & 3, cg = cgp * 2 + cgl, l31 = lane & 31, hh = lane >> 5;
    const bf16_t* wrow = (const bf16_t*)(p.ws + WS_WCMP_T) + ((size_t)cg * 128 + nt * 32 + l31) * 1024 + 8 * hh;
    LAS const unsigned char* arow = lds + (cgl * 32 + l31) * CH_STRIDE + 16 * hh;
    f32x16 acc = zero16();
#pragma unroll 8
    for (int s = 0; s < 64; ++s) {
        const bf16x8 a = *(LAS const bf16x8*)(arow + s * 32);
        const bf16x8 w = *(const bf16x8*)(wrow + s * 16);
        acc = MFMA32(a, w, acc);
    }
    float* part = (float*)(p.ws + (isP ? WS_PART_P : WS_PART_S));
#pragma unroll
    for (int i = 0; i < 16; ++i) {
        const int ch = q4 * 32 + crow(i, hh);
        part[(((size_t)b * 128 + ch) * 8 + cg) * 128 + nt * 32 + l31] = acc[i];
    }
    __syncthreads();
}

DI void pool_unit(const Params& p, int unit, LAS unsigned char* lds) {
    const int tid = threadIdx.x, wid = tid >> 6, lane = tid & 63;
    const int tile = unit >> 2, gi = unit & 3, w = 2 << gi;
    const int row0 = tile * 128; const bool isS = row0 >= NP;
    const bf16_t* ubf = (const bf16_t*)(p.ws + WS_UBF);
    constexpr int AST = 264;
    LAS bf16_t* A = (LAS bf16_t*)lds;
    for (int it = tid; it < 128 * 32; it += 512) {
        const int r = it >> 5, c8 = (it & 31) * 8, row = row0 + r, col = gi * 256 + c8;
        int bb, t; if (isS) { bb = (row - NP) >> 3; t = (row - NP) & 7; } else { bb = row >> 11; t = row & 2047; }
        float sum[8]; for (int i = 0; i < 8; ++i) sum[i] = 0.f;
        float self[8];
        for (int j = 0; j < w; ++j) {
            const int tt = t - j;
            float x[8];
            if (tt >= 0) { const u32x4 q = *(const u32x4*)(ubf + (size_t)(row - j) * 1024 + col);
                for (int i = 0; i < 4; ++i) { x[2 * i] = bf_lo(q[i]); x[2 * i + 1] = bf_hi(q[i]); } }
            else if (isS) { const float* sp = p.state_pool + ((size_t)bb * 15 + 15 + tt) * 1024 + col; const f32x4 a = ld4(sp), c = ld4(sp + 4);
                for (int i = 0; i < 4; ++i) { x[i] = a[i]; x[4 + i] = c[i]; } }
            else { for (int i = 0; i < 8; ++i) x[i] = 0.f; }
            for (int i = 0; i < 8; ++i) sum[i] += x[i];
            if (j == 0) for (int i = 0; i < 8; ++i) self[i] = x[i];
        }
        const float inv = isS ? 1.0f / (float)w : 1.0f / (float)(t + 1 < w ? t + 1 : w);
        u32x4 o;
        for (int i = 0; i < 4; ++i) o[i] = pack_bf2(sum[2 * i] * inv - self[2 * i], sum[2 * i + 1] * inv - self[2 * i + 1]);
        *(LAS u32x4*)(A + r * AST + c8) = o;
    }
    __syncthreads();
    const int wm = wid >> 1, wn = wid & 1, l31 = lane & 31, hh = lane >> 5;
    const bf16_t* wt = (const bf16_t*)(p.ws + WS_WPOOL_T) + (size_t)gi * 65536 + (size_t)(wn * 128 + l31) * 256 + 8 * hh;
    LAS const bf16_t* arow = A + (wm * 32 + l31) * AST + 8 * hh;
    f32x16 acc[4]; for (int i = 0; i < 4; ++i) acc[i] = zero16();
#pragma unroll 4
    for (int s = 0; s < 16; ++s) {
        const bf16x8 a = *(LAS const bf16x8*)(arow + s * 16);
#pragma unroll
        for (int nt = 0; nt < 4; ++nt) { const bf16x8 wv = *(const bf16x8*)(wt + (size_t)nt * 32 * 256 + s * 16); acc[nt] = MFMA32(wv, a, acc[nt]); }
    }
    bf16_t* ocat = (bf16_t*)(p.ws + WS_OCAT);
    const int row = row0 + wm * 32 + l31;
#pragma unroll
    for (int nt = 0; nt < 4; ++nt)
#pragma unroll
        for (int gq = 0; gq < 4; ++gq) {
            const int n0 = gi * 256 + wn * 128 + nt * 32 + 8 * gq + 4 * hh;
            const f32x4 ps = ld4(p.pool_scale + n0);
            f32x4 y; for (int i = 0; i < 4; ++i) y[i] = acc[nt][4 * gq + i] * ps[i];
            st_bf4(ocat + (size_t)row * DM + 1024 + n0, y);
        }
    __syncthreads();
}
struct AttnSt { float m, l; f32x16 o0, o1; };
DI void attn_init(AttnSt& s) { s.m = NEGBIG; s.l = 0.f; s.o0 = zero16(); s.o1 = zero16(); }
constexpr int KST = 72, VST = 68, CVST = 136;
constexpr int KVBUF = 64 * KST * 2 + 64 * VST * 2;

DI float xhalf_max(float v) { return fmaxf(v, __shfl_xor(v, 32)); }
DI float xhalf_sum(float v) { return v + __shfl_xor(v, 32); }

template <int MODE>
DI void attn_tile64(LAS const bf16_t* Kb, LAS const bf16_t* Vt, const bf16x8 (&qf)[4], int rel, float slope2, bool allow, int lane, AttnSt& st) {
    const int l31 = lane & 31, hh = lane >> 5;
    f32x16 sacc[2];
#pragma unroll
    for (int kt = 0; kt < 2; ++kt) { sacc[kt] = zero16();
#pragma unroll
        for (int s = 0; s < 4; ++s) { const bf16x8 a = *(LAS const bf16x8*)(Kb + (32 * kt + l31) * KST + 16 * s + 8 * hh); sacc[kt] = MFMA32(a, qf[s], sacc[kt]); } }
    const float c1 = 0.125f * LOG2E;
    const int relh = rel - 4 * hh;
    const float base = -slope2 * (float)relh;
    float mx = NEGBIG;
#pragma unroll
    for (int kt = 0; kt < 2; ++kt)
#pragma unroll
        for (int i = 0; i < 16; ++i) {
            const int ci = 32 * kt + (i & 3) + 8 * (i >> 2);
            bool valid = allow && (ci <= relh); if (MODE == 1) valid = valid && (relh - ci <= 512);
            float sc = __builtin_fmaf(sacc[kt][i], c1, __builtin_fmaf(slope2, (float)ci, base));
            sc = valid ? sc : NEGBIG; sacc[kt][i] = sc; mx = fmaxf(mx, sc);
        }
    mx = xhalf_max(mx);
    const float m_new = fmaxf(fmaxf(st.m, mx), -1.0e20f);
    const float alpha = fast_exp2(st.m - m_new);
    float rs = 0.f;
#pragma unroll
    for (int kt = 0; kt < 2; ++kt)
#pragma unroll
        for (int i = 0; i < 16; ++i) { const float pv = fast_exp2(sacc[kt][i] - m_new); sacc[kt][i] = pv; rs += pv; }
    rs = xhalf_sum(rs);
    st.l = st.l * alpha + rs; st.m = m_new;
    if (!__all(alpha == 1.0f)) { st.o0 *= alpha; st.o1 *= alpha; }
#pragma unroll
    for (int kt = 0; kt < 2; ++kt)
#pragma unroll
        for (int s2 = 0; s2 < 2; ++s2) {
            const bf16x8 pf = pack_step(sacc[kt], s2);
            const int kb = 32 * kt + 16 * s2 + 4 * hh;
#pragma unroll
            for (int dt = 0; dt < 2; ++dt) {
                LAS const bf16_t* vp = Vt + (32 * dt + l31) * VST + kb;
                const s16x4 lo = *(LAS const s16x4*)vp, hi = *(LAS const s16x4*)(vp + 8);
                const bf16x8 vf = __builtin_shufflevector(lo, hi, 0, 1, 2, 3, 4, 5, 6, 7);
                if (dt == 0) st.o0 = MFMA32(vf, pf, st.o0); else st.o1 = MFMA32(vf, pf, st.o1);
            }
        }
}

DI void attn_cmp(LAS const bf16_t* Kc, LAS const bf16_t* Vct, const bf16x8 (&qf)[4], int t, float slope2, int ntile, int lane, f32x16& oc0, f32x16& oc1, float (&imp)[16]) {
    const int l31 = lane & 31, hh = lane >> 5;
    const float c1 = 0.125f * LOG2E;
    int nmax = (t - 31) >> 4; nmax = nmax > 126 ? 126 : nmax;
    const int nmaxh = nmax - 4 * hh;
    const float base = -slope2 * (float)(t - 31 - 64 * hh), s16 = slope2 * 16.0f;
    float mx = NEGBIG;
#pragma unroll
    for (int kt = 0; kt < 4; ++kt) {
        if (kt < ntile) {
            f32x16 sacc = zero16();
#pragma unroll
            for (int s = 0; s < 4; ++s) { const bf16x8 a = *(LAS const bf16x8*)(Kc + (32 * kt + l31) * KST + 16 * s + 8 * hh); sacc = MFMA32(a, qf[s], sacc); }
#pragma unroll
            for (int i = 0; i < 16; ++i) {
                const int ci = 32 * kt + (i & 3) + 8 * (i >> 2);
                const float sc = __builtin_fmaf(sacc[i], c1, __builtin_fmaf(s16, (float)ci, base));
                mx = fmaxf(mx, (ci <= nmaxh) ? sc : NEGBIG);
            }
        }
    }
    mx = fmaxf(xhalf_max(mx), -1.0e20f);
    float sum = 0.f, prevc = 0.f;
    oc0 = zero16(); oc1 = zero16();
#pragma unroll
    for (int j = 0; j < 16; ++j) imp[j] = 0.f;
#pragma unroll
    for (int kt = 0; kt < 4; ++kt) {
        if (kt < ntile) {
            f32x16 sacc = zero16();
#pragma unroll
            for (int s = 0; s < 4; ++s) { const bf16x8 a = *(LAS const bf16x8*)(Kc + (32 * kt + l31) * KST + 16 * s + 8 * hh); sacc = MFMA32(a, qf[s], sacc); }
#pragma unroll
            for (int i = 0; i < 16; ++i) {
                const int ci = 32 * kt + (i & 3) + 8 * (i >> 2);
                float sc = __builtin_fmaf(sacc[i], c1, __builtin_fmaf(s16, (float)ci, base));
                sc = (ci <= nmaxh) ? sc : NEGBIG;
                const float e = fast_exp2(sc - mx); sacc[i] = e; sum += e;
            }
            float co[4];
#pragma unroll
            for (int gq = 0; gq < 4; ++gq) { const float p3 = 0.5f * sacc[4 * gq + 3];
                imp[4 * kt + gq] = sacc[4 * gq] + sacc[4 * gq + 1] + sacc[4 * gq + 2] + p3; co[gq] = __shfl_xor(p3, 32); }
#pragma unroll
            for (int gq = 0; gq < 4; ++gq) imp[4 * kt + gq] += hh ? co[gq] : (gq > 0 ? co[gq - 1] : prevc);
            prevc = co[3];
#pragma unroll
            for (int s2 = 0; s2 < 2; ++s2) {
                const bf16x8 pf = pack_step(sacc, s2);
                const int kb = 32 * kt + 16 * s2 + 4 * hh;
#pragma unroll
                for (int dt = 0; dt < 2; ++dt) {
                    LAS const bf16_t* vp = Vct + (32 * dt + l31) * CVST + kb;
                    const s16x4 lo = *(LAS const s16x4*)vp, hi = *(LAS const s16x4*)(vp + 8);
                    const bf16x8 vf = __builtin_shufflevector(lo, hi, 0, 1, 2, 3, 4, 5, 6, 7);
                    if (dt == 0) oc0 = MFMA32(vf, pf, oc0); else oc1 = MFMA32(vf, pf, oc1);
                }
            }
        }
    }
    sum = xhalf_sum(sum);
    const float inv = 1.0f / fmaxf(sum, 1.0e-30f);
#pragma unroll
    for (int j = 0; j < 16; ++j) imp[j] *= inv;
    oc0 *= inv; oc1 *= inv;
}

DI void load_cmp(const float* part_b, const float* pebias, const float* gk0, int g, int nkeys, LAS bf16_t* Kc, LAS bf16_t* Vct) {
    const int tid = threadIdx.x, e8 = (tid & 7) * 8;
    for (int n = tid >> 3; n < nkeys; n += 64) {
        float xk[8], xv[8];
        if (n <= 126) {
            const float* lo = part_b + ((size_t)n * 8) * 128; const float* hi = part_b + ((size_t)(n + 1) * 8) * 128 + 64;
            const f32x4 a0 = ld4(lo + g * 128 + e8), a1 = ld4(lo + g * 128 + e8 + 4), b0 = ld4(hi + g * 128 + e8), b1 = ld4(hi + g * 128 + e8 + 4);
            const f32x4 c0 = ld4(pebias + g * 64 + e8), c1 = ld4(pebias + g * 64 + e8 + 4);
            const f32x4 d0 = ld4(lo + (4 + g) * 128 + e8), d1 = ld4(lo + (4 + g) * 128 + e8 + 4), f0 = ld4(hi + (4 + g) * 128 + e8), f1 = ld4(hi + (4 + g) * 128 + e8 + 4);
            const f32x4 h0 = ld4(pebias + (4 + g) * 64 + e8), h1 = ld4(pebias + (4 + g) * 64 + e8 + 4);
            for (int i = 0; i < 4; ++i) { xk[i] = a0[i] + b0[i] + c0[i]; xk[4 + i] = a1[i] + b1[i] + c1[i]; xv[i] = d0[i] + f0[i] + h0[i]; xv[4 + i] = d1[i] + f1[i] + h1[i]; }
        } else { for (int i = 0; i < 8; ++i) { xk[i] = 0.f; xv[i] = 0.f; } }
        float ss = 0.f; for (int i = 0; i < 8; ++i) ss += xk[i] * xk[i];
        ss += __shfl_xor(ss, 1); ss += __shfl_xor(ss, 2); ss += __shfl_xor(ss, 4);
        const float rstd = __builtin_amdgcn_rsqf(ss * (1.0f / 64.0f) + 1e-6f);
        const f32x4 g0 = ld4(gk0 + e8), g1 = ld4(gk0 + e8 + 4);
        u32x4 w; for (int i = 0; i < 2; ++i) { w[i] = pack_bf2(xk[2 * i] * rstd * g0[2 * i], xk[2 * i + 1] * rstd * g0[2 * i + 1]); w[2 + i] = pack_bf2(xk[4 + 2 * i] * rstd * g1[2 * i], xk[5 + 2 * i] * rstd * g1[2 * i + 1]); }
        *(LAS u32x4*)(Kc + n * KST + e8) = w;
        for (int i = 0; i < 8; ++i) Vct[(e8 + i) * CVST + n] = (bf16_t)(pack_bf2(xv[i], 0.f) & 0xffffu);
    }
}

DI void attn_unit_P(const Params& p, int b, int g, int qt, LAS unsigned char* lds) {
    const int tid = threadIdx.x, wid = tid >> 6, lane = tid & 63, l31 = lane & 31, hh = lane >> 5;
    const int r = wid & 3, qh = wid >> 2, head = 4 * g + r;
    const int ql = 32 * qh + l31, t = 64 * qt + ql, row = b * 2048 + t;
    const float slope2 = fast_exp2(-0.5f * (float)(head + 1)) * LOG2E;
    const bf16_t* qbf = (const bf16_t*)(p.ws + WS_Q);
    bf16x8 qf[4];
#pragma unroll
    for (int s = 0; s < 4; ++s) qf[s] = *(const bf16x8*)(qbf + (size_t)row * 1024 + head * 64 + 16 * s + 8 * hh);
    LAS bf16_t* Kc = (LAS bf16_t*)lds; LAS bf16_t* Vct = (LAS bf16_t*)(lds + 128 * KST * 2);
    LAS float* impbuf = (LAS float*)(lds + 2 * KVBUF);
    LAS float* impsum = impbuf + 4 * 64 * 33;
    LAS unsigned* selm = (LAS unsigned*)(impsum + 64 * 33);
    const float* gt = (const float*)(p.ws + WS_GATES) + (size_t)row * 48 + head * 3;
    const float g0 = gt[0], g1 = gt[1], g2 = gt[2];
    f32x16 comb0, comb1;
    {
        int n_hi = 4 * qt + 2; n_hi = n_hi > 126 ? 126 : n_hi; const int ntile = (n_hi >> 5) + 1;
        load_cmp((const float*)(p.ws + WS_PART_P) + (size_t)b * 131072, (const float*)(p.ws + WS_PEBIAS), p.g_knorm, g, 32 * ntile, Kc, Vct);
        if (tid < 65) selm[tid] = 0u;
        __syncthreads();
        float imp[16]; f32x16 oc0, oc1;
        attn_cmp(Kc, Vct, qf, t, slope2, ntile, lane, oc0, oc1, imp);
        comb0 = oc0 * g0; comb1 = oc1 * g0;
#pragma unroll
        for (int j = 0; j < 16; ++j) impbuf[(r * 64 + ql) * 33 + 8 * (j >> 2) + 2 * (j & 3) + hh] = imp[j];
        __syncthreads();
    }
    unsigned mysel, un;
    if (qt >= 16) {
        const int q = tid >> 3, sub = tid & 7;
#pragma unroll
        for (int j = 0; j < 4; ++j) { const int s = sub * 4 + j; impsum[q * 33 + s] = (impbuf[(0 * 64 + q) * 33 + s] + impbuf[(1 * 64 + q) * 33 + s]) + (impbuf[(2 * 64 + q) * 33 + s] + impbuf[(3 * 64 + q) * 33 + s]); }
        __syncthreads();
        unsigned bits = 0u;
        for (int j = 0; j < 4; ++j) { const int s = sub * 4 + j;
            if (s >= 1 && s <= qt - 2) { const float v = impsum[q * 33 + s]; int cnt = 0;
                for (int s2 = 1; s2 <= qt - 2; ++s2) { const float v2 = impsum[q * 33 + s2]; cnt += (v2 > v || (v2 == v && s2 < s)) ? 1 : 0; }
                if (cnt < 13) bits |= 1u << s; } }
        bits |= __shfl_xor(bits, 1); bits |= __shfl_xor(bits, 2); bits |= __shfl_xor(bits, 4);
        bits |= 1u | (1u << qt) | (1u << (qt - 1));
        if (sub == 0) { selm[q] = bits; atomicOr((unsigned*)(selm + 64), bits); }
        __syncthreads();
        mysel = selm[ql]; un = selm[64];
    } else { mysel = (2u << qt) - 1u; un = mysel; }
    const bf16_t* kvs = (const bf16_t*)(p.ws + WS_KVS); const bf16_t* kvw = (const bf16_t*)(p.ws + WS_KVW);
    const bool ldK = tid < 256; const int v = tid & 255;
#pragma unroll 1
    for (int br = 0; br < 2; ++br) {
        const bf16_t* src = br ? kvw : kvs;
        const int k_lo = br ? (qt > 8 ? qt - 8 : 0) : 0;
        const unsigned tmask = br ? 0xffffffffu : un;
        AttnSt st; attn_init(st);
        u32x4 r0, r1;
        int kt = k_lo; while (kt <= qt && !((tmask >> kt) & 1u)) ++kt;
        auto issue = [&](int tile) {
            const size_t base = ((size_t)b * 2048 + 64 * tile) * 512 + g * 64;
            if (ldK) { r0 = *(const u32x4*)(src + base + (size_t)(v >> 3) * 512 + (v & 7) * 8); r1 = *(const u32x4*)(src + base + (size_t)((v >> 3) + 32) * 512 + (v & 7) * 8); }
            else { r0 = *(const u32x4*)(src + base + 256 + (size_t)(2 * (v >> 3)) * 512 + (v & 7) * 8); r1 = *(const u32x4*)(src + base + 256 + (size_t)(2 * (v >> 3) + 1) * 512 + (v & 7) * 8); }
        };
        if (kt <= qt) issue(kt);
        int buf = 0;
        while (kt <= qt) {
            LAS bf16_t* Kb = (LAS bf16_t*)(lds + buf * KVBUF); LAS bf16_t* Vt = Kb + 64 * KST;
            if (ldK) { *(LAS u32x4*)(Kb + (v >> 3) * KST + (v & 7) * 8) = r0; *(LAS u32x4*)(Kb + ((v >> 3) + 32) * KST + (v & 7) * 8) = r1; }
            else {
#pragma unroll
                for (int j = 0; j < 4; ++j) {
                    const unsigned a = r0[j], c = r1[j];
                    *(LAS unsigned*)(Vt + ((v & 7) * 8 + 2 * j) * VST + 2 * (v >> 3)) = (a & 0xffffu) | (c << 16);
                    *(LAS unsigned*)(Vt + ((v & 7) * 8 + 2 * j + 1) * VST + 2 * (v >> 3)) = (a >> 16) | (c & 0xffff0000u);
                }
            }
            __syncthreads();
            int nk = kt + 1; while (nk <= qt && !((tmask >> nk) & 1u)) ++nk;
            if (nk <= qt) issue(nk);
            const bool allow = br ? true : (((mysel >> kt) & 1u) != 0u);
            if (__any(allow)) { if (br) attn_tile64<1>(Kb, Vt, qf, t - 64 * kt, slope2, allow, lane, st); else attn_tile64<0>(Kb, Vt, qf, t - 64 * kt, slope2, allow, lane, st); }
            kt = nk; buf ^= 1;
        }
        const float sc = (br ? g2 : g1) / fmaxf(st.l, 1.0e-30f);
        comb0 += st.o0 * sc; comb1 += st.o1 * sc;
        __syncthreads();
    }
    bf16_t* ocat = (bf16_t*)(p.ws + WS_OCAT) + (size_t)row * DM + head * 64;
#pragma unroll
    for (int gq = 0; gq < 4; ++gq) {
        f32x4 a, c; for (int i = 0; i < 4; ++i) { a[i] = comb0[4 * gq + i]; c[i] = comb1[4 * gq + i]; }
        st_bf4(ocat + 8 * gq + 4 * hh, a); st_bf4(ocat + 32 + 8 * gq + 4 * hh, c);
    }
}
template <class RP>
DI void wave_load_kv(RP rp, LAS bf16_t* Kb, LAS bf16_t* Vt, int lane) {
    const int sub = lane >> 4, seg = lane & 15;
#pragma unroll 4
    for (int ps = 0; ps < 16; ++ps) {
        const int row = ps * 4 + sub; const float* ptr = rp(row);
        f32x4 v = {0.f, 0.f, 0.f, 0.f}; if (ptr) v = ld4(ptr + seg * 4);
        u32x2 w; w[0] = pack_bf2(v[0], v[1]); w[1] = pack_bf2(v[2], v[3]);
        *(LAS u32x2*)(Kb + row * KST + seg * 4) = w;
    }
#pragma unroll 4
    for (int ps = 0; ps < 8; ++ps) {
        const int kp = ps * 4 + sub; const float* p0 = rp(2 * kp); const float* p1 = rp(2 * kp + 1);
        f32x4 a = {0.f, 0.f, 0.f, 0.f}, c = {0.f, 0.f, 0.f, 0.f};
        if (p0) a = ld4(p0 + 256 + seg * 4); if (p1) c = ld4(p1 + 256 + seg * 4);
#pragma unroll
        for (int j = 0; j < 4; ++j) *(LAS unsigned*)(Vt + (seg * 4 + j) * VST + 2 * kp) = pack_bf2(a[j], c[j]);
    }
}

DI void attn_unit_S(const Params& p, int b, int g, LAS unsigned char* lds) {
    const int tid = threadIdx.x, wid = tid >> 6, lane = tid & 63, l31 = lane & 31, hh = lane >> 5;
    const int r = l31 >> 3, qi = l31 & 7, head = 4 * g + r, t = PAST + qi, row = NP + b * 8 + qi;
    const float slope2 = fast_exp2(-0.5f * (float)(head + 1)) * LOG2E;
    const bf16_t* qbf = (const bf16_t*)(p.ws + WS_Q);
    bf16x8 qf[4];
#pragma unroll
    for (int s = 0; s < 4; ++s) qf[s] = *(const bf16x8*)(qbf + (size_t)row * 1024 + head * 64 + 16 * s + 8 * hh);
    LAS bf16_t* Kc = (LAS bf16_t*)lds; LAS bf16_t* Vct = (LAS bf16_t*)(lds + 128 * KST * 2);
    LAS bf16_t* Kb = (LAS bf16_t*)(lds + wid * KVBUF); LAS bf16_t* Vt = Kb + 64 * KST;
    LAS float* impS = (LAS float*)(lds + 8 * KVBUF) + wid * 8 * 33;
    LAS float* ocb = (LAS float*)(lds + 8 * KVBUF + 8 * 8 * 33 * 4);
    LAS float* mo = (LAS float*)lds;
    LAS float* mm = mo + 8 * 2048; LAS float* ml = mm + 256;
    load_cmp((const float*)(p.ws + WS_PART_S) + (size_t)b * 131072, (const float*)(p.ws + WS_PEBIAS), p.g_knorm, g, 128, Kc, Vct);
    __syncthreads();
    unsigned mysel;
    {
        float imp[16]; f32x16 oc0, oc1;
        attn_cmp(Kc, Vct, qf, t, slope2, 4, lane, oc0, oc1, imp);
#pragma unroll
        for (int j = 0; j < 16; ++j) { float v = imp[j]; v += __shfl_xor(v, 8); v += __shfl_xor(v, 16); imp[j] = v; }
        if (l31 < 8) {
#pragma unroll
            for (int j = 0; j < 16; ++j) impS[qi * 33 + 8 * (j >> 2) + 2 * (j & 3) + hh] = imp[j];
        }
        if (wid == 0) {
#pragma unroll
            for (int i = 0; i < 16; ++i) { ocb[(crow(i, hh)) * 32 + l31] = oc0[i]; ocb[(32 + crow(i, hh)) * 32 + l31] = oc1[i]; }
        }
        __syncthreads();
        const int q2 = lane & 7, part = lane >> 3;
        unsigned bits = 0u;
        for (int j = 0; j < 4; ++j) { const int s = part * 4 + j;
            if (s >= 1 && s <= 30) { const float v = impS[q2 * 33 + s]; int cnt = 0;
                for (int s2 = 1; s2 <= 30; ++s2) { const float v2 = impS[q2 * 33 + s2]; cnt += (v2 > v || (v2 == v && s2 < s)) ? 1 : 0; }
                if (cnt < 13) bits |= 1u << s; } }
        bits |= __shfl_xor(bits, 8); bits |= __shfl_xor(bits, 16); bits |= __shfl_xor(bits, 32);
        bits |= 1u | (1u << 31);
        mysel = __shfl(bits, qi);
    }
    unsigned un = mysel;
    un |= __shfl_xor(un, 1); un |= __shfl_xor(un, 2); un |= __shfl_xor(un, 4);
    un = __builtin_amdgcn_readfirstlane(un);
    float res[4];
    const int mq = tid & 31, md = tid >> 5;
    const int mrow = NP + b * 8 + (mq & 7), mhead = 4 * g + (mq >> 3);
    const float* gt = (const float*)(p.ws + WS_GATES) + (size_t)mrow * 48 + mhead * 3;
    { const float g0 = gt[0]; for (int i = 0; i < 4; ++i) res[i] = g0 * ocb[(4 * md + i) * 32 + mq]; }
#pragma unroll 1
    for (int br = 0; br < 2; ++br) {
        AttnSt st; attn_init(st);
        if (br == 0) {
            int cnt = 0;
            for (int s = 0; s <= 32; ++s) {
                if (s < 32 && !((un >> s) & 1u)) continue;
                if ((cnt++ & 7) != wid) continue;
                if (s < 32) {
                    const int page = p.page_table[b * 16 + (s >> 1)];
                    const float* base = p.cache_slc + ((size_t)page * 128 + (s & 1) * 64) * 512 + g * 64;
                    wave_load_kv([&](int i) { return base + (size_t)i * 512; }, Kb, Vt, lane);
                } else {
                    const float* base = p.out + O_SLC_S + (size_t)b * 8 * 512 + g * 64;
                    wave_load_kv([&](int i) { return i < 8 ? base + (size_t)i * 512 : (const float*)nullptr; }, Kb, Vt, lane);
                }
                asm volatile("s_waitcnt lgkmcnt(0)" ::: "memory");
                const bool allow = s < 32 ? (((mysel >> s) & 1u) != 0u) : true;
                attn_tile64<0>(Kb, Vt, qf, t - 64 * s, slope2, allow, lane, st);
                asm volatile("s_waitcnt lgkmcnt(0)" ::: "memory");
            }
        } else {
            for (int j = wid; j < 9; j += 8) {
                if (j < 8) {
                    const float* base = p.cache_win + ((size_t)b * 512 + 64 * j) * 512 + g * 64;
                    wave_load_kv([&](int i) { return base + (size_t)i * 512; }, Kb, Vt, lane);
                } else {
                    const float* base = p.out + O_WIN_S + ((size_t)b * 512 + 504) * 512 + g * 64;
                    wave_load_kv([&](int i) { return i < 8 ? base + (size_t)i * 512 : (const float*)nullptr; }, Kb, Vt, lane);
                }
                asm volatile("s_waitcnt lgkmcnt(0)" ::: "memory");
                attn_tile64<1>(Kb, Vt, qf, t - (1536 + 64 * j), slope2, true, lane, st);
                asm volatile("s_waitcnt lgkmcnt(0)" ::: "memory");
            }
        }
        __syncthreads();
#pragma unroll
        for (int i = 0; i < 16; ++i) { mo[wid * 2048 + crow(i, hh) * 32 + l31] = st.o0[i]; mo[wid * 2048 + (32 + crow(i, hh)) * 32 + l31] = st.o1[i]; }
        if (hh == 0) { mm[wid * 32 + l31] = st.m; ml[wid * 32 + l31] = st.l; }
        __syncthreads();
        {
            float M = NEGBIG;
            for (int w = 0; w < 8; ++w) M = fmaxf(M, mm[w * 32 + mq]);
            float L = 0.f, acc[4] = {0.f, 0.f, 0.f, 0.f};
            for (int w = 0; w < 8; ++w) { const float f = fast_exp2(mm[w * 32 + mq] - M); L += ml[w * 32 + mq] * f;
                for (int i = 0; i < 4; ++i) acc[i] += mo[w * 2048 + (4 * md + i) * 32 + mq] * f; }
            const float sc = gt[1 + br] / fmaxf(L, 1.0e-30f);
            for (int i = 0; i < 4; ++i) res[i] += acc[i] * sc;
        }
        __syncthreads();
    }
    f32x4 o = {res[0], res[1], res[2], res[3]};
    st_bf4((bf16_t*)(p.ws + WS_OCAT) + (size_t)mrow * DM + mhead * 64 + 4 * md, o);
}
DI unsigned f2sortable(float f) { const unsigned u = __float_as_uint(f); return (u & 0x80000000u) ? ~u : (u | 0x80000000u); }
DI float sortable2f(unsigned s) { const unsigned u = (s & 0x80000000u) ? (s & 0x7fffffffu) : ~s; return __uint_as_float(u); }

DI void peer_scores_item(const Params& p, int item, int lane) {
    const int tile = item >> 4, hp = item & 15, h = hp >> 1, pp = hp & 1, l31 = lane & 31, hh = lane >> 5;
    const bf16_t* pq = (const bf16_t*)(p.ws + WS_PQ) + (size_t)(tile * 32 + l31) * DM + h * 256 + pp * 128 + 8 * hh;
    const bf16_t* sk = (const bf16_t*)(p.ws + WS_SUBK) + ((size_t)(pp * 8 + h) * 128 + l31) * 128 + 8 * hh;
    f32x16 acc[4]; for (int i = 0; i < 4; ++i) acc[i] = zero16();
#pragma unroll
    for (int s = 0; s < 8; ++s) {
        const bf16x8 qv = *(const bf16x8*)(pq + 16 * s);
#pragma unroll
        for (int kt = 0; kt < 4; ++kt) { const bf16x8 kv = *(const bf16x8*)(sk + (size_t)kt * 32 * 128 + 16 * s); acc[kt] = MFMA32(kv, qv, acc[kt]); }
    }
    unsigned x[64];
#pragma unroll
    for (int kt = 0; kt < 4; ++kt)
#pragma unroll
        for (int i = 0; i < 16; ++i) { const int key = 32 * kt + crow(i, hh); x[kt * 16 + i] = (f2sortable(acc[kt][i]) & ~127u) | (unsigned)(127 - key); }
    unsigned prev = 0xffffffffu; unsigned win[16];
#pragma unroll
    for (int rnd = 0; rnd < 16; ++rnd) {
        unsigned best = 0u;
#pragma unroll
        for (int j = 0; j < 64; ++j) { const unsigned c = x[j] < prev ? x[j] : 0u; best = best > c ? best : c; }
        const unsigned o = (unsigned)__shfl_xor((int)best, 32); best = best > o ? best : o;
        win[rnd] = best; prev = best;
    }
    if (hh == 0) {
        float* tv = (float*)(p.ws + WS_TOPV) + ((size_t)(tile * 32 + l31) * 16 + hp) * 16;
        int* ti = (int*)(p.ws + WS_TOPI) + ((size_t)(tile * 32 + l31) * 16 + hp) * 16;
#pragma unroll
        for (int j = 0; j < 4; ++j) {
            f32x4 v; u32x4 k;
            for (int i = 0; i < 4; ++i) { const unsigned w = win[4 * j + i]; v[i] = sortable2f(w & ~127u); k[i] = 127u - (w & 127u); }
            st4(tv + 4 * j, v); *(u32x4*)(ti + 4 * j) = k;
        }
    }
}

DI float wave_sum(float v) {
#pragma unroll
    for (int o = 32; o >= 1; o >>= 1) v += __shfl_xor(v, o);
    return v;
}
DI float gelu_exact(float x) { return 0.5f * x * (1.0f + erff(x * 0.70710678118654752f)); }

DI void peer_token(const Params& p, int tok, int lane) {
    const float* tv = (const float*)(p.ws + WS_TOPV) + (size_t)tok * 256;
    const int* ti = (const int*)(p.ws + WS_TOPI) + (size_t)tok * 256;
    const int hd = lane >> 3, sub = lane & 7;
    float s2v[16];
#pragma unroll
    for (int j = 0; j < 4; ++j) { const f32x4 v = ld4(tv + hd * 32 + 16 + 4 * j); for (int i = 0; i < 4; ++i) s2v[4 * j + i] = v[i]; }
    const float s1a = tv[hd * 32 + 2 * sub], s1b = tv[hd * 32 + 2 * sub + 1];
    unsigned x[32];
#pragma unroll
    for (int bb = 0; bb < 16; ++bb) {
        x[bb] = (f2sortable(s1a + s2v[bb]) & ~255u) | (unsigned)(255 - ((2 * sub) * 16 + bb));
        x[16 + bb] = (f2sortable(s1b + s2v[bb]) & ~255u) | (unsigned)(255 - ((2 * sub + 1) * 16 + bb));
    }
    unsigned prev = 0xffffffffu, w0 = 0u, w1 = 0u;
#pragma unroll
    for (int rnd = 0; rnd < 16; ++rnd) {
        unsigned best = 0u;
#pragma unroll
        for (int j = 0; j < 32; ++j) { const unsigned c = x[j] < prev ? x[j] : 0u; best = best > c ? best : c; }
#pragma unroll
        for (int o = 1; o <= 4; o <<= 1) { const unsigned ot = (unsigned)__shfl_xor((int)best, o); best = best > ot ? best : ot; }
        if (sub == (rnd >> 1)) { if (rnd & 1) w1 = best; else w0 = best; }
        prev = best;
    }
    const float sc0 = sortable2f(w0 & ~255u), sc1 = sortable2f(w1 & ~255u);
    const int id0 = 255 - (int)(w0 & 255u), id1 = 255 - (int)(w1 & 255u);
    const int e0 = ti[hd * 32 + (id0 >> 4)] * 128 + ti[hd * 32 + 16 + (id0 & 15)];
    const int e1 = ti[hd * 32 + (id1 >> 4)] * 128 + ti[hd * 32 + 16 + (id1 & 15)];
    float mx = fmaxf(sc0, sc1);
#pragma unroll
    for (int o = 1; o <= 4; o <<= 1) mx = fmaxf(mx, __shfl_xor(mx, o));
    float p0 = fast_exp2((sc0 - mx) * LOG2E), p1 = fast_exp2((sc1 - mx) * LOG2E);
    float sm = p0 + p1;
#pragma unroll
    for (int o = 1; o <= 4; o <<= 1) sm += __shfl_xor(sm, o);
    const float isum = 1.0f / sm; p0 *= isum; p1 *= isum;
    const bf16_t* h2 = (const bf16_t*)(p.ws + WS_H) + (size_t)tok * DM;
    float hx[32];
#pragma unroll
    for (int j = 0; j < 4; ++j) { const u32x4 q = *(const u32x4*)(h2 + j * 512 + lane * 8); for (int i = 0; i < 4; ++i) { hx[8 * j + 2 * i] = bf_lo(q[i]); hx[8 * j + 2 * i + 1] = bf_hi(q[i]); } }
    const bf16_t* U = (const bf16_t*)(p.ws + WS_U); const bf16_t* V = (const bf16_t*)(p.ws + WS_V);
    float wg0 = 0.f, wg1 = 0.f;
#pragma unroll 1
    for (int k0 = 0; k0 < 128; k0 += 4) {
        float dsum[4];
        u32x4 ub[4][4];
#pragma unroll
        for (int kk = 0; kk < 4; ++kk) { const int k = k0 + kk; const int e = __builtin_amdgcn_readlane((k & 1) ? e1 : e0, k >> 1);
            const bf16_t* ur = U + (size_t)e * DM + lane * 8;
#pragma unroll
            for (int j = 0; j < 4; ++j) ub[kk][j] = *(const u32x4*)(ur + j * 512); }
#pragma unroll
        for (int kk = 0; kk < 4; ++kk) { float d = 0.f;
#pragma unroll
            for (int j = 0; j < 4; ++j)
#pragma unroll
                for (int i = 0; i < 4; ++i) { d = __builtin_fmaf(bf_lo(ub[kk][j][i]), hx[8 * j + 2 * i], d); d = __builtin_fmaf(bf_hi(ub[kk][j][i]), hx[8 * j + 2 * i + 1], d); }
            dsum[kk] = wave_sum(d); }
#pragma unroll
        for (int kk = 0; kk < 4; ++kk) { const int k = k0 + kk; const float a = gelu_exact(dsum[kk]);
            if (lane == (k >> 1)) { if (k & 1) wg1 = p1 * a; else wg0 = p0 * a; } }
    }
    float ov[32];
#pragma unroll
    for (int i = 0; i < 32; ++i) ov[i] = 0.f;
#pragma unroll 1
    for (int k0 = 0; k0 < 128; k0 += 4) {
        u32x4 vb[4][4]; float wk[4];
#pragma unroll
        for (int kk = 0; kk < 4; ++kk) { const int k = k0 + kk; const int e = __builtin_amdgcn_readlane((k & 1) ? e1 : e0, k >> 1);
            wk[kk] = __builtin_bit_cast(float, __builtin_amdgcn_readlane(__builtin_bit_cast(int, (k & 1) ? wg1 : wg0), k >> 1));
            const bf16_t* vr = V + (size_t)e * DM + lane * 8;
#pragma unroll
            for (int j = 0; j < 4; ++j) vb[kk][j] = *(const u32x4*)(vr + j * 512); }
#pragma unroll
        for (int kk = 0; kk < 4; ++kk)
#pragma unroll
            for (int j = 0; j < 4; ++j)
#pragma unroll
                for (int i = 0; i < 4; ++i) { ov[8 * j + 2 * i] = __builtin_fmaf(bf_lo(vb[kk][j][i]), wk[kk], ov[8 * j + 2 * i]); ov[8 * j + 2 * i + 1] = __builtin_fmaf(bf_hi(vb[kk][j][i]), wk[kk], ov[8 * j + 2 * i + 1]); }
    }
    const int mrow = tok < NP ? (tok >> 11) : 8 + ((tok - NP) >> 3);
    const float* gate = (const float*)(p.ws + WS_MOD) + (size_t)mrow * 12288 + 5 * DM;
    float* y = p.out + (size_t)tok * DM;
#pragma unroll
    for (int j = 0; j < 4; ++j) {
        const int c = j * 512 + lane * 8;
        f32x4 a = ld4(y + c), b2 = ld4(y + c + 4); const f32x4 ga = ld4(gate + c), gb = ld4(gate + c + 4);
        for (int i = 0; i < 4; ++i) { a[i] += ga[i] * ov[8 * j + i]; b2[i] += gb[i] * ov[8 * j + 4 + i]; }
        st4(y + c, a); st4(y + c + 4, b2);
    }
}
constexpr int LDS_BYTES = 163840 - 64;
constexpr int N_PHASES = 11;
#ifndef MK_LAUNCHES
#define MK_LAUNCHES 11
#endif

__global__ __launch_bounds__(512, 2) void mega(Params p) {
    extern __shared__ __attribute__((aligned(16))) unsigned char shm[];
    LAS unsigned char* lds = (LAS unsigned char*)shm;
    const int tid = threadIdx.x, wid = tid >> 6, lane = tid & 63;
    volatile LAS unsigned* xbw = (volatile LAS unsigned*)(lds + LDS_BYTES - 16);
    if (tid == 0) { xbw[0] = 0u; xbw[1] = 0u; xbw[2] = 0u; xbw[3] = 0u; }
    __syncthreads();
    XcdBarrier bar = xcd_barrier_post((unsigned*)(p.ws + WS_BAR), xbw);
#ifndef PH_MASK
#define PH_MASK 0x7ff
#endif
#define IN(ph) (((PH_MASK >> (ph)) & 1) && p.ph_lo <= (ph) && (ph) < p.ph_hi)
#define SEAM(ph) do { if (IN(ph) && IN((ph) + 1)) xcd_barrier(bar); } while (0)
    if (IN(0)) phase_A(p, lds);
    SEAM(0);
    if (IN(1)) {
        constexpr int NADA = 48;
        if ((int)gridDim.x > NADA) {
            if ((int)blockIdx.x < NADA) {
                pg8::Gemm g{(const bf16_t*)(p.ws + WS_SILUC), (const bf16_t*)(p.ws + WS_WADA_T), 256, 12288, DM};
                pg8::StaticOrder S; S.init(256, 12288, NADA, (int)blockIdx.x);
                EpiAda E{(float*)(p.ws + WS_MOD), p.b_ada};
                pg8::gemm_phase<EpiAda, pg8::StaticOrder, false>(lds, g, S, E, nullptr);
            } else phase_B_stream(p, NADA);
        }
    }
    SEAM(1);
    if (IN(2)) phase_modulate(p, 0);
    SEAM(2);
    if (IN(3)) {
        pg8::Gemm g{(const bf16_t*)(p.ws + WS_H), (const bf16_t*)(p.ws + WS_WIN_T), NTOK, NIN_PAD, DM};
        pg8::StaticOrder S; S.init(NTOK, NIN_PAD, (int)gridDim.x, (int)blockIdx.x);
        EpiIn E{(bf16_t*)(p.ws + WS_Q), (bf16_t*)(p.ws + WS_KVS), (bf16_t*)(p.ws + WS_KVW), (bf16_t*)(p.ws + WS_UBF), p.out, (float*)(p.ws + WS_GATES), p.g_qnorm, p.g_knorm};
        pg8::gemm_phase<EpiIn, pg8::StaticOrder, false>(lds, g, S, E, nullptr);
    }
    SEAM(3);
    if (IN(4)) {
        for (int u = blockIdx.x; u < 2176 + 544; u += gridDim.x) { if (u < 2176) cmp_unit(p, u, lds); else pool_unit(p, u - 2176, lds); }
    }
    SEAM(4);
    if (IN(5)) {
        const int G = gridDim.x;
#ifndef NO_P
#pragma unroll 1
        for (int i = blockIdx.x; i < 1024; i += G) {
            const int rnd = i / 256, k = (i % 256) >> 5, bg = i & 31;
            const int qt = (rnd & 1) ? (31 - 8 * rnd - 7 + k) : (31 - 8 * rnd - k);
            attn_unit_P(p, bg >> 2, bg & 3, qt, lds);
        }
#endif
#ifndef NO_S
#pragma unroll 1
        for (int j = blockIdx.x; j < 512; j += G) attn_unit_S(p, j >> 2, j & 3, lds);
#endif
    }
    SEAM(5);
    if (IN(6)) {
        pg8::Gemm g{(const bf16_t*)(p.ws + WS_OCAT), (const bf16_t*)(p.ws + WS_WOUT_T), NTOK, DM, DM};
        pg8::StaticOrder S; S.init(NTOK, DM, (int)gridDim.x, (int)blockIdx.x);
        EpiOut E{p.x_prompt, p.x_sample, (const float*)(p.ws + WS_MOD), p.out};
        pg8::gemm_phase<EpiOut, pg8::StaticOrder, false>(lds, g, S, E, nullptr);
    }
    SEAM(6);
    if (IN(7)) phase_modulate(p, 1);
    SEAM(7);
    if (IN(8)) {
        pg8::Gemm g{(const bf16_t*)(p.ws + WS_H), (const bf16_t*)(p.ws + WS_WQ_T), NTOK, DM, DM};
        pg8::StaticOrder S; S.init(NTOK, DM, (int)gridDim.x, (int)blockIdx.x);
        EpiPq E{(bf16_t*)(p.ws + WS_PQ)};
        pg8::gemm_phase<EpiPq, pg8::StaticOrder, false>(lds, g, S, E, nullptr);
    }
    SEAM(8);
    if (IN(9)) { for (int it = blockIdx.x * 8 + wid; it < 544 * 16; it += gridDim.x * 8) peer_scores_item(p, it, lane); }
    SEAM(9);
    if (IN(10)) { for (int tok = blockIdx.x * 8 + wid; tok < NTOK; tok += gridDim.x * 8) peer_token(p, tok, lane); }
#undef IN
#undef SEAM
}

extern "C" void kernel_launch(void* const* d_in, const int* in_sizes, int n_in, void* d_out, int out_size, void* d_ws, size_t ws_size, hipStream_t stream) {
    static int grid = 0;
    if (grid == 0) {
        if (n_in != 25 || ws_size < WS_END) { fprintf(stderr, "kernel_launch: unexpected inputs (n_in %d, ws %zu < %zu)\n", n_in, ws_size, (size_t)WS_END); grid = -1; return; }
        int dev = 0, cus = 0, per_cu = 0;
        if (hipGetDevice(&dev) != hipSuccess || hipDeviceGetAttribute(&cus, hipDeviceAttributeMultiprocessorCount, dev) != hipSuccess) { grid = -1; return; }
        if (hipFuncSetAttribute((const void*)mega, hipFuncAttributeMaxDynamicSharedMemorySize, LDS_BYTES) != hipSuccess) { fprintf(stderr, "kernel_launch: hipFuncSetAttribute failed\n"); grid = -1; return; }
        if (hipOccupancyMaxActiveBlocksPerMultiprocessor(&per_cu, (const void*)mega, 512, LDS_BYTES) != hipSuccess || per_cu < 1)
            fprintf(stderr, "kernel_launch: occupancy query reports %d blocks per CU\n", per_cu);
        (void)hipGetLastError();
        grid = cus;
    }
    if (grid < 0) return;
    (void)hipMemsetAsync((char*)d_ws + WS_BAR, 0, XCD_BAR_WORDS * sizeof(unsigned), stream);
    Params p{};
    p.x_prompt = (const float*)d_in[0]; p.x_sample = (const float*)d_in[1]; p.cache_cmp = (const float*)d_in[2]; p.cache_slc = (const float*)d_in[3];
    p.cache_win = (const float*)d_in[4]; p.state_pool = (const float*)d_in[5]; p.page_table = (const int*)d_in[6]; p.c_prompt = (const float*)d_in[7];
    p.c_sample = (const float*)d_in[8]; p.w_ada = (const float*)d_in[9]; p.b_ada = (const float*)d_in[10]; p.g_norm1 = (const float*)d_in[11];
    p.g_norm2 = (const float*)d_in[12]; p.w_in = (const float*)d_in[13]; p.w_out = (const float*)d_in[14]; p.g_qnorm = (const float*)d_in[15];
    p.g_knorm = (const float*)d_in[16]; p.cmp_pe = (const float*)d_in[17]; p.w_cmp = (const float*)d_in[18]; p.w_pool = (const float*)d_in[19];
    p.pool_scale = (const float*)d_in[20]; p.peer_wq = (const float*)d_in[21]; p.peer_subkeys = (const float*)d_in[22]; p.peer_u = (const float*)d_in[23];
    p.peer_v = (const float*)d_in[24];
    p.out = (float*)d_out; p.ws = (unsigned char*)d_ws;
#if MK_LAUNCHES == 1
    p.ph_lo = 0; p.ph_hi = N_PHASES;
    hipLaunchKernelGGL(mega, dim3(grid), dim3(512), LDS_BYTES, stream, p);
#else
    for (int ph = 0; ph < N_PHASES; ++ph) { p.ph_lo = ph; p.ph_hi = ph + 1; hipLaunchKernelGGL(mega, dim3(grid), dim3(512), LDS_BYTES, stream, p); }
#endif
}
```

```cpp
#include <hip/hip_runtime.h>
#include <stdint.h>
#include <stdio.h>

#define DI __device__ __forceinline__
#define LAS __attribute__((address_space(3)))
typedef unsigned short bf16_t;
typedef short bf16x8 __attribute__((ext_vector_type(8)));
typedef short s16x4 __attribute__((ext_vector_type(4)));
typedef float f32x2 __attribute__((ext_vector_type(2)));
typedef float f32x4 __attribute__((ext_vector_type(4)));
typedef float f32x16 __attribute__((ext_vector_type(16)));
typedef unsigned u32x2 __attribute__((ext_vector_type(2)));
typedef unsigned u32x4 __attribute__((ext_vector_type(4)));
typedef __bf16 bf16v2 __attribute__((ext_vector_type(2)));

constexpr int DM = 2048;
constexpr int NP = 16384;
constexpr int NSM = 1024;
constexpr int NTOK = NP + NSM;
constexpr int SEQ = 2048, NB_P = 8, NB_S = 128, TS = 8, PAST = 2048;
constexpr int NIN_PAD = 3840;
constexpr int NEXP = 16384;
constexpr float LOG2E = 1.4426950408889634f;
constexpr float NEGBIG = -1.0e30f;

constexpr size_t O_Y = 0;
constexpr size_t O_CMP_P = 35651584, O_SLC_P = 44040192, O_WIN_P = 52428800, O_POOL_P = 54525952;
constexpr size_t O_CMP_S = 54648832, O_SLC_S = 55173120, O_WIN_S = 55697408, O_POOL_S = 89251840;

constexpr size_t al256(size_t x) { return (x + 255) & ~(size_t)255; }
constexpr size_t WS_BAR = 0;
constexpr size_t WS_WIN_T = 16384;
constexpr size_t WS_WOUT_T = WS_WIN_T + (size_t)NIN_PAD * DM * 2;
constexpr size_t WS_WQ_T = WS_WOUT_T + (size_t)DM * DM * 2;
constexpr size_t WS_WCMP_T = WS_WQ_T + (size_t)DM * DM * 2 + (size_t)12288 * DM * 2;
constexpr size_t WS_WPOOL_T = WS_WCMP_T + (size_t)8 * 128 * 1024 * 2;
constexpr size_t WS_SUBK = WS_WPOOL_T + (size_t)4 * 256 * 256 * 2;
constexpr size_t WS_U = WS_SUBK + (size_t)2 * 8 * 128 * 128 * 2;
constexpr size_t WS_V = WS_U + (size_t)NEXP * DM * 2;
constexpr size_t WS_PEBIAS = WS_V + (size_t)NEXP * DM * 2;
constexpr size_t WS_MOD = WS_PEBIAS + 4096 + (size_t)256 * DM * 2;
constexpr size_t WS_H = WS_MOD + (size_t)256 * 12288 * 4;
constexpr size_t WS_Q = WS_H + (size_t)NTOK * DM * 2;
constexpr size_t WS_X1 = WS_Q;
constexpr size_t WS_KVS = WS_Q + (size_t)NTOK * 1024 * 2;
constexpr size_t WS_KVW = WS_KVS + (size_t)NP * 512 * 2;
constexpr size_t WS_GATES = WS_KVW + (size_t)NP * 512 * 2;
constexpr size_t WS_UBF = WS_GATES + (size_t)NTOK * 48 * 4;
constexpr size_t WS_PART_S = WS_UBF + (size_t)NTOK * 1024 * 2;
constexpr size_t WS_PART_P = WS_PART_S + (size_t)NB_S * 128 * 8 * 128 * 4;
constexpr size_t WS_OCAT = WS_PART_P + (size_t)NB_P * 128 * 8 * 128 * 4;
constexpr size_t WS_PQ = WS_OCAT + (size_t)NTOK * DM * 2;
constexpr size_t WS_TOPV = WS_PQ + (size_t)NTOK * DM * 2;
constexpr size_t WS_TOPI = WS_TOPV + (size_t)NTOK * 256 * 4;
constexpr size_t WS_USCALE = WS_TOPI + (size_t)NTOK * 256 * 4;
constexpr size_t WS_VSCALE = WS_USCALE + (size_t)NEXP * 64;
constexpr size_t WS_END = WS_VSCALE + (size_t)NEXP * 64;

struct Params {
    const float *x_prompt, *x_sample, *cache_cmp, *cache_slc, *cache_win, *state_pool;
    const int* page_table;
    const float *c_prompt, *c_sample, *w_ada, *b_ada, *g_norm1, *g_norm2, *w_in, *w_out, *g_qnorm, *g_knorm, *cmp_pe, *w_cmp, *w_pool, *pool_scale,
        *peer_wq, *peer_subkeys, *peer_u, *peer_v;
    float* out;
    unsigned char* ws;
    int ph_lo, ph_hi;
};

DI unsigned pack_bf2(float lo, float hi) {
    f32x2 v = {lo, hi};
    bf16v2 r = __builtin_convertvector(v, bf16v2);
    return __builtin_bit_cast(unsigned, r);
}
DI float bf_lo(unsigned u) { return __uint_as_float(u << 16); }
DI float bf_hi(unsigned u) { return __uint_as_float(u & 0xffff0000u); }
DI float fast_exp2(float x) { return __builtin_amdgcn_exp2f(x); }
DI float fast_rcp(float x) { return __builtin_amdgcn_rcpf(x); }
DI int crow(int reg, int h) { return (reg & 3) + 8 * (reg >> 2) + 4 * h; }
#define MFMA32(a, b, c) __builtin_amdgcn_mfma_f32_32x32x16_bf16((a), (b), (c), 0, 0, 0)
DI f32x16 zero16() { f32x16 z; for (int i = 0; i < 16; ++i) z[i] = 0.f; return z; }
DI bf16x8 pack_step(const f32x16& x, int s) {
    u32x4 p;
    p[0] = pack_bf2(x[8 * s + 0], x[8 * s + 1]); p[1] = pack_bf2(x[8 * s + 2], x[8 * s + 3]);
    p[2] = pack_bf2(x[8 * s + 4], x[8 * s + 5]); p[3] = pack_bf2(x[8 * s + 6], x[8 * s + 7]);
    return __builtin_bit_cast(bf16x8, p);
}
#define XB_TMO      128
#define XB_XCNT(j)  (256  + 64 * (j))
#define XB_XSUB(j)  (1280 + 64 * (j))
#define XB_XGEN(j)  (2304 + 64 * (j))
#define XB_TOP      3328
#define XB_TOPGEN   3392
#define XCD_BAR_WORDS 3456
#define XB_SPIN_CAP (1u << 22)

__device__ __forceinline__ unsigned xb_ld(unsigned* p)              { return __hip_atomic_load(p, __ATOMIC_RELAXED, __HIP_MEMORY_SCOPE_AGENT); }
__device__ __forceinline__ unsigned xb_add(unsigned* p, unsigned v) { return __hip_atomic_fetch_add(p, v, __ATOMIC_RELAXED, __HIP_MEMORY_SCOPE_AGENT); }
__device__ __forceinline__ unsigned xb_xcc_id() { return (unsigned)__builtin_amdgcn_s_getreg((3 << 11) | 20) & 0xFu; }
#define XB_SPIN(cond, bar) do { unsigned _sp = 0; while (cond) { __builtin_amdgcn_s_sleep(1); \
    if ((++_sp & 255u) == 0u) { if (xb_ld(&(bar)[XB_TMO])) break; if (_sp > XB_SPIN_CAP) { atomicAdd(&(bar)[XB_TMO], 1u); break; } } } } while (0)

struct XcdBarrier {
    unsigned* bar; unsigned x;
    volatile LAS unsigned* st;
};

__device__ __forceinline__ XcdBarrier xcd_barrier_post(unsigned* bar, volatile LAS unsigned* st) {
    XcdBarrier b; b.bar = bar; b.x = xb_xcc_id(); b.st = st;
    if (threadIdx.x == 0) (void)xb_add(&bar[XB_XCNT(b.x)], 1u);
    return b;
}
__device__ __forceinline__ void xcd_barrier_complete(unsigned* bar, unsigned x, unsigned& nloc, unsigned& nx) {
    const unsigned G = gridDim.x * gridDim.y * gridDim.z;
    unsigned sum, cnt, mine, sp = 0u;
    for (;;) {
        sum = 0u; cnt = 0u; mine = 0u;
#pragma unroll
        for (unsigned j = 0; j < 16; ++j) { const unsigned c = xb_ld(&bar[XB_XCNT(j)]); sum += c; cnt += (c > 0u) ? 1u : 0u; mine = (j == x) ? c : mine; }
        if (sum == G) break;
        __builtin_amdgcn_s_sleep(1);
        if ((++sp & 255u) == 0u) { if (xb_ld(&bar[XB_TMO])) break; if (sp > XB_SPIN_CAP) { atomicAdd(&bar[XB_TMO], 1u); break; } }
    }
    nloc = mine > 0u ? mine : 1u; nx = cnt > 0u ? cnt : 1u;
}

__device__ __forceinline__ void xcd_barrier(const XcdBarrier& b) {
    asm volatile("s_waitcnt vmcnt(0)" ::: "memory");
    __syncthreads();
    if (threadIdx.x == 0) {
        unsigned* bar = b.bar;
        __builtin_amdgcn_s_waitcnt(0);
        unsigned nloc = b.st[0], nx = b.st[1];
        if (nloc == 0u) { xcd_barrier_complete(bar, b.x, nloc, nx); b.st[0] = nloc; b.st[1] = nx; }
        const unsigned old = xb_add(&bar[XB_XSUB(b.x)], 1u);
        const unsigned gen = old / nloc;
        if (old + 1u == (gen + 1u) * nloc) {
            __builtin_amdgcn_fence(__ATOMIC_RELEASE, "agent");
            asm volatile("s_waitcnt vmcnt(0)" ::: "memory");
            const unsigned og = xb_add(&bar[XB_TOP], 1u);
            const unsigned tg = og / nx;
            if (og + 1u == (tg + 1u) * nx) xb_add(&bar[XB_TOPGEN], 1u);
            else XB_SPIN(xb_ld(&bar[XB_TOPGEN]) == tg, bar);
            __builtin_amdgcn_fence(__ATOMIC_ACQUIRE, "agent");
            xb_add(&bar[XB_XGEN(b.x)], 1u);
            asm volatile("s_waitcnt vmcnt(0)" ::: "memory");
        } else {
            XB_SPIN(xb_ld(&bar[XB_XGEN(b.x)]) == gen, bar);
            __builtin_amdgcn_fence(__ATOMIC_ACQUIRE, "agent");
            asm volatile("s_waitcnt vmcnt(0)" ::: "memory");
        }
    }
    __syncthreads();
}

namespace pg8 {
#define PG8_LAS __attribute__((address_space(3)))
constexpr int BM = 256, BK = 64, HALF = 128, HTB = HALF * BK * 2  , STAGE_BYTES = 8 * HTB, NXCD = 8, WGM = 8;

__host__ __device__ __forceinline__ int lds_byte(int r, int c) { const int st = (r >> 4) * 2 + (c >> 5), rr = r & 15, cc = c & 31, ob = rr * 64 + cc * 2; return st * 1024 + (ob ^ (((ob >> 9) & 1) << 5)); }
__host__ __device__ __forceinline__ void stage_rc(int b, int& R, int& C) { const int st = b / 1024, sb = b % 1024, swz = sb ^ (((sb >> 9) & 1) << 5); R = (st >> 1) * 16 + swz / 64; C = (st & 1) * 32 + (swz % 64) / 2; }
__host__ __device__ __forceinline__ int perm32(int rho) { const int n = rho >> 4, i = rho & 15; return 8 * (i >> 2) + 4 * n + (i & 3); }

struct Unit { int pm, pn; };
struct Gemm { const bf16_t* A; const bf16_t* Bt; int M, N, K; };

struct StaticOrder {
    int nM, nN, nwg, G, c;
    __host__ __device__ void init(int M, int N, int G_, int c_) { nM = M / BM; nN = N / BM; nwg = nM * nN; G = G_; c = c_; }
    __host__ __device__ bool next(int i, Unit& u) const {
        const long L = (long)i * G + c; if (L >= nwg) return false;
        int wgid = (int)L; { const int q = nwg / NXCD, r = nwg % NXCD, xcd = wgid % NXCD, off = wgid / NXCD; wgid = (xcd < r ? xcd * (q + 1) : r * (q + 1) + (xcd - r) * q) + off; }
        const int nig = WGM * nN, gid = wgid / nig, fm = gid * WGM, gsz = (nM - fm) < WGM ? (nM - fm) : WGM;
        u.pm = fm + ((wgid % nig) % gsz); u.pn = (wgid % nig) / gsz; return true;
    }
    __device__ __forceinline__ void a_ready(const Unit&) const {}
    __device__ __forceinline__ void done(const Unit&) const {}
};
template <class Epi, class Sched, bool STAMP = false>
__device__ __forceinline__ void gemm_phase(PG8_LAS unsigned char* lds, const Gemm g, const Sched& S, const Epi& E, unsigned long long* stamps) {
    const int tid = threadIdx.x, wid = __builtin_amdgcn_readfirstlane(tid >> 6), lane = tid & 63, wr = wid >> 2, wc = wid & 3, fr = lane & 15, fq = lane >> 4;
    const int K = g.K, nt = K / BK;
    int ts_lo = 0, ts_hi = 0, nts = 0; const unsigned long long rt_entry = STAMP ? (unsigned long long)wall_clock64() : 0ull;
#define PG8_STAMP() do { if (STAMP && wid == 0 && nts < 64) { const unsigned long long _c = (unsigned long long)clock64(); \
        ts_lo = (lane == nts) ? (int)(unsigned)_c : ts_lo; ts_hi = (lane == nts) ? (int)(unsigned)(_c >> 32) : ts_hi; ++nts; } } while (0)
    PG8_STAMP();
    unsigned voffA[2], voffB[2];
#pragma unroll
    for (int i = 0; i < 2; ++i) { int R, C; stage_rc(tid * 16 + i * 8192, R, C); const int Rb = Epi::PERM ? ((R & ~31) + perm32(R & 31)) : R;
        voffA[i] = (unsigned)(R * K + C) * 2u; voffB[i] = (unsigned)(Rb * K + C) * 2u; }
    const size_t kstep = (size_t)(BK * 2);
    const size_t hstep = (size_t)HALF * K * 2;
    const size_t tstep = 2 * hstep;
    const unsigned ldsw = (unsigned)wid * 1024u;
    const int aoff = lds_byte(wr * 64 + fr, fq * 8), boff = lds_byte(wc * 32 + fr, fq * 8);
#define PG8_SA(b, h) (((b) * 2 + (h)) * HTB)
#define PG8_SB(b, h) ((4 + (b) * 2 + (h)) * HTB)
#define PG8_STAGE(bufoff, gbase, voff) do { _Pragma("unroll") for (int _i = 0; _i < 2; ++_i) \
        __builtin_amdgcn_global_load_lds((const unsigned*)((const char*)(gbase) + (voff)[_i]), (PG8_LAS unsigned*)(lds + (bufoff) + ldsw + _i * 8192), 16, 0, 0); } while (0)
#define PG8_LDA(dst, b, h) do { _Pragma("unroll") for (int m = 0; m < 4; ++m) _Pragma("unroll") for (int k = 0; k < 2; ++k) dst[m][k] = *(const PG8_LAS bf16x8*)(lds + PG8_SA(b, h) + aoff + m * 2048 + k * 1024); } while (0)
#define PG8_LDB(dst, b, h) do { _Pragma("unroll") for (int n = 0; n < 2; ++n) _Pragma("unroll") for (int k = 0; k < 2; ++k) dst[n][k] = *(const PG8_LAS bf16x8*)(lds + PG8_SB(b, h) + boff + n * 2048 + k * 1024); } while (0)
#define PG8_MMA(ai, bj, At, Bt) do { __builtin_amdgcn_s_setprio(1); _Pragma("unroll") for (int m = 0; m < 4; ++m) _Pragma("unroll") for (int n = 0; n < 2; ++n) _Pragma("unroll") for (int k = 0; k < 2; ++k) \
        acc[ai][bj][m][n] = __builtin_amdgcn_mfma_f32_16x16x32_bf16(Bt[n][k], At[m][k], acc[ai][bj][m][n], 0, 0, 0); __builtin_amdgcn_s_setprio(0); } while (0)
#define PG8_WAIT_V(n) asm volatile("s_waitcnt vmcnt(" #n ")" ::: "memory")
#define PG8_WAIT_L(n) asm volatile("s_waitcnt lgkmcnt(" #n ")" ::: "memory")
#define PG8_BAR __builtin_amdgcn_s_barrier()
#define PG8_SCHED __builtin_amdgcn_sched_barrier(0)
    Unit cur, nxt; int ui = 0;
    if (!S.next(0, cur)) return;
    f32x4 acc[2][2][4][2];
#pragma unroll
    for (int a = 0; a < 2; ++a)
#pragma unroll
        for (int b = 0; b < 2; ++b)
#pragma unroll
            for (int m = 0; m < 4; ++m)
#pragma unroll
                for (int n = 0; n < 2; ++n) acc[a][b][m][n] = (f32x4){0.f, 0.f, 0.f, 0.f};
    bf16x8 At[4][2], B0[2][2], B1[2][2];
    const char* cA = (const char*)g.A + (size_t)cur.pm * tstep; const char* cB = (const char*)g.Bt + (size_t)cur.pn * tstep;
    S.a_ready(cur);
    PG8_STAGE(PG8_SB(0, 0), cB, voffB); PG8_STAGE(PG8_SA(0, 0), cA, voffA); PG8_STAGE(PG8_SB(0, 1), cB + hstep, voffB); PG8_STAGE(PG8_SA(0, 1), cA + hstep, voffA);
    if (wr == 1) PG8_BAR;
    PG8_WAIT_V(4); PG8_BAR;
    PG8_STAGE(PG8_SB(1, 0), cB + kstep, voffB); PG8_STAGE(PG8_SA(1, 0), cA + kstep, voffA); PG8_STAGE(PG8_SB(1, 1), cB + hstep + kstep, voffB);
    PG8_WAIT_V(6); PG8_BAR;
    PG8_STAMP();
    for (;;) {
        const bool has_next = S.next(ui + 1, nxt);
        const char* nA = has_next ? (const char*)g.A + (size_t)nxt.pm * tstep : cA; const char* nB = has_next ? (const char*)g.Bt + (size_t)nxt.pn * tstep : cB;
        for (int t = 0; t < nt; t += 2) {
            const bool last = (t == nt - 2);
            const char* a1 = cA + (size_t)(t + 1) * kstep;
            const char* a2 = last ? nA : cA + (size_t)(t + 2) * kstep; const char* b2 = last ? nB : cB + (size_t)(t + 2) * kstep;
            const char* a3 = a2 + kstep; const char* b3 = b2 + kstep;
            if (last && has_next) S.a_ready(nxt);
            PG8_LDB(B0, 0, 0); PG8_SCHED; PG8_LDA(At, 0, 0); PG8_STAGE(PG8_SA(1, 1), a1 + hstep, voffA);
            PG8_WAIT_L(8); PG8_BAR; PG8_WAIT_L(0); PG8_MMA(0, 0, At, B0); PG8_BAR; PG8_SCHED;
            PG8_LDB(B1, 0, 1); PG8_STAGE(PG8_SB(0, 0), b2, voffB);
            PG8_BAR; PG8_WAIT_L(0); PG8_MMA(0, 1, At, B1); PG8_BAR;
            PG8_LDA(At, 0, 1); PG8_STAGE(PG8_SA(0, 0), a2, voffA);
            PG8_BAR; PG8_WAIT_L(0); PG8_MMA(1, 0, At, B0); PG8_BAR; PG8_SCHED;
            PG8_STAGE(PG8_SB(0, 1), b2 + hstep, voffB);
            PG8_WAIT_V(6); PG8_BAR; PG8_MMA(1, 1, At, B1); PG8_BAR;
            PG8_LDB(B0, 1, 0); PG8_SCHED; PG8_LDA(At, 1, 0); PG8_STAGE(PG8_SA(0, 1), a2 + hstep, voffA);
            PG8_WAIT_L(8); PG8_BAR; PG8_WAIT_L(0); PG8_MMA(0, 0, At, B0); PG8_BAR; PG8_SCHED;
            PG8_LDB(B1, 1, 1); PG8_STAGE(PG8_SB(1, 0), b3, voffB);
            PG8_BAR; PG8_WAIT_L(0); PG8_MMA(0, 1, At, B1); PG8_BAR;
            PG8_LDA(At, 1, 1); PG8_STAGE(PG8_SA(1, 0), a3, voffA);
            PG8_BAR; PG8_WAIT_L(0); PG8_MMA(1, 0, At, B0); PG8_BAR; PG8_SCHED;
            PG8_STAGE(PG8_SB(1, 1), b3 + hstep, voffB);
            PG8_WAIT_V(6); PG8_BAR; PG8_MMA(1, 1, At, B1); PG8_BAR;
        }
        PG8_STAMP();
        if constexpr (!Epi::AFTER_DRAIN) { E(acc, cur, wr, wc, fr, fq); S.done(cur); }
        PG8_STAMP();
        if (!has_next) break;
#pragma unroll
        for (int a = 0; a < 2; ++a)
#pragma unroll
            for (int b = 0; b < 2; ++b)
#pragma unroll
                for (int m = 0; m < 4; ++m)
#pragma unroll
                    for (int n = 0; n < 2; ++n) acc[a][b][m][n] = (f32x4){0.f, 0.f, 0.f, 0.f};
        cur = nxt; cA = nA; cB = nB; ++ui;
    }
    PG8_WAIT_V(0);
    if (wr == 0) PG8_BAR;
    PG8_BAR;
    if constexpr (Epi::AFTER_DRAIN) { E.fused(acc, cur, wr, wc, fr, fq, lds, wid, lane); S.done(cur); }
    PG8_STAMP();
    if (STAMP && wid == 0) { stamps[lane] = lane < nts ? (((unsigned long long)(unsigned)ts_hi << 32) | (unsigned)ts_lo) : 0ull;
        if (lane == 62) stamps[62] = rt_entry; if (lane == 63) stamps[63] = (unsigned long long)wall_clock64(); }
#undef PG8_STAMP
#undef PG8_SA
#undef PG8_SB
#undef PG8_STAGE
#undef PG8_LDA
#undef PG8_LDB
#undef PG8_MMA
#undef PG8_WAIT_V
#undef PG8_WAIT_L
#undef PG8_BAR
#undef PG8_SCHED
}
}
DI f32x4 ld4(const float* p) { return *(const f32x4*)p; }
DI void st4(float* p, f32x4 v) { *(f32x4*)p = v; }
DI void st_bf4(bf16_t* p, f32x4 v) { u32x2 w; w[0] = pack_bf2(v[0], v[1]); w[1] = pack_bf2(v[2], v[3]); *(u32x2*)p = w; }

struct EpiIn {
    static constexpr bool PERM = false, AFTER_DRAIN = false;
    bf16_t *q_bf, *kvs_bf, *kvw_bf, *u_bf; float *out, *gates; const float *g_qnorm, *g_knorm;
    DI void operator()(const f32x4 (&acc)[2][2][4][2], const pg8::Unit& u, int wr, int wc, int fr, int fq) const {
        const int pn = u.pn; const bool isS = u.pm >= 64;
#pragma unroll
        for (int ai = 0; ai < 2; ++ai)
#pragma unroll
            for (int m = 0; m < 4; ++m) {
                const int row = u.pm * 256 + ai * 128 + wr * 64 + m * 16 + fr;
                f32x4 v[2][2];
#pragma unroll
                for (int bj = 0; bj < 2; ++bj)
#pragma unroll
                    for (int n = 0; n < 2; ++n) v[bj][n] = acc[ai][bj][m][n];
                float ss = 0.f;
#pragma unroll
                for (int bj = 0; bj < 2; ++bj)
#pragma unroll
                    for (int n = 0; n < 2; ++n)
#pragma unroll
                        for (int i = 0; i < 4; ++i) ss += v[bj][n][i] * v[bj][n][i];
                ss += __shfl_xor(ss, 16); ss += __shfl_xor(ss, 32);
                const float rstd = __builtin_amdgcn_rsqf(ss * (1.0f / 64.0f) + 1e-6f);
                int sb, st;
                if (isS) { const int sr = row - NP; sb = sr >> 3; st = sr & 7; } else { sb = row >> 11; st = row & 2047; }
                if (pn < 4) {
                    const int head = pn * 4 + wc;
#pragma unroll
                    for (int bj = 0; bj < 2; ++bj)
#pragma unroll
                        for (int n = 0; n < 2; ++n) { const int e0 = 32 * bj + 16 * n + 4 * fq;
                            st_bf4(q_bf + (size_t)row * 1024 + head * 64 + e0, v[bj][n] * (rstd * (0.125f * LOG2E)) * ld4(g_qnorm + e0)); }
                } else if (pn < 10) {
                    const int sec = (pn - 4) >> 1, c = (pn - 4) & 1, g = wc; const bool nrm = (c == 0) && (sec > 0);
#pragma unroll
                    for (int bj = 0; bj < 2; ++bj)
#pragma unroll
                        for (int n = 0; n < 2; ++n) { const int e0 = 32 * bj + 16 * n + 4 * fq; const int cg = c * 256 + g * 64 + e0;
                            f32x4 y = v[bj][n];
                            if (nrm) y = y * rstd * ld4(g_knorm + sec * 64 + e0);
                            if (sec == 0) { st4(out + (isS ? O_CMP_S + (size_t)(row - NP) * 512 : O_CMP_P + (size_t)row * 512) + cg, y); }
                            else if (sec == 1) { st4(out + (isS ? O_SLC_S + (size_t)(row - NP) * 512 : O_SLC_P + (size_t)row * 512) + cg, y);
                                if (!isS) st_bf4(kvs_bf + (size_t)row * 512 + cg, y); }
                            else { if (isS) st4(out + O_WIN_S + ((size_t)sb * 512 + 504 + st) * 512 + cg, y);
                                else { st_bf4(kvw_bf + (size_t)row * 512 + cg, y); if (st >= 1536) st4(out + O_WIN_P + ((size_t)sb * 512 + st - 1536) * 512 + cg, y); } }
                        }
                } else if (pn == 10) {
                    if (wc == 0) {
#pragma unroll
                        for (int bj = 0; bj < 2; ++bj)
#pragma unroll
                            for (int n = 0; n < 2; ++n) { const int e0 = 32 * bj + 16 * n + 4 * fq;
                                if (e0 < 48) { f32x4 y; for (int i = 0; i < 4; ++i) y[i] = fast_rcp(1.0f + fast_exp2(-LOG2E * v[bj][n][i])); st4(gates + (size_t)row * 48 + e0, y); } }
                    }
                } else {
#pragma unroll
                    for (int bj = 0; bj < 2; ++bj)
#pragma unroll
                        for (int n = 0; n < 2; ++n) { const int col = (pn - 11) * 256 + 64 * wc + 32 * bj + 16 * n + 4 * fq;
                            st_bf4(u_bf + (size_t)row * 1024 + col, v[bj][n]);
                            if (isS) st4(out + O_POOL_S + ((size_t)sb * 15 + 7 + st) * 1024 + col, v[bj][n]);
                            else if (st >= 2033) st4(out + O_POOL_P + ((size_t)sb * 15 + st - 2033) * 1024 + col, v[bj][n]); }
                }
            }
    }
};

struct EpiOut {
    static constexpr bool PERM = false, AFTER_DRAIN = false;
    const float *x_prompt, *x_sample, *mod; bf16_t* x1;
    DI void operator()(const f32x4 (&acc)[2][2][4][2], const pg8::Unit& u, int wr, int wc, int fr, int fq) const {
        const int col0 = u.pn * 256 + wc * 32 + 4 * fq;
#pragma unroll
        for (int ai = 0; ai < 2; ++ai)
#pragma unroll
            for (int m = 0; m < 4; ++m) {
                const int row = u.pm * 256 + ai * 128 + wr * 64 + m * 16 + fr;
                const float* xr = row < NP ? x_prompt + (size_t)row * DM : x_sample + (size_t)(row - NP) * DM;
                const int mrow = row < NP ? (row >> 11) : 8 + ((row - NP) >> 3);
                const float* gate = mod + (size_t)mrow * 12288 + 2 * DM;
#pragma unroll
                for (int bj = 0; bj < 2; ++bj)
#pragma unroll
                    for (int n = 0; n < 2; ++n) { const int col = col0 + bj * 128 + n * 16;
                        st_bf4(x1 + (size_t)row * DM + col, ld4(xr + col) + ld4(gate + col) * acc[ai][bj][m][n]); }
            }
    }
};

struct EpiPq {
    static constexpr bool PERM = false, AFTER_DRAIN = false;
    bf16_t* pq;
    DI void operator()(const f32x4 (&acc)[2][2][4][2], const pg8::Unit& u, int wr, int wc, int fr, int fq) const {
        const int col0 = u.pn * 256 + wc * 32 + 4 * fq;
#pragma unroll
        for (int ai = 0; ai < 2; ++ai)
#pragma unroll
            for (int m = 0; m < 4; ++m) {
                const int row = u.pm * 256 + ai * 128 + wr * 64 + m * 16 + fr;
#pragma unroll
                for (int bj = 0; bj < 2; ++bj)
#pragma unroll
                    for (int n = 0; n < 2; ++n) st_bf4(pq + (size_t)row * DM + col0 + bj * 128 + n * 16, acc[ai][bj][m][n]);
            }
    }
};

struct EpiNull {
    static constexpr bool PERM = false, AFTER_DRAIN = false;
    float* sink;
    DI void operator()(const f32x4 (&acc)[2][2][4][2], const pg8::Unit& u, int wr, int wc, int fr, int fq) const {
        float s = 0.f;
#pragma unroll
        for (int ai = 0; ai < 2; ++ai) for (int bj = 0; bj < 2; ++bj) for (int m = 0; m < 4; ++m) for (int n = 0; n < 2; ++n) s += acc[ai][bj][m][n][0] + acc[ai][bj][m][n][3];
        if (s == 12345.678f) sink[threadIdx.x] = s;
    }
};
DI int win_logical(int p) {
    const int pn = p >> 8, pp = p & 255, bj = pp >> 7, wc = (pp >> 5) & 3, r = pp & 31;
    const int lu = 64 * wc + 32 * bj + r;
    if (pn < 10) return 256 * pn + lu;
    if (pn == 10) return lu < 48 ? 2560 + lu : -1;
    return 2608 + 256 * (pn - 11) + lu;
}
template <int KT>
DI void transpose_tile(const float* src, int ldsrc, int k0, int c0, int nvalid, bf16_t* dst, int lddst, int p0, LAS unsigned char* lds) {
    const int tid = threadIdx.x;
    constexpr int TS = 128 * KT + 8;
    LAS bf16_t* T = (LAS bf16_t*)lds;
    f32x4 v[2 * KT];
    const int c4 = (tid & 7) * 4;
#pragma unroll
    for (int i = 0; i < 2 * KT; ++i) {
        const int kk = (tid >> 3) + 64 * i;
        v[i] = (f32x4){0.f, 0.f, 0.f, 0.f};
        if (c0 >= 0 && c4 < nvalid) v[i] = ld4(src + (size_t)(k0 + kk) * ldsrc + c0 + c4);
    }
#pragma unroll
    for (int i = 0; i < 2 * KT; ++i) {
        const int kk = (tid >> 3) + 64 * i;
#pragma unroll
        for (int j = 0; j < 4; ++j) T[(c4 + j) * TS + kk] = (bf16_t)(pack_bf2(v[i][j], 0.f) & 0xffffu);
    }
    __syncthreads();
#pragma unroll
    for (int i = 0; i < KT; ++i) { const int ch = tid + 512 * i, col = ch / (16 * KT), kc = ch % (16 * KT);
      const u32x4 w = *(const LAS u32x4*)(T + col * TS + kc * 8);
      *(u32x4*)(dst + (size_t)(p0 + col) * lddst + k0 + kc * 8) = w; }
    __syncthreads();
}

DI void adaln_item(const Params& p, int slice, LAS unsigned char* lds) {
    const int tid = threadIdx.x, wid = tid >> 6, lane = tid & 63, l31 = lane & 31, hh = lane >> 5, n0 = slice * 96;
    constexpr int RS = 136, ABYTES = 160 * RS * 2, WBYTES = 96 * RS * 2, BUF = ABYTES + WBYTES;
    for (int i = tid; i < 2 * BUF / 16; i += 512) *(LAS u32x4*)(lds + i * 16) = (u32x4){0u, 0u, 0u, 0u};
    const int msub = tid >> 5, k4 = (tid & 31) * 4;
    const float* a0 = (msub < 8 ? p.c_prompt + (size_t)msub * DM : p.c_sample + (size_t)(msub - 8) * DM) + k4;
    const float* aS = p.c_sample + ((long)msub - 8) * DM + k4;
    const float* w0 = p.w_ada + n0;
    f32x4 ra[9], rw0[6], rw1[6];
#define ADA_ISSUE_A(KT) { ra[0] = ld4(a0 + (KT) * 128); _Pragma("unroll") for (int j = 1; j < 9; ++j) { ra[j] = (f32x4){0.f, 0.f, 0.f, 0.f}; if (j < 8 || msub < 8) ra[j] = ld4(aS + (size_t)j * 16 * DM + (KT) * 128); } }
#define ADA_ISSUE_W(RW, KT) { _Pragma("unroll") for (int j = 0; j < 3; ++j) { const int idx_ = tid + 512 * j, kp_ = idx_ / 24, c4_ = (idx_ % 24) * 4; \
        const float* wp_ = w0 + ((size_t)(KT) * 128 + 2 * kp_) * 12288 + c4_; RW[2 * j] = ld4(wp_); RW[2 * j + 1] = ld4(wp_ + 12288); } }
#define ADA_STASH(RW, BUFI) { LAS bf16_t* A_ = (LAS bf16_t*)(lds + (BUFI) * BUF); LAS bf16_t* W_ = (LAS bf16_t*)(lds + (BUFI) * BUF + ABYTES); \
        _Pragma("unroll") for (int j = 0; j < 9; ++j) { if (j < 8 || msub < 8) { f32x4 v = ra[j]; for (int i = 0; i < 4; ++i) v[i] = v[i] * fast_rcp(1.0f + fast_exp2(-LOG2E * v[i])); \
            u32x2 w_; w_[0] = pack_bf2(v[0], v[1]); w_[1] = pack_bf2(v[2], v[3]); *(LAS u32x2*)(A_ + (msub + 16 * j) * RS + k4) = w_; } } \
        _Pragma("unroll") for (int j = 0; j < 3; ++j) { const int idx_ = tid + 512 * j, kp_ = idx_ / 24, c4_ = (idx_ % 24) * 4; \
            _Pragma("unroll") for (int i = 0; i < 4; ++i) *(LAS unsigned*)(W_ + (c4_ + i) * RS + 2 * kp_) = pack_bf2(RW[2 * j][i], RW[2 * j + 1][i]); } }
    f32x16 acc[2]; acc[0] = zero16(); acc[1] = zero16();
    const int t0 = wid, t1 = wid + 8;
    ADA_ISSUE_A(0) ADA_ISSUE_W(rw0, 0) ADA_ISSUE_W(rw1, 1)
    __syncthreads();
#define ADA_COMPUTE(BUFI) { LAS const bf16_t* A = (LAS const bf16_t*)(lds + (BUFI) * BUF); LAS const bf16_t* W = (LAS const bf16_t*)(lds + (BUFI) * BUF + ABYTES); \
        _Pragma("unroll") for (int ks = 0; ks < 8; ++ks) { \
            { const bf16x8 a = *(LAS const bf16x8*)(A + ((t0 % 5) * 32 + l31) * RS + 16 * ks + 8 * hh); const bf16x8 w = *(LAS const bf16x8*)(W + ((t0 / 5) * 32 + l31) * RS + 16 * ks + 8 * hh); acc[0] = MFMA32(a, w, acc[0]); } \
            if (t1 < 15) { const bf16x8 a = *(LAS const bf16x8*)(A + ((t1 % 5) * 32 + l31) * RS + 16 * ks + 8 * hh); const bf16x8 w = *(LAS const bf16x8*)(W + ((t1 / 5) * 32 + l31) * RS + 16 * ks + 8 * hh); acc[1] = MFMA32(a, w, acc[1]); } } }
#pragma unroll 1
    for (int kt = 0; kt < 16; kt += 2) {
        ADA_STASH(rw0, 0)
        __syncthreads();
        ADA_ISSUE_A(kt + 1)
        if (kt + 2 < 16) ADA_ISSUE_W(rw0, kt + 2)
        ADA_COMPUTE(0)
        ADA_STASH(rw1, 1)
        __syncthreads();
        if (kt + 2 < 16) ADA_ISSUE_A(kt + 2)
        if (kt + 3 < 16) ADA_ISSUE_W(rw1, kt + 3)
        ADA_COMPUTE(1)
    }
#undef ADA_COMPUTE
#undef ADA_ISSUE_A
#undef ADA_ISSUE_W
#undef ADA_STASH
    float* mod = (float*)(p.ws + WS_MOD);
    int hh_ = hh, l31_ = l31; asm volatile("" : "+v"(hh_), "+v"(l31_));
#pragma unroll
    for (int q = 0; q < 2; ++q) { const int t = q ? t1 : t0; if (t < 15) { const int n = (t / 5) * 32 + l31_;
        if (n < 96) { const float bias = p.b_ada[n0 + n];
#pragma unroll
            for (int i = 0; i < 16; ++i) { const int m = (t % 5) * 32 + crow(i, hh_); if (m < 136) mod[(size_t)m * 12288 + n0 + n] = acc[q][i] + bias; } } } }
    __syncthreads();
}

DI void phase_A(const Params& p, LAS unsigned char* lds) {
    bf16_t* win_t = (bf16_t*)(p.ws + WS_WIN_T); bf16_t* wout_t = (bf16_t*)(p.ws + WS_WOUT_T); bf16_t* wq_t = (bf16_t*)(p.ws + WS_WQ_T);
    bf16_t* wcmp_t = (bf16_t*)(p.ws + WS_WCMP_T); bf16_t* wpool_t = (bf16_t*)(p.ws + WS_WPOOL_T);
    constexpr int T_ADA = 128, T_IN = 4 * 120, T_OUT = 4 * 64, T_Q = 0  , T_POOL = 4 * 8, T_CMP = 8 * 2 * 2 * 2, T_MISC = 8 + 112;
    constexpr int E0 = T_IN, E1 = E0 + T_OUT, E2 = E1 + T_Q, E3 = E2, E4 = E3 + T_POOL, E5 = E4 + T_CMP, E6 = E5 + T_MISC;
    const int tid = threadIdx.x;
    const int gh = (int)gridDim.x >> 1;
    if ((int)blockIdx.x < gh) {
#pragma unroll 1
        for (int sl = blockIdx.x; sl < T_ADA; sl += gh) adaln_item(p, sl, lds);
        return;
    }
#pragma unroll 1
    for (int it = (int)blockIdx.x - gh; it < E6; it += (int)gridDim.x - gh) {
        if (it < E0) { const int kt = it & 3, pt = it >> 2; const int p0 = pt * 32; const int c0 = win_logical(p0);
            int nv = 32; if (c0 >= 0 && win_logical(p0 + 31) < 0) nv = 16;
            transpose_tile<4>(p.w_in, 3632, kt * 512, c0, nv, win_t, DM, p0, lds); }
        else if (it < E1) { const int j = it - E0, kt = j & 3, pt = j >> 2; transpose_tile<4>(p.w_out, DM, kt * 512, pt * 32, 32, wout_t, DM, pt * 32, lds); }
        else if (it < E2) { const int j = it - E1, kt = j & 3, pt = j >> 2; transpose_tile<4>(p.peer_wq, DM, kt * 512, pt * 32, 32, wq_t, DM, pt * 32, lds); }
        else if (it < E4) { const int j = it - E3, gi = j >> 3, pt = j & 7;
            transpose_tile<2>(p.w_pool + (size_t)gi * 65536, 256, 0, pt * 32, 32, wpool_t + (size_t)gi * 65536, 256, pt * 32, lds); }
        else if (it < E5) { const int j = it - E4, cg = j >> 3, lohi = (j >> 2) & 1, kt = (j >> 1) & 1, pt = j & 1;
            transpose_tile<4>(p.w_cmp + ((size_t)cg * 32 + lohi * 16) * 4096, 64, kt * 512, pt * 32, 32, wcmp_t + (size_t)cg * 131072, 1024, lohi * 64 + pt * 32, lds); }
        else {
            const int j = it - E5;
            if (j < 8) {
                const int cg = j, e = tid & 63, part = tid >> 6, c = cg >> 2, g = cg & 3; float s = 0.f;
                for (int l = 4 * part; l < 4 * part + 4; ++l)
#pragma unroll 8
                    for (int d = 0; d < 64; ++d) s += p.cmp_pe[((c * 32 + l) * 4 + g) * 64 + d] * p.w_cmp[(((size_t)cg * 32 + l) * 64 + d) * 64 + e];
                LAS float* red = (LAS float*)lds; red[tid] = s;
                __syncthreads();
                if (tid < 64) { float t = 0.f; for (int q = 0; q < 8; ++q) t += red[q * 64 + tid]; ((float*)(p.ws + WS_PEBIAS))[cg * 64 + tid] = t; }
                __syncthreads();
            } else {
                const int q = j - 8;
                for (int i = 0; i < 4; ++i) { const size_t f = (size_t)q * 8192 + (size_t)(i * 512 + tid) * 4; const size_t b = f / 7168, rem = f % 7168;
                    st4(p.out + O_POOL_S + b * 15360 + rem, ld4(p.state_pool + b * 15360 + 8 * 1024 + rem)); }
            }
        }
    }
}

DI void transpose_wq(const Params& p, int first_blk, LAS unsigned char* lds) {
    bf16_t* wq_t = (bf16_t*)(p.ws + WS_WQ_T);
#pragma unroll 1
    for (int j = (int)blockIdx.x - first_blk; j < 4 * 64; j += (int)gridDim.x - first_blk) { const int kt = j & 3, pt = j >> 2; transpose_tile<4>(p.peer_wq, DM, kt * 512, pt * 32, 32, wq_t, DM, pt * 32, lds); }
}

DI void phase_B_stream(const Params& p, int first_blk, int part, LAS unsigned char* lds) {
    const int tid = threadIdx.x, wid = tid >> 6, lane = tid & 63;
    const int nw = (gridDim.x - first_blk) * 8, wi = (blockIdx.x - first_blk) * 8 + wid;
    constexpr int C_U = 16384, C_V = 16384, C_SK = 128, C_WIN = 128 * 126, C_END = C_U + C_V + C_SK + C_WIN;
    unsigned char* u4 = p.ws + WS_U; unsigned char* v4 = p.ws + WS_V; bf16_t* sk = (bf16_t*)(p.ws + WS_SUBK);
    unsigned char* su = p.ws + WS_USCALE; unsigned char* sv = p.ws + WS_VSCALE;
    LAS f32x4* T = (LAS f32x4*)(lds + wid * 8192);
    const int nitems = part == 0 ? C_U + C_SK + C_WIN / 2 : C_V + C_WIN / 2;
    for (int it = wi; it < nitems; it += nw) {
        int c;
        if (part == 0) c = it < C_U ? it : (it < C_U + C_SK ? C_U + C_V + (it - C_U) : C_U + C_V + C_SK + (it - C_U - C_SK));
        else c = it < C_V ? C_U + it : C_U + C_V + C_SK + C_WIN / 2 + (it - C_V);
        if (c < C_U + C_V) {
            const bool isV = c >= C_U; const int r = isV ? c - C_U : c;
            const float* src = (isV ? p.peer_v : p.peer_u) + (size_t)r * 2048;
            f32x4 v[8];
#pragma unroll
            for (int j = 0; j < 8; ++j) v[j] = __builtin_nontemporal_load((const f32x4*)(src + j * 256 + lane * 4));
#pragma unroll
            for (int j = 0; j < 8; ++j) T[j * 64 + lane] = v[j];
            asm volatile("s_waitcnt lgkmcnt(0)" ::: "memory");
#pragma unroll
            for (int q = 0; q < 8; ++q) v[q] = T[8 * lane + q];
            asm volatile("s_waitcnt lgkmcnt(0)" ::: "memory");
            float am = 0.f, ss = 0.f;
#pragma unroll
            for (int j = 0; j < 8; ++j) for (int i = 0; i < 4; ++i) { am = fmaxf(am, fabsf(v[j][i])); ss += v[j][i] * v[j][i]; }
#pragma unroll
            for (int o = 32; o >= 1; o >>= 1) { am = fmaxf(am, __shfl_xor(am, o)); ss += __shfl_xor(ss, o); }
            const float scale = fmaxf(fmaxf(0.5f * __builtin_sqrtf(ss * (1.0f / 2048.0f)), am * 0.125f), 1.0e-30f), inv = 1.0f / scale;
#pragma unroll
            for (int j = 0; j < 8; ++j) for (int i = 0; i < 4; ++i) v[j][i] = fminf(fmaxf(v[j][i] * inv, -6.0f), 6.0f);
            u32x4 w;
#pragma unroll
            for (int j = 0; j < 4; ++j) { unsigned d = 0u; const f32x4 a = v[2 * j], c2 = v[2 * j + 1];
                d = __builtin_amdgcn_cvt_scalef32_pk_fp4_f32(d, a[0], a[1], 1.0f, 0); d = __builtin_amdgcn_cvt_scalef32_pk_fp4_f32(d, a[2], a[3], 1.0f, 1);
                d = __builtin_amdgcn_cvt_scalef32_pk_fp4_f32(d, c2[0], c2[1], 1.0f, 2); d = __builtin_amdgcn_cvt_scalef32_pk_fp4_f32(d, c2[2], c2[3], 1.0f, 3);
                w[j] = d; }
            *(u32x4*)((isV ? v4 : u4) + (size_t)r * 1024 + lane * 16) = w;
            if (lane == 0) ((float*)(isV ? sv : su))[r] = scale;
        } else if (c < C_U + C_V + C_SK) { const int r = c - C_U - C_V;
#pragma unroll
            for (int j = 0; j < 8; ++j) st_bf4(sk + (size_t)r * 2048 + j * 256 + lane * 4, ld4(p.peer_subkeys + (size_t)r * 2048 + j * 256 + lane * 4));
        } else { const int r = c - C_U - C_V - C_SK, b = r / 126, q = r % 126;
            const float* src = p.cache_win + (size_t)b * 262144 + 4096 + (size_t)q * 2048; float* dst = p.out + O_WIN_S + (size_t)b * 262144 + (size_t)q * 2048;
            f32x4 v[8];
#pragma unroll
            for (int j = 0; j < 8; ++j) v[j] = __builtin_nontemporal_load((const f32x4*)(src + j * 256 + lane * 4));
#pragma unroll
            for (int j = 0; j < 8; ++j) __builtin_nontemporal_store(v[j], (f32x4*)(dst + j * 256 + lane * 4)); }
    }
}

DI void phase_modulate(const Params& p, int which) {
    const int tid = threadIdx.x, wid = tid >> 6, lane = tid & 63;
    const float* mod = (const float*)(p.ws + WS_MOD); bf16_t* h = (bf16_t*)(p.ws + WS_H);
    const float* gn = which ? p.g_norm2 : p.g_norm1;
    for (int row = wid * gridDim.x + blockIdx.x; row < NTOK; row += gridDim.x * 8) {
        const float* src = row < NP ? p.x_prompt + (size_t)row * DM : p.x_sample + (size_t)(row - NP) * DM;
        const bf16_t* srcb = (const bf16_t*)(p.ws + WS_X1) + (size_t)row * DM;
        const int mrow = row < NP ? (row >> 11) : 8 + ((row - NP) >> 3);
        const float* shift = mod + (size_t)mrow * 12288 + (which ? 3 : 0) * DM; const float* scale = shift + DM;
        f32x4 v[8]; float ss = 0.f;
        if (which) {
#pragma unroll
            for (int j = 0; j < 4; ++j) { const u32x4 q = __builtin_nontemporal_load((const u32x4*)(srcb + j * 512 + lane * 8));
                v[2 * j] = (f32x4){bf_lo(q[0]), bf_hi(q[0]), bf_lo(q[1]), bf_hi(q[1])}; v[2 * j + 1] = (f32x4){bf_lo(q[2]), bf_hi(q[2]), bf_lo(q[3]), bf_hi(q[3])}; } }
        else {
#pragma unroll
            for (int j = 0; j < 4; ++j) { v[2 * j] = __builtin_nontemporal_load((const f32x4*)(src + j * 512 + lane * 8)); v[2 * j + 1] = __builtin_nontemporal_load((const f32x4*)(src + j * 512 + lane * 8 + 4)); } }
#pragma unroll
        for (int j = 0; j < 8; ++j) for (int i = 0; i < 4; ++i) ss += v[j][i] * v[j][i];
#pragma unroll
        for (int o = 32; o >= 1; o >>= 1) ss += __shfl_xor(ss, o);
        const float rstd = __builtin_amdgcn_rsqf(ss * (1.0f / 2048.0f) + 1e-6f);
#pragma unroll
        for (int j = 0; j < 4; ++j) {
            const int c = j * 512 + lane * 8;
            f32x4 a = v[2 * j] * rstd * ld4(gn + c) * (ld4(scale + c) + 1.0f) + ld4(shift + c);
            f32x4 b = v[2 * j + 1] * rstd * ld4(gn + c + 4) * (ld4(scale + c + 4) + 1.0f) + ld4(shift + c + 4);
            u32x4 w; w[0] = pack_bf2(a[0], a[1]); w[1] = pack_bf2(a[2], a[3]); w[2] = pack_bf2(b[0], b[1]); w[3] = pack_bf2(b[2], b[3]);
            *(u32x4*)(h + (size_t)row * DM + c) = w;
        }
    }
}
DI void cmp_unit(const Params& p, int unit, LAS unsigned char* lds) {
    const int tid = threadIdx.x, wid = tid >> 6, lane = tid & 63, l31 = lane & 31, hh = lane >> 5;
    const bool isP = unit >= 2048;
    const int u = isP ? unit - 2048 : unit, b = u >> 4, mh = (u >> 3) & 1, cg = u & 7;
    constexpr int RS = 136;
    constexpr int ABYTES = 64 * RS * 2, WBYTES = 128 * RS * 2, BUF = ABYTES + WBYTES;
    const int d4 = tid & 15, lsl = (tid >> 4) & 1, ch0 = tid >> 5;
    const float* abase[4];
#pragma unroll
    for (int j = 0; j < 4; ++j) {
        const int ch = ch0 + 16 * j, chg = mh * 64 + ch;
        if (isP) abase[j] = p.out + O_CMP_P + ((size_t)b * 2048 + chg * 16 + lsl) * 512 + cg * 64 + d4 * 4;
        else { const int page = p.page_table[b * 16 + (chg >> 3)]; abase[j] = p.cache_cmp + ((size_t)page * 128 + (chg & 7) * 16 + lsl) * 512 + cg * 64 + d4 * 4; }
    }
    const bf16_t* wbase = (const bf16_t*)(p.ws + WS_WCMP_T) + ((size_t)cg * 128 + (tid >> 4)) * 1024 + (tid & 15) * 8;
    f32x4 ra0[4], ra1[4]; u32x4 rw0[4], rw1[4];
#define CMP_ISSUE(RA, RW, S) { _Pragma("unroll") for (int j = 0; j < 4; ++j) { RA[j] = __builtin_nontemporal_load((const f32x4*)(abase[j] + (size_t)(S) * 1024)); RW[j] = *(const u32x4*)(wbase + (size_t)j * 32 * 1024 + (S) * 128); } }
#define CMP_STASH(RA, RW, BUFI) { LAS unsigned char* A_ = lds + (BUFI) * BUF; LAS unsigned char* W_ = A_ + ABYTES; _Pragma("unroll") for (int j = 0; j < 4; ++j) { \
            u32x2 w_; w_[0] = pack_bf2(RA[j][0], RA[j][1]); w_[1] = pack_bf2(RA[j][2], RA[j][3]); \
            *(LAS u32x2*)(A_ + ((ch0 + 16 * j) * RS + lsl * 64 + d4 * 4) * 2) = w_; \
            *(LAS u32x4*)(W_ + (((tid >> 4) + 32 * j) * RS + (tid & 15) * 8) * 2) = RW[j]; } }
    const int mt = wid >> 2, nt = wid & 3;
    f32x16 acc = zero16();
    CMP_ISSUE(ra0, rw0, 0) CMP_ISSUE(ra1, rw1, 1)
#pragma unroll
    for (int s = 0; s < 8; ++s) {
        if (s & 1) CMP_STASH(ra1, rw1, 1) else CMP_STASH(ra0, rw0, 0)
        __syncthreads();
        if (s + 2 < 8) { if (s & 1) CMP_ISSUE(ra1, rw1, s + 2) else CMP_ISSUE(ra0, rw0, s + 2) }
        __builtin_amdgcn_sched_barrier(0);
        LAS const unsigned char* A = lds + (s & 1) * BUF; LAS const unsigned char* W = A + ABYTES;
        LAS const unsigned char* ar = A + ((mt * 32 + l31) * RS + 8 * hh) * 2; LAS const unsigned char* wr = W + ((nt * 32 + l31) * RS + 8 * hh) * 2;
#pragma unroll
        for (int ks = 0; ks < 8; ++ks) { const bf16x8 a = *(LAS const bf16x8*)(ar + ks * 32); const bf16x8 w = *(LAS const bf16x8*)(wr + ks * 32); acc = MFMA32(a, w, acc); }
        __builtin_amdgcn_sched_barrier(0);
    }
#undef CMP_ISSUE
#undef CMP_STASH
    bf16_t* part = (bf16_t*)(p.ws + (isP ? WS_PART_P : WS_PART_S));
#pragma unroll
    for (int i = 0; i < 16; ++i) {
        const int chg = mh * 64 + mt * 32 + crow(i, hh);
        const float nb = __shfl_xor(acc[i], 1);
        if (!(lane & 1)) *(unsigned*)(part + (((size_t)b * 128 + chg) * 8 + cg) * 128 + nt * 32 + l31) = pack_bf2(acc[i], nb);
    }
    __syncthreads();
}

DI void pool_unit(const Params& p, int unit, LAS unsigned char* lds) {
    const int tid = threadIdx.x, wid = tid >> 6, lane = tid & 63;
    const int tile = unit >> 2, gi = unit & 3, w = 2 << gi;
    const int row0 = tile * 128; const bool isS = row0 >= NP;
    const bf16_t* ubf = (const bf16_t*)(p.ws + WS_UBF);
    constexpr int AST = 264;
    LAS bf16_t* A = (LAS bf16_t*)lds;
    LAS bf16_t* E = (LAS bf16_t*)(lds + 128 * AST * 2);
    const bf16_t* wg = (const bf16_t*)(p.ws + WS_WPOOL_T) + (size_t)gi * 65536;
    u32x4 wr[8], wr1[8];
#define POOL_ISSUE_W { _Pragma("unroll") for (int j = 0; j < 8; ++j) { const int ch = tid + 512 * j, n = ch >> 4, k8 = (ch & 15) * 8; wr[j] = *(const u32x4*)(wg + (size_t)n * 256 + k8); wr1[j] = *(const u32x4*)(wg + (size_t)n * 256 + 128 + k8); } }
    if (!isS) {
        const int t0 = row0 & 2047;
        u32x4 q[9];
#pragma unroll
        for (int i = 0; i < 9; ++i) { const int idx = tid + 512 * i, r = idx >> 5, c8 = (idx & 31) * 8;
            q[i] = (u32x4){0u, 0u, 0u, 0u};
            if (idx < 143 * 32 && t0 - 15 + r >= 0) q[i] = *(const u32x4*)(ubf + (size_t)(row0 - 15 + r) * 1024 + gi * 256 + c8); }
        asm volatile("" ::: "memory");
        POOL_ISSUE_W
#pragma unroll
        for (int i = 0; i < 9; ++i) { const int idx = tid + 512 * i, r = idx >> 5, c8 = (idx & 31) * 8;
            if (idx < 143 * 32) *(LAS u32x4*)(E + r * AST + c8) = q[i]; }
        __syncthreads();
#pragma unroll 1
        for (int it = tid; it < 128 * 32; it += 512) {
            const int r = it >> 5, c8 = (it & 31) * 8, t = t0 + r;
            float sum[8]; for (int i = 0; i < 8; ++i) sum[i] = 0.f;
#pragma unroll 4
            for (int j = 0; j < w; ++j) { const u32x4 q = *(LAS const u32x4*)(E + (r + 15 - j) * AST + c8);
                for (int i = 0; i < 4; ++i) { sum[2 * i] += bf_lo(q[i]); sum[2 * i + 1] += bf_hi(q[i]); } }
            const u32x4 qs = *(LAS const u32x4*)(E + (r + 15) * AST + c8);
            const float inv = 1.0f / (float)(t + 1 < w ? t + 1 : w);
            u32x4 o;
            for (int i = 0; i < 4; ++i) o[i] = pack_bf2(sum[2 * i] * inv - bf_lo(qs[i]), sum[2 * i + 1] * inv - bf_hi(qs[i]));
            *(LAS u32x4*)(A + r * AST + c8) = o;
        }
    } else {
        POOL_ISSUE_W
#pragma unroll 1
        for (int it = tid; it < 128 * 32; it += 512) {
            const int r = it >> 5, c8 = (it & 31) * 8, row = row0 + r, col = gi * 256 + c8;
            const int bb = (row - NP) >> 3, t = (row - NP) & 7;
            float sum[8], self[8]; for (int i = 0; i < 8; ++i) { sum[i] = 0.f; self[i] = 0.f; }
#pragma unroll 4
            for (int j = 0; j < w; ++j) {
                const int tt = t - j; float x[8];
                if (tt >= 0) { const u32x4 q = *(const u32x4*)(ubf + (size_t)(row - j) * 1024 + col);
                    for (int i = 0; i < 4; ++i) { x[2 * i] = bf_lo(q[i]); x[2 * i + 1] = bf_hi(q[i]); } }
                else { const float* sp = p.state_pool + ((size_t)bb * 15 + 15 + tt) * 1024 + col; const f32x4 a = ld4(sp), c = ld4(sp + 4);
                    for (int i = 0; i < 4; ++i) { x[i] = a[i]; x[4 + i] = c[i]; } }
                for (int i = 0; i < 8; ++i) sum[i] += x[i];
                if (j == 0) for (int i = 0; i < 8; ++i) self[i] = x[i];
            }
            const float inv = 1.0f / (float)w;
            u32x4 o;
            for (int i = 0; i < 4; ++i) o[i] = pack_bf2(sum[2 * i] * inv - self[2 * i], sum[2 * i + 1] * inv - self[2 * i + 1]);
            *(LAS u32x4*)(A + r * AST + c8) = o;
        }
    }
#undef POOL_ISSUE_W
    __syncthreads();
    const int wm = wid >> 1, wn = wid & 1, l31 = lane & 31, hh = lane >> 5;
    LAS bf16_t* WL = (LAS bf16_t*)(lds + 128 * AST * 2);
    LAS const bf16_t* arow = A + (wm * 32 + l31) * AST + 8 * hh;
    f32x16 acc[4]; for (int i = 0; i < 4; ++i) acc[i] = zero16();
#pragma unroll
    for (int half = 0; half < 2; ++half) {
        if (half) __syncthreads();
#pragma unroll
        for (int j = 0; j < 8; ++j) { const int ch = tid + 512 * j, n = ch >> 4, k8 = (ch & 15) * 8; *(LAS u32x4*)(WL + n * 136 + k8) = wr[j]; }
        __syncthreads();
        if (half == 0) {
#pragma unroll
            for (int j = 0; j < 8; ++j) wr[j] = wr1[j]; }
#pragma unroll
        for (int s = 0; s < 8; ++s) {
            const bf16x8 a = *(LAS const bf16x8*)(arow + (half * 8 + s) * 16);
#pragma unroll
            for (int nt = 0; nt < 4; ++nt) { const bf16x8 wv = *(LAS const bf16x8*)(WL + (wn * 128 + nt * 32 + l31) * 136 + s * 16 + 8 * hh); acc[nt] = MFMA32(wv, a, acc[nt]); }
        }
    }
    __syncthreads();
    LAS bf16_t* O = (LAS bf16_t*)lds;
#pragma unroll
    for (int nt = 0; nt < 4; ++nt)
#pragma unroll
        for (int gq = 0; gq < 4; ++gq) {
            const int nl = wn * 128 + nt * 32 + 8 * gq + 4 * hh;
            const f32x4 ps = ld4(p.pool_scale + gi * 256 + nl);
            u32x2 w; w[0] = pack_bf2(acc[nt][4 * gq] * ps[0], acc[nt][4 * gq + 1] * ps[1]); w[1] = pack_bf2(acc[nt][4 * gq + 2] * ps[2], acc[nt][4 * gq + 3] * ps[3]);
            *(LAS u32x2*)(O + (wm * 32 + l31) * AST + nl) = w;
        }
    __syncthreads();
    bf16_t* ocat = (bf16_t*)(p.ws + WS_OCAT);
#pragma unroll
    for (int j = 0; j < 8; ++j) { const int ch = tid + 512 * j, r = ch >> 5, c8 = (ch & 31) * 8;
        *(u32x4*)(ocat + (size_t)(row0 + r) * DM + 1024 + gi * 256 + c8) = *(LAS const u32x4*)(O + r * AST + c8); }
    __syncthreads();
}
struct AttnSt { float m, l; f32x16 o0, o1; };
DI void attn_init(AttnSt& s) { s.m = NEGBIG; s.l = 0.f; s.o0 = zero16(); s.o1 = zero16(); }
constexpr int KST = 72, VST = 68, CVST = 136;
constexpr int KVBUF = 64 * KST * 2 + 64 * VST * 2;

DI float xhalf_max(float v) { return fmaxf(v, __shfl_xor(v, 32)); }
DI float xhalf_sum(float v) { return v + __shfl_xor(v, 32); }

template <int MODE, bool FULL = false>
DI void attn_tile64(LAS const bf16_t* Kb, LAS const bf16_t* Vt, const bf16x8 (&qf)[4], int rel, float slope2, bool allow, int lane, AttnSt& st) {
    const int l31 = lane & 31, hh = lane >> 5;
    const int relh = rel - 4 * hh;
    float sl = slope2; asm volatile("" : "+v"(sl));
    const float base = allow ? -sl * (float)relh : NEGBIG;
    const f32x2 bA = {0.f, sl}, bB = {2.0f * sl, 3.0f * sl};
    f32x16 sacc[2];
#pragma unroll
    for (int kt = 0; kt < 2; ++kt) {
#pragma unroll
        for (int q4 = 0; q4 < 4; ++q4) {
            const float gb = __builtin_fmaf(sl, (float)(32 * kt + 8 * q4), base);
            const f32x2 g2 = {gb, gb}, lo2 = g2 + bA, hi2 = g2 + bB;
            sacc[kt][4 * q4] = lo2[0]; sacc[kt][4 * q4 + 1] = lo2[1]; sacc[kt][4 * q4 + 2] = hi2[0]; sacc[kt][4 * q4 + 3] = hi2[1];
        }
#pragma unroll
        for (int s = 0; s < 4; ++s) { const bf16x8 a = *(LAS const bf16x8*)(Kb + (32 * kt + l31) * KST + 16 * s + 8 * hh); sacc[kt] = MFMA32(a, qf[s], sacc[kt]); } }
    float mx = NEGBIG;
#pragma unroll
    for (int kt = 0; kt < 2; ++kt)
#pragma unroll
        for (int i = 0; i < 16; ++i) {
            if (!FULL) { const int ci = 32 * kt + (i & 3) + 8 * (i >> 2); bool valid = (ci <= relh); if (MODE == 1) valid = valid && (relh - ci <= 512); sacc[kt][i] = valid ? sacc[kt][i] : NEGBIG; }
            mx = fmaxf(mx, sacc[kt][i]);
        }
    mx = xhalf_max(mx);
    const float m_new = fmaxf(fmaxf(st.m, mx), -1.0e20f);
    const float alpha = fast_exp2(st.m - m_new);
    const f32x2 mneg = {-m_new, -m_new};
    f32x2 rs2 = {0.f, 0.f};
    if (!__all(alpha == 1.0f)) { st.o0 *= alpha; st.o1 *= alpha; }
#pragma unroll
    for (int kt = 0; kt < 2; ++kt) {
#pragma unroll
        for (int i = 0; i < 8; ++i) { f32x2 d = {sacc[kt][2 * i], sacc[kt][2 * i + 1]}; d += mneg; d[0] = fast_exp2(d[0]); d[1] = fast_exp2(d[1]);
            sacc[kt][2 * i] = d[0]; sacc[kt][2 * i + 1] = d[1]; rs2 += d; }
#pragma unroll
        for (int s2 = 0; s2 < 2; ++s2) {
            const bf16x8 pf = pack_step(sacc[kt], s2);
            const int kb = 32 * kt + 16 * s2 + 4 * hh;
#pragma unroll
            for (int dt = 0; dt < 2; ++dt) {
                LAS const bf16_t* vp = Vt + (32 * dt + l31) * VST + kb;
                const s16x4 lo = *(LAS const s16x4*)vp, hi = *(LAS const s16x4*)(vp + 8);
                const bf16x8 vf = __builtin_shufflevector(lo, hi, 0, 1, 2, 3, 4, 5, 6, 7);
                if (dt == 0) st.o0 = MFMA32(vf, pf, st.o0); else st.o1 = MFMA32(vf, pf, st.o1);
            }
        }
        if (kt == 0) __builtin_amdgcn_sched_barrier(0);
    }
    float rs = rs2[0] + rs2[1];
    rs = xhalf_sum(rs);
    st.l = st.l * alpha + rs; st.m = m_new;
}

DI void attn_cmp(LAS const bf16_t* Kc, LAS const bf16_t* Vct, const bf16x8 (&qf)[4], int t, float slope2, int ntile, int lane, f32x16& oc0, f32x16& oc1, float (&imp)[16]) {
    const int l31 = lane & 31, hh = lane >> 5;
    const float c1 = 1.0f;
    int nmax = (t - 31) >> 4; nmax = nmax > 126 ? 126 : nmax;
    const int nmaxh = nmax - 4 * hh;
    const float base = -slope2 * (float)(t - 31 - 64 * hh), s16 = slope2 * 16.0f;
    float mx = NEGBIG;
#pragma unroll
    for (int kt = 0; kt < 4; ++kt) {
        if (kt < ntile) {
            f32x16 sacc = zero16();
#pragma unroll
            for (int s = 0; s < 4; ++s) { const bf16x8 a = *(LAS const bf16x8*)(Kc + (32 * kt + l31) * KST + 16 * s + 8 * hh); sacc = MFMA32(a, qf[s], sacc); }
#pragma unroll
            for (int i = 0; i < 16; ++i) {
                const int ci = 32 * kt + (i & 3) + 8 * (i >> 2);
                const float sc = __builtin_fmaf(sacc[i], c1, __builtin_fmaf(s16, (float)ci, base));
                mx = fmaxf(mx, (ci <= nmaxh) ? sc : NEGBIG);
            }
        }
    }
    mx = fmaxf(xhalf_max(mx), -1.0e20f);
    float sum = 0.f, prevc = 0.f;
    oc0 = zero16(); oc1 = zero16();
#pragma unroll
    for (int j = 0; j < 16; ++j) imp[j] = 0.f;
#pragma unroll
    for (int kt = 0; kt < 4; ++kt) {
        if (kt < ntile) {
            f32x16 sacc = zero16();
#pragma unroll
            for (int s = 0; s < 4; ++s) { const bf16x8 a = *(LAS const bf16x8*)(Kc + (32 * kt + l31) * KST + 16 * s + 8 * hh); sacc = MFMA32(a, qf[s], sacc); }
#pragma unroll
            for (int i = 0; i < 16; ++i) {
                const int ci = 32 * kt + (i & 3) + 8 * (i >> 2);
                float sc = __builtin_fmaf(sacc[i], c1, __builtin_fmaf(s16, (float)ci, base));
                sc = (ci <= nmaxh) ? sc : NEGBIG;
                const float e = fast_exp2(sc - mx); sacc[i] = e; sum += e;
            }
            float co[4];
#pragma unroll
            for (int gq = 0; gq < 4; ++gq) { const float p3 = 0.5f * sacc[4 * gq + 3];
                imp[4 * kt + gq] = sacc[4 * gq] + sacc[4 * gq + 1] + sacc[4 * gq + 2] + p3; co[gq] = __shfl_xor(p3, 32); }
#pragma unroll
            for (int gq = 0; gq < 4; ++gq) imp[4 * kt + gq] += hh ? co[gq] : (gq > 0 ? co[gq - 1] : prevc);
            prevc = co[3];
#pragma unroll
            for (int s2 = 0; s2 < 2; ++s2) {
                const bf16x8 pf = pack_step(sacc, s2);
                const int kb = 32 * kt + 16 * s2 + 4 * hh;
#pragma unroll
                for (int dt = 0; dt < 2; ++dt) {
                    LAS const bf16_t* vp = Vct + (32 * dt + l31) * CVST + kb;
                    const s16x4 lo = *(LAS const s16x4*)vp, hi = *(LAS const s16x4*)(vp + 8);
                    const bf16x8 vf = __builtin_shufflevector(lo, hi, 0, 1, 2, 3, 4, 5, 6, 7);
                    if (dt == 0) oc0 = MFMA32(vf, pf, oc0); else oc1 = MFMA32(vf, pf, oc1);
                }
            }
        }
    }
    sum = xhalf_sum(sum);
    const float inv = 1.0f / fmaxf(sum, 1.0e-30f);
#pragma unroll
    for (int j = 0; j < 16; ++j) imp[j] *= inv;
    oc0 *= inv; oc1 *= inv;
}

DI void load_cmp(const bf16_t* part_b, const float* pebias, const float* gk0, int g, int nkeys, LAS bf16_t* Kc, LAS bf16_t* Vct) {
    const int tid = threadIdx.x, e8 = (tid & 7) * 8, n0 = tid >> 3;
    const f32x4 c0 = ld4(pebias + g * 64 + e8), c1 = ld4(pebias + g * 64 + e8 + 4), h0 = ld4(pebias + (4 + g) * 64 + e8), h1 = ld4(pebias + (4 + g) * 64 + e8 + 4);
    const f32x4 g0 = ld4(gk0 + e8), g1 = ld4(gk0 + e8 + 4);
    u32x4 q[2][4];
#pragma unroll
    for (int it = 0; it < 2; ++it) { const int n = n0 + 64 * it;
#pragma unroll
        for (int j = 0; j < 4; ++j) q[it][j] = (u32x4){0u, 0u, 0u, 0u};
        if (n < nkeys && n <= 126) {
            const bf16_t* lo = part_b + ((size_t)n * 8) * 128; const bf16_t* hi = part_b + ((size_t)(n + 1) * 8) * 128 + 64;
            q[it][0] = *(const u32x4*)(lo + g * 128 + e8); q[it][1] = *(const u32x4*)(hi + g * 128 + e8);
            q[it][2] = *(const u32x4*)(lo + (4 + g) * 128 + e8); q[it][3] = *(const u32x4*)(hi + (4 + g) * 128 + e8);
        } }
#pragma unroll
    for (int it = 0; it < 2; ++it) { const int n = n0 + 64 * it;
        if (n < nkeys) {
            float xk[8], xv[8];
            if (n <= 126) { for (int i = 0; i < 4; ++i) {
                    xk[2 * i] = bf_lo(q[it][0][i]) + bf_lo(q[it][1][i]) + (i < 2 ? c0[2 * i] : c1[2 * i - 4]); xk[2 * i + 1] = bf_hi(q[it][0][i]) + bf_hi(q[it][1][i]) + (i < 2 ? c0[2 * i + 1] : c1[2 * i - 3]);
                    xv[2 * i] = bf_lo(q[it][2][i]) + bf_lo(q[it][3][i]) + (i < 2 ? h0[2 * i] : h1[2 * i - 4]); xv[2 * i + 1] = bf_hi(q[it][2][i]) + bf_hi(q[it][3][i]) + (i < 2 ? h0[2 * i + 1] : h1[2 * i - 3]); } }
            else { for (int i = 0; i < 8; ++i) { xk[i] = 0.f; xv[i] = 0.f; } }
            float ss = 0.f; for (int i = 0; i < 8; ++i) ss += xk[i] * xk[i];
            ss += __shfl_xor(ss, 1); ss += __shfl_xor(ss, 2); ss += __shfl_xor(ss, 4);
            const float rstd = __builtin_amdgcn_rsqf(ss * (1.0f / 64.0f) + 1e-6f);
            u32x4 w; for (int i = 0; i < 2; ++i) { w[i] = pack_bf2(xk[2 * i] * rstd * g0[2 * i], xk[2 * i + 1] * rstd * g0[2 * i + 1]); w[2 + i] = pack_bf2(xk[4 + 2 * i] * rstd * g1[2 * i], xk[5 + 2 * i] * rstd * g1[2 * i + 1]); }
            *(LAS u32x4*)(Kc + n * KST + e8) = w;
            for (int i = 0; i < 8; ++i) Vct[(e8 + i) * CVST + n] = (bf16_t)(pack_bf2(xv[i], 0.f) & 0xffffu);
        } }
}

DI void attn_unit_P(const Params& p, int b, int g, int qt, LAS unsigned char* lds) {
    const int tid = threadIdx.x, wid = tid >> 6, lane = tid & 63, l31 = lane & 31, hh = lane >> 5;
    const int r = wid & 3, qh = wid >> 2, head = 4 * g + r;
    const int ql = 32 * qh + l31, t = 64 * qt + ql, row = b * 2048 + t;
    const float slope2 = fast_exp2(-0.5f * (float)(head + 1)) * LOG2E;
    const bf16_t* qbf = (const bf16_t*)(p.ws + WS_Q);
    bf16x8 qf[4];
#pragma unroll
    for (int s = 0; s < 4; ++s) qf[s] = *(const bf16x8*)(qbf + (size_t)row * 1024 + head * 64 + 16 * s + 8 * hh);
    LAS bf16_t* Kc = (LAS bf16_t*)lds; LAS bf16_t* Vct = (LAS bf16_t*)(lds + 128 * KST * 2);
    LAS float* impbuf = (LAS float*)(lds + 2 * KVBUF);
    LAS float* impsum = impbuf + 4 * 64 * 33;
    LAS unsigned* selm = (LAS unsigned*)(impsum + 64 * 33);
    const float* gt = (const float*)(p.ws + WS_GATES) + (size_t)row * 48 + head * 3;
    const float g0 = gt[0], g1 = gt[1], g2 = gt[2];
    LAS float* cacc = (LAS float*)(lds + 81920 + wid * 8192);
    {
        int n_hi = 4 * qt + 2; n_hi = n_hi > 126 ? 126 : n_hi; const int ntile = (n_hi >> 5) + 1;
        load_cmp((const bf16_t*)(p.ws + WS_PART_P) + (size_t)b * 131072, (const float*)(p.ws + WS_PEBIAS), p.g_knorm, g, 32 * ntile, Kc, Vct);
        if (tid < 65) selm[tid] = 0u;
        __syncthreads();
        float imp[16]; f32x16 oc0, oc1;
        attn_cmp(Kc, Vct, qf, t, slope2, ntile, lane, oc0, oc1, imp);
#pragma unroll
        for (int i = 0; i < 16; ++i) { cacc[crow(i, hh) * 32 + l31] = oc0[i] * g0; cacc[(32 + crow(i, hh)) * 32 + l31] = oc1[i] * g0; }
#pragma unroll
        for (int j = 0; j < 16; ++j) impbuf[(r * 64 + ql) * 33 + 8 * (j >> 2) + 2 * (j & 3) + hh] = imp[j];
        __syncthreads();
    }
    unsigned mysel, un;
    if (qt >= 16) {
        const int q = tid >> 3, sub = tid & 7;
#pragma unroll
        for (int j = 0; j < 4; ++j) { const int s = sub * 4 + j; impsum[q * 33 + s] = (impbuf[(0 * 64 + q) * 33 + s] + impbuf[(1 * 64 + q) * 33 + s]) + (impbuf[(2 * 64 + q) * 33 + s] + impbuf[(3 * 64 + q) * 33 + s]); }
        __syncthreads();
        unsigned bits = 0u;
        for (int j = 0; j < 4; ++j) { const int s = sub * 4 + j;
            if (s >= 1 && s <= qt - 2) { const float v = impsum[q * 33 + s]; int cnt = 0;
                for (int s2 = 1; s2 <= qt - 2; ++s2) { const float v2 = impsum[q * 33 + s2]; cnt += (v2 > v || (v2 == v && s2 < s)) ? 1 : 0; }
                if (cnt < 13) bits |= 1u << s; } }
        bits |= __shfl_xor(bits, 1); bits |= __shfl_xor(bits, 2); bits |= __shfl_xor(bits, 4);
        bits |= 1u | (1u << qt) | (1u << (qt - 1));
        if (sub == 0) { selm[q] = bits; atomicOr((unsigned*)(selm + 64), bits); }
        __syncthreads();
        mysel = selm[ql]; un = selm[64];
    } else { mysel = (2u << qt) - 1u; un = mysel; }
    const bf16_t* kvs = (const bf16_t*)(p.ws + WS_KVS); const bf16_t* kvw = (const bf16_t*)(p.ws + WS_KVW);
    const bool ldK = tid < 256; const int v = tid & 255;
#pragma unroll 1
    for (int br = 0; br < 2; ++br) {
        const bf16_t* src = br ? kvw : kvs;
        const int k_lo = br ? (qt > 8 ? qt - 8 : 0) : 0;
        const unsigned tmask = br ? 0xffffffffu : un;
        AttnSt st; attn_init(st);
        u32x4 r0, r1, r2, r3;
#define P_ISSUE(RA, RB, TILE) { const size_t base = ((size_t)b * 2048 + 64 * (TILE)) * 512 + g * 64; \
            if (ldK) { RA = *(const u32x4*)(src + base + (size_t)(v >> 3) * 512 + (v & 7) * 8); RB = *(const u32x4*)(src + base + (size_t)((v >> 3) + 32) * 512 + (v & 7) * 8); } \
            else { RA = *(const u32x4*)(src + base + 256 + (size_t)(2 * (v >> 3)) * 512 + (v & 7) * 8); RB = *(const u32x4*)(src + base + 256 + (size_t)(2 * (v >> 3) + 1) * 512 + (v & 7) * 8); } }
#define P_STASH(RA, RB, KB_, VT_) { if (ldK) { *(LAS u32x4*)(KB_ + (v >> 3) * KST + (v & 7) * 8) = RA; *(LAS u32x4*)(KB_ + ((v >> 3) + 32) * KST + (v & 7) * 8) = RB; } \
            else { _Pragma("unroll") for (int j = 0; j < 4; ++j) { const unsigned a_ = RA[j], c_ = RB[j]; \
                    *(LAS unsigned*)(VT_ + ((v & 7) * 8 + 2 * j) * VST + 2 * (v >> 3)) = (a_ & 0xffffu) | (c_ << 16); \
                    *(LAS unsigned*)(VT_ + ((v & 7) * 8 + 2 * j + 1) * VST + 2 * (v >> 3)) = (a_ >> 16) | (c_ & 0xffff0000u); } } }
#define P_NEXT(FROM) ({ int n_ = (FROM) - 1; while (n_ >= k_lo && !((tmask >> n_) & 1u)) --n_; n_; })
#define P_TILE(KT, KB_, VT_) { const bool allow = br ? true : (((mysel >> (KT)) & 1u) != 0u); \
            if (__any(allow)) { \
                if (br) { if ((KT) < qt && (KT) + 8 > qt) attn_tile64<1, true>(KB_, VT_, qf, t - 64 * (KT), slope2, allow, lane, st); else attn_tile64<1, false>(KB_, VT_, qf, t - 64 * (KT), slope2, allow, lane, st); } \
                else { if ((KT) < qt) attn_tile64<0, true>(KB_, VT_, qf, t - 64 * (KT), slope2, allow, lane, st); else attn_tile64<0, false>(KB_, VT_, qf, t - 64 * (KT), slope2, allow, lane, st); } } }
        int kA = P_NEXT(qt + 1), kB = kA >= k_lo ? P_NEXT(kA) : -1;
        if (kA >= k_lo) P_ISSUE(r0, r1, kA)
        if (kB >= k_lo) P_ISSUE(r2, r3, kB)
        int sb = 0;
        while (kA >= k_lo) {
            LAS bf16_t* Ka = (LAS bf16_t*)(lds + (2 * sb) * KVBUF); LAS bf16_t* Va = Ka + 64 * KST;
            LAS bf16_t* Kb2 = (LAS bf16_t*)(lds + (2 * sb + 1) * KVBUF); LAS bf16_t* Vb2 = Kb2 + 64 * KST;
            P_STASH(r0, r1, Ka, Va)
            if (kB >= k_lo) P_STASH(r2, r3, Kb2, Vb2)
            __syncthreads();
            const int nA = kB >= k_lo ? P_NEXT(kB) : -1, nB = nA >= k_lo ? P_NEXT(nA) : -1;
            if (nA >= k_lo) P_ISSUE(r0, r1, nA)
            if (nB >= k_lo) P_ISSUE(r2, r3, nB)
            P_TILE(kA, Ka, Va)
            if (kB >= k_lo) P_TILE(kB, Kb2, Vb2)
            kA = nA; kB = nB; sb ^= 1;
        }
#undef P_ISSUE
#undef P_STASH
#undef P_NEXT
#undef P_TILE
        const float sc = (br ? g2 : g1) / fmaxf(st.l, 1.0e-30f);
#pragma unroll
        for (int i = 0; i < 16; ++i) { cacc[crow(i, hh) * 32 + l31] += st.o0[i] * sc; cacc[(32 + crow(i, hh)) * 32 + l31] += st.o1[i] * sc; }
        __syncthreads();
    }
    bf16_t* ocat = (bf16_t*)(p.ws + WS_OCAT) + (size_t)row * DM + head * 64;
#pragma unroll
    for (int gq = 0; gq < 4; ++gq) {
        f32x4 a, c; for (int i = 0; i < 4; ++i) { a[i] = cacc[crow(4 * gq + i, hh) * 32 + l31]; c[i] = cacc[(32 + crow(4 * gq + i, hh)) * 32 + l31]; }
        st_bf4(ocat + 8 * gq + 4 * hh, a); st_bf4(ocat + 32 + 8 * gq + 4 * hh, c);
    }
}
DI const char* uniform_ptr(const void* p) {
    const unsigned long long v = (unsigned long long)p;
    const unsigned lo = __builtin_amdgcn_readfirstlane((unsigned)v), hi = __builtin_amdgcn_readfirstlane((unsigned)(v >> 32));
    return (const char*)(((unsigned long long)hi << 32) | lo);
}
DI void wave_load_kv(const float* base, int nvalid, LAS bf16_t* Kb, LAS bf16_t* Vt, int lane) {
    const int sub = lane >> 4, seg = lane & 15;
    const char* ub = uniform_ptr(base);
    const unsigned loffK = (unsigned)(sub * 512 + seg * 4) * 4u, loffV = (unsigned)(sub * 1024 + 256 + seg * 4) * 4u;
    f32x4 vk[16], vv[16];
#pragma unroll
    for (int ps = 0; ps < 16; ++ps) { vk[ps] = (f32x4){0.f, 0.f, 0.f, 0.f}; if (ps * 4 + sub < nvalid) vk[ps] = __builtin_nontemporal_load((const f32x4*)(ub + (size_t)ps * 8192 + loffK)); }
#define S_LOAD_V(PS) { const int kp = (PS) * 4 + sub; vv[2 * (PS)] = (f32x4){0.f, 0.f, 0.f, 0.f}; vv[2 * (PS) + 1] = (f32x4){0.f, 0.f, 0.f, 0.f}; \
        if (2 * kp < nvalid) vv[2 * (PS)] = __builtin_nontemporal_load((const f32x4*)(ub + (size_t)(PS) * 16384 + loffV)); \
        if (2 * kp + 1 < nvalid) vv[2 * (PS) + 1] = __builtin_nontemporal_load((const f32x4*)(ub + (size_t)(PS) * 16384 + 2048 + loffV)); }
#pragma unroll
    for (int ps = 0; ps < 4; ++ps) S_LOAD_V(ps)
#pragma unroll
    for (int ps = 0; ps < 16; ++ps) { u32x2 w; w[0] = pack_bf2(vk[ps][0], vk[ps][1]); w[1] = pack_bf2(vk[ps][2], vk[ps][3]);
        *(LAS u32x2*)(Kb + (ps * 4 + sub) * KST + seg * 4) = w; }
    asm volatile("" ::: "memory");
#pragma unroll
    for (int ps = 4; ps < 8; ++ps) S_LOAD_V(ps)
#undef S_LOAD_V
#pragma unroll
    for (int ps = 0; ps < 8; ++ps) { const int kp = ps * 4 + sub;
#pragma unroll
        for (int j = 0; j < 4; ++j) *(LAS unsigned*)(Vt + (seg * 4 + j) * VST + 2 * kp) = pack_bf2(vv[2 * ps][j], vv[2 * ps + 1][j]); }
}

DI void attn_unit_S(const Params& p, int b, int g, LAS unsigned char* lds) {
    const int tid = threadIdx.x, wid = tid >> 6, lane = tid & 63, l31 = lane & 31, hh = lane >> 5;
    const int r = l31 >> 3, qi = l31 & 7, head = 4 * g + r, t = PAST + qi, row = NP + b * 8 + qi;
    const float slope2 = fast_exp2(-0.5f * (float)(head + 1)) * LOG2E;
    const bf16_t* qbf = (const bf16_t*)(p.ws + WS_Q);
    bf16x8 qf[4];
#pragma unroll
    for (int s = 0; s < 4; ++s) qf[s] = *(const bf16x8*)(qbf + (size_t)row * 1024 + head * 64 + 16 * s + 8 * hh);
    LAS bf16_t* Kc = (LAS bf16_t*)lds; LAS bf16_t* Vct = (LAS bf16_t*)(lds + 128 * KST * 2);
    LAS bf16_t* Kb = (LAS bf16_t*)(lds + wid * KVBUF); LAS bf16_t* Vt = Kb + 64 * KST;
    LAS float* impS = (LAS float*)(lds + 8 * KVBUF) + wid * 8 * 33;
    LAS float* ocb = (LAS float*)(lds + 8 * KVBUF + 8 * 8 * 33 * 4);
    LAS float* mo = (LAS float*)lds;
    LAS float* mm = mo + 8 * 2048; LAS float* ml = mm + 256;
    load_cmp((const bf16_t*)(p.ws + WS_PART_S) + (size_t)b * 131072, (const float*)(p.ws + WS_PEBIAS), p.g_knorm, g, 128, Kc, Vct);
    __syncthreads();
    unsigned mysel;
    {
        float imp[16]; f32x16 oc0, oc1;
        attn_cmp(Kc, Vct, qf, t, slope2, 4, lane, oc0, oc1, imp);
#pragma unroll
        for (int j = 0; j < 16; ++j) { float v = imp[j]; v += __shfl_xor(v, 8); v += __shfl_xor(v, 16); imp[j] = v; }
        if (l31 < 8) {
#pragma unroll
            for (int j = 0; j < 16; ++j) impS[qi * 33 + 8 * (j >> 2) + 2 * (j & 3) + hh] = imp[j];
        }
        if (wid == 0) {
#pragma unroll
            for (int i = 0; i < 16; ++i) { ocb[(crow(i, hh)) * 32 + l31] = oc0[i]; ocb[(32 + crow(i, hh)) * 32 + l31] = oc1[i]; }
        }
        __syncthreads();
        const int q2 = lane & 7, part = lane >> 3;
        unsigned bits = 0u;
        for (int j = 0; j < 4; ++j) { const int s = part * 4 + j;
            if (s >= 1 && s <= 30) { const float v = impS[q2 * 33 + s]; int cnt = 0;
                for (int s2 = 1; s2 <= 30; ++s2) { const float v2 = impS[q2 * 33 + s2]; cnt += (v2 > v || (v2 == v && s2 < s)) ? 1 : 0; }
                if (cnt < 13) bits |= 1u << s; } }
        bits |= __shfl_xor(bits, 8); bits |= __shfl_xor(bits, 16); bits |= __shfl_xor(bits, 32);
        bits |= 1u | (1u << 31);
        mysel = __shfl(bits, qi);
    }
    unsigned un = mysel;
    un |= __shfl_xor(un, 1); un |= __shfl_xor(un, 2); un |= __shfl_xor(un, 4);
    un = __builtin_amdgcn_readfirstlane(un);
    float res[4];
    const int mq = tid & 31, md = tid >> 5;
    const int mrow = NP + b * 8 + (mq & 7), mhead = 4 * g + (mq >> 3);
    const float* gt = (const float*)(p.ws + WS_GATES) + (size_t)mrow * 48 + mhead * 3;
    { const float g0 = gt[0]; for (int i = 0; i < 4; ++i) res[i] = g0 * ocb[(4 * md + i) * 32 + mq]; }
#pragma unroll 1
    for (int br = 0; br < 2; ++br) {
        AttnSt st; attn_init(st);
        {
            int s = -1, cnt = 0, j = wid - 8;
            for (;;) {
                const float* base; int nvalid = 64, rel; bool allow = true;
                if (br == 0) {
                    bool found = false;
                    while (++s <= 32) { if (s < 32 && !((un >> s) & 1u)) continue; if ((cnt++ & 7) == wid) { found = true; break; } }
                    if (!found) break;
                    if (s < 32) { const int page = p.page_table[b * 16 + (s >> 1)];
                        base = p.cache_slc + ((size_t)page * 128 + (s & 1) * 64) * 512 + g * 64; allow = ((mysel >> s) & 1u) != 0u; }
                    else { base = p.out + O_SLC_S + (size_t)b * 8 * 512 + g * 64; nvalid = 8; }
                    rel = t - 64 * s;
                } else {
                    j += 8; if (j >= 9) break;
                    if (j < 8) base = p.cache_win + ((size_t)b * 512 + 64 * j) * 512 + g * 64;
                    else { base = p.out + O_WIN_S + ((size_t)b * 512 + 504) * 512 + g * 64; nvalid = 8; }
                    rel = t - (1536 + 64 * j);
                }
                wave_load_kv(base, nvalid, Kb, Vt, lane);
                asm volatile("s_waitcnt lgkmcnt(0)" ::: "memory");
                if (br) { if (j >= 1 && j < 8) attn_tile64<1, true>(Kb, Vt, qf, rel, slope2, allow, lane, st); else attn_tile64<1, false>(Kb, Vt, qf, rel, slope2, allow, lane, st); }
                else { if (s < 32) attn_tile64<0, true>(Kb, Vt, qf, rel, slope2, allow, lane, st); else attn_tile64<0, false>(Kb, Vt, qf, rel, slope2, allow, lane, st); }
                asm volatile("s_waitcnt lgkmcnt(0)" ::: "memory");
            }
        }
        __syncthreads();
#pragma unroll
        for (int i = 0; i < 16; ++i) { mo[wid * 2048 + crow(i, hh) * 32 + l31] = st.o0[i]; mo[wid * 2048 + (32 + crow(i, hh)) * 32 + l31] = st.o1[i]; }
        if (hh == 0) { mm[wid * 32 + l31] = st.m; ml[wid * 32 + l31] = st.l; }
        __syncthreads();
        {
            float M = NEGBIG;
            for (int w = 0; w < 8; ++w) M = fmaxf(M, mm[w * 32 + mq]);
            float L = 0.f, acc[4] = {0.f, 0.f, 0.f, 0.f};
            for (int w = 0; w < 8; ++w) { const float f = fast_exp2(mm[w * 32 + mq] - M); L += ml[w * 32 + mq] * f;
                for (int i = 0; i < 4; ++i) acc[i] += mo[w * 2048 + (4 * md + i) * 32 + mq] * f; }
            const float sc = gt[1 + br] / fmaxf(L, 1.0e-30f);
            for (int i = 0; i < 4; ++i) res[i] += acc[i] * sc;
        }
        __syncthreads();
    }
    f32x4 o = {res[0], res[1], res[2], res[3]};
    st_bf4((bf16_t*)(p.ws + WS_OCAT) + (size_t)mrow * DM + mhead * 64 + 4 * md, o);
}
DI unsigned f2sortable(float f) { const unsigned u = __float_as_uint(f); return (u & 0x80000000u) ? ~u : (u | 0x80000000u); }
DI float sortable2f(unsigned s) { const unsigned u = (s & 0x80000000u) ? (s & 0x7fffffffu) : ~s; return __uint_as_float(u); }

#define PEER_CE(a, b) { const unsigned hi_ = (a) > (b) ? (a) : (b), lo_ = (a) > (b) ? (b) : (a); (a) = hi_; (b) = lo_; }
template <int B> DI void peer_sort16(unsigned (&x)[64]) {
#pragma unroll
    for (int k = 2; k <= 16; k <<= 1)
#pragma unroll
        for (int j = k >> 1; j > 0; j >>= 1)
#pragma unroll
            for (int i = 0; i < 16; ++i) { const int l = i ^ j; if (l > i) { if ((i & k) == 0) PEER_CE(x[B + i], x[B + l]) else PEER_CE(x[B + l], x[B + i]) } }
}
DI void peer_merge16(unsigned (&t)[16]) {
#pragma unroll
    for (int j = 8; j > 0; j >>= 1)
#pragma unroll
        for (int i = 0; i < 16; ++i) { const int l = i ^ j; if (l > i) PEER_CE(t[i], t[l]) }
}
DI void peer_scores_item(const Params& p, int tile, int hp, int lane, LAS const bf16_t* SK) {
    const int h = hp >> 1, pp = hp & 1, l31 = lane & 31, hh = lane >> 5;
    const bf16_t* pq = (const bf16_t*)(p.ws + WS_PQ) + (size_t)(tile * 32 + l31) * DM + h * 256 + pp * 128 + 8 * hh;
    bf16x8 qv[8];
#pragma unroll
    for (int s = 0; s < 8; ++s) qv[s] = *(const bf16x8*)(pq + 16 * s);
    f32x16 acc[4]; for (int i = 0; i < 4; ++i) acc[i] = zero16();
#pragma unroll
    for (int s = 0; s < 8; ++s) {
#pragma unroll
        for (int kt = 0; kt < 4; ++kt) { const bf16x8 kv = *(LAS const bf16x8*)(SK + (kt * 32 + l31) * 136 + 16 * s + 8 * hh); acc[kt] = MFMA32(kv, qv[s], acc[kt]); }
    }
    unsigned x[64];
#pragma unroll
    for (int kt = 0; kt < 4; ++kt)
#pragma unroll
        for (int i = 0; i < 16; ++i) { const int key = 32 * kt + crow(i, hh); x[kt * 16 + i] = (f2sortable(acc[kt][i]) & ~127u) | (unsigned)(127 - key); }
    unsigned win[16], w2[16];
    peer_sort16<0>(x); peer_sort16<16>(x);
#pragma unroll
    for (int i = 0; i < 16; ++i) win[i] = x[i] > x[31 - i] ? x[i] : x[31 - i];
    peer_merge16(win);
    peer_sort16<32>(x); peer_sort16<48>(x);
#pragma unroll
    for (int i = 0; i < 16; ++i) w2[i] = x[32 + i] > x[63 - i] ? x[32 + i] : x[63 - i];
    peer_merge16(w2);
#pragma unroll
    for (int i = 0; i < 8; ++i) { const unsigned a = win[i] > w2[15 - i] ? win[i] : w2[15 - i], b = win[15 - i] > w2[i] ? win[15 - i] : w2[i]; win[i] = a; win[15 - i] = b; }
    peer_merge16(win);
#pragma unroll
    for (int i = 0; i < 16; ++i) w2[i] = (unsigned)__shfl_xor((int)win[i], 32);
#pragma unroll
    for (int i = 0; i < 8; ++i) { const unsigned a = win[i] > w2[15 - i] ? win[i] : w2[15 - i], b = win[15 - i] > w2[i] ? win[15 - i] : w2[i]; win[i] = a; win[15 - i] = b; }
    peer_merge16(win);
    if (hh == 0) {
        int l31_ = l31; asm volatile("" : "+v"(l31_));
        float* tv = (float*)(p.ws + WS_TOPV) + ((size_t)(tile * 32 + l31_) * 16 + hp) * 16;
        unsigned char* ti = p.ws + WS_TOPI + ((size_t)(tile * 32 + l31_) * 16 + hp) * 16;
        u32x4 kb = {0u, 0u, 0u, 0u};
#pragma unroll
        for (int j = 0; j < 4; ++j) {
            f32x4 v;
            for (int i = 0; i < 4; ++i) { const unsigned w = win[4 * j + i]; v[i] = sortable2f(w & ~127u); kb[j] |= (127u - (w & 127u)) << (8 * i); }
            st4(tv + 4 * j, v);
        }
        *(u32x4*)ti = kb;
    }
}

DI float wave_sum(float v) {
#pragma unroll
    for (int o = 32; o >= 1; o >>= 1) v += __shfl_xor(v, o);
    return v;
}
DI float gelu_exact(float x) { return 0.5f * x * (1.0f + erff(x * 0.70710678118654752f)); }

#define PEER_DOT4(B) { const bf16v2 f = __builtin_amdgcn_cvt_scalef32_pk_bf16_fp4(ub[kk][i], 1.0f, B); acc = __builtin_amdgcn_fdot2_f32_bf16(f, __builtin_bit_cast(bf16v2, hp[4 * i + B]), acc, false); }
#define PEER_AXPY4(B) { const f32x2 f = __builtin_amdgcn_cvt_scalef32_pk_f32_fp4(vb[kk][i], 1.0f, B); ov[8 * i + 2 * B] = __builtin_fmaf(f[0], ws[kk], ov[8 * i + 2 * B]); ov[8 * i + 2 * B + 1] = __builtin_fmaf(f[1], ws[kk], ov[8 * i + 2 * B + 1]); }
constexpr int PEER_SLOTS = 9;
DI void peer_token_U(const Params& p, int tok, int lane, LAS unsigned char* lds, int slot) {
    const float* tv = (const float*)(p.ws + WS_TOPV) + (size_t)tok * 256;
    const unsigned char* ti = p.ws + WS_TOPI + (size_t)tok * 256;
    const int hd = lane >> 3, sub = lane & 7;
    unsigned x[7];
#pragma unroll
    for (int i = 0; i < 7; ++i) {
        const int j = sub + 8 * i;
        int ca, cb;
        if (j < 16) { ca = 0; cb = j; } else if (j < 24) { ca = 1; cb = j - 16; } else if (j < 29) { ca = 2; cb = j - 24; } else if (j < 33) { ca = 3; cb = j - 29; }
        else if (j < 36) { ca = 4; cb = j - 33; } else if (j < 38) { ca = 5; cb = j - 36; } else if (j < 40) { ca = 6; cb = j - 38; } else if (j < 42) { ca = 7; cb = j - 40; }
        else { ca = 8 + (j - 42); cb = 0; }
        x[i] = 0u;
        if (j < 50) { const float v = tv[hd * 32 + ca] + tv[hd * 32 + 16 + cb]; x[i] = (f2sortable(v) & ~255u) | (unsigned)(255 - (ca * 16 + cb)); }
    }
    unsigned prev = 0xffffffffu, w0 = 0u, w1 = 0u;
#pragma unroll
    for (int rnd = 0; rnd < 16; ++rnd) {
        unsigned best = 0u;
#pragma unroll
        for (int j = 0; j < 7; ++j) { const unsigned c = x[j] < prev ? x[j] : 0u; best = best > c ? best : c; }
#pragma unroll
        for (int o = 1; o <= 4; o <<= 1) { const unsigned ot = (unsigned)__shfl_xor((int)best, o); best = best > ot ? best : ot; }
        if (sub == (rnd >> 1)) { if (rnd & 1) w1 = best; else w0 = best; }
        prev = best;
    }
    const float sc0 = sortable2f(w0 & ~255u), sc1 = sortable2f(w1 & ~255u);
    const int id0 = 255 - (int)(w0 & 255u), id1 = 255 - (int)(w1 & 255u);
    const int e0 = (int)ti[hd * 32 + (id0 >> 4)] * 128 + (int)ti[hd * 32 + 16 + (id0 & 15)];
    const int e1 = (int)ti[hd * 32 + (id1 >> 4)] * 128 + (int)ti[hd * 32 + 16 + (id1 & 15)];
    float mx = fmaxf(sc0, sc1);
#pragma unroll
    for (int o = 1; o <= 4; o <<= 1) mx = fmaxf(mx, __shfl_xor(mx, o));
    float p0 = fast_exp2((sc0 - mx) * LOG2E), p1 = fast_exp2((sc1 - mx) * LOG2E);
    float sm = p0 + p1;
#pragma unroll
    for (int o = 1; o <= 4; o <<= 1) sm += __shfl_xor(sm, o);
    const float isum = 1.0f / sm; p0 *= isum; p1 *= isum;
    const bf16_t* h2 = (const bf16_t*)(p.ws + WS_H) + (size_t)tok * DM;
    unsigned hp[16];
    { LAS bf16_t* HT = (LAS bf16_t*)(lds + 81920 + (threadIdx.x >> 6) * 9216);
      u32x4 q[4];
#pragma unroll
      for (int c = 0; c < 4; ++c) q[c] = *(const u32x4*)(h2 + c * 512 + lane * 8);
#pragma unroll
      for (int c = 0; c < 4; ++c) *(LAS u32x4*)(HT + (c * 16 + (lane >> 2)) * 40 + (lane & 3) * 8) = q[c];
      asm volatile("s_waitcnt lgkmcnt(0)" ::: "memory");
#pragma unroll
      for (int c = 0; c < 4; ++c) { const u32x4 r = *(LAS const u32x4*)(HT + lane * 40 + 8 * c); for (int i = 0; i < 4; ++i) hp[4 * c + i] = r[i]; }
      asm volatile("s_waitcnt lgkmcnt(0)" ::: "memory"); }
    const unsigned char* U = p.ws + WS_U; const float* su = (const float*)(p.ws + WS_USCALE); const float* sv = (const float*)(p.ws + WS_VSCALE);
    LAS float* gl = (LAS float*)(lds + (threadIdx.x >> 6) * 1024); LAS float* gs = gl + 128; LAS float* wl = (LAS float*)(lds + 8192 + (threadIdx.x >> 6) * 9216 + slot * 1024);
    { u32x2 ee; ee[0] = (unsigned)e0; ee[1] = (unsigned)e1; *(LAS u32x2*)((LAS unsigned char*)wl + 512 + lane * 8) = ee; }
    gl[2 * lane] = p0 * sv[e0]; gl[2 * lane + 1] = p1 * sv[e1]; gs[2 * lane] = su[e0]; gs[2 * lane + 1] = su[e1];
    asm volatile("s_waitcnt lgkmcnt(0)" ::: "memory");
    const int kkl = (lane >> 2) & 15;
#pragma unroll 1
    for (int k0 = 0; k0 < 128; k0 += 16) {
        u32x4 ub[16]; float d[16];
#pragma unroll
        for (int kk = 0; kk < 16; ++kk) { const int e = __builtin_amdgcn_readlane((kk & 1) ? e1 : e0, (k0 + kk) >> 1);
            ub[kk] = *(const u32x4*)(U + (size_t)e * 1024 + lane * 16); }
#pragma unroll
        for (int kk = 0; kk < 16; ++kk) { float acc = 0.f;
            if (kk > 0) asm volatile("" : "+v"(ub[kk][0]), "+v"(ub[kk][1]), "+v"(ub[kk][2]), "+v"(ub[kk][3]), "+v"(d[kk - 1]));
#pragma unroll
            for (int i = 0; i < 4; ++i)
                { PEER_DOT4(0) PEER_DOT4(1) PEER_DOT4(2) PEER_DOT4(3) }
            d[kk] = acc; }
        float r8[8], r4[4], r2[2], r1;
        { const bool up = (lane & 32) != 0;
#pragma unroll
          for (int i = 0; i < 8; ++i) { const float keep = up ? d[8 + i] : d[i], send = up ? d[i] : d[8 + i]; r8[i] = keep + __shfl_xor(send, 32); } }
        { const bool up = (lane & 16) != 0;
#pragma unroll
          for (int i = 0; i < 4; ++i) { const float keep = up ? r8[4 + i] : r8[i], send = up ? r8[i] : r8[4 + i]; r4[i] = keep + __shfl_xor(send, 16); } }
        { const bool up = (lane & 8) != 0;
#pragma unroll
          for (int i = 0; i < 2; ++i) { const float keep = up ? r4[2 + i] : r4[i], send = up ? r4[i] : r4[2 + i]; r2[i] = keep + __shfl_xor(send, 8); } }
        { const bool up = (lane & 4) != 0; const float keep = up ? r2[1] : r2[0], send = up ? r2[0] : r2[1]; r1 = keep + __shfl_xor(send, 4); }
        r1 += __shfl_xor(r1, 2); r1 += __shfl_xor(r1, 1);
        const float wgt = gl[k0 + kkl] * gelu_exact(r1 * gs[k0 + kkl]);
        if ((lane & 3) == 0) wl[k0 + kkl] = wgt;
    }
    asm volatile("s_waitcnt lgkmcnt(0)" ::: "memory");
}

DI void peer_token_V(const Params& p, int tok, int lane, LAS unsigned char* lds, int slot, bool commit) {
    const unsigned char* V = p.ws + WS_V;
    LAS const float* wl = (LAS const float*)(lds + 8192 + (threadIdx.x >> 6) * 9216 + slot * 1024);
    int e0, e1; { const u32x2 ee = *(LAS const u32x2*)((LAS const unsigned char*)wl + 512 + lane * 8); e0 = (int)ee[0]; e1 = (int)ee[1]; }
    asm volatile("s_waitcnt lgkmcnt(0)" ::: "memory");
    float ov[32];
#pragma unroll
    for (int i = 0; i < 32; ++i) ov[i] = 0.f;
#pragma unroll 1
    for (int k0 = 0; k0 < 128; k0 += 16) {
        u32x4 vb[16]; float ws[16];
#pragma unroll
        for (int kk = 0; kk < 16; ++kk) { const int e = __builtin_amdgcn_readlane((kk & 1) ? e1 : e0, (k0 + kk) >> 1);
            vb[kk] = *(const u32x4*)(V + (size_t)e * 1024 + lane * 16);
            ws[kk] = wl[k0 + kk]; }
#pragma unroll
        for (int kk = 0; kk < 16; ++kk) {
            if (kk > 0) asm volatile("" : "+v"(vb[kk][0]), "+v"(vb[kk][1]), "+v"(vb[kk][2]), "+v"(vb[kk][3]), "+v"(ov[31]), "+v"(ov[15]));
#pragma unroll
            for (int i = 0; i < 4; ++i)
                { PEER_AXPY4(0) PEER_AXPY4(1) PEER_AXPY4(2) PEER_AXPY4(3) }
        }
    }
    asm volatile("s_waitcnt lgkmcnt(0)" ::: "memory");
    LAS float* T = (LAS float*)(lds + 81920 + (threadIdx.x >> 6) * 9216);
#pragma unroll
    for (int c = 0; c < 8; ++c) *(LAS f32x4*)(T + lane * 36 + 4 * c) = (f32x4){ov[4 * c], ov[4 * c + 1], ov[4 * c + 2], ov[4 * c + 3]};
    asm volatile("s_waitcnt lgkmcnt(0)" ::: "memory");
    const int mrow = tok < NP ? (tok >> 11) : 8 + ((tok - NP) >> 3);
    const float* gate = (const float*)(p.ws + WS_MOD) + (size_t)mrow * 12288 + 5 * DM;
    float* y = p.out + (size_t)tok * DM; const bf16_t* x1 = (const bf16_t*)(p.ws + WS_X1) + (size_t)tok * DM;
#pragma unroll
    for (int c = 0; c < 8; ++c) {
        const int col = c * 256 + lane * 4;
        const f32x4 o = *(LAS const f32x4*)(T + (c * 8 + (lane >> 3)) * 36 + (lane & 7) * 4);
        const u32x2 xb = *(const u32x2*)(x1 + col); f32x4 a = {bf_lo(xb[0]), bf_hi(xb[0]), bf_lo(xb[1]), bf_hi(xb[1])}; const f32x4 ga = ld4(gate + col);
        for (int i = 0; i < 4; ++i) a[i] += ga[i] * o[i];
        st4((commit ? y : (float*)(p.ws + WS_OCAT) + (size_t)tok * DM) + col, a);
    }
    asm volatile("s_waitcnt lgkmcnt(0)" ::: "memory");
}
constexpr int LDS_BYTES = 163840 - 64;
constexpr int N_PHASES = 11;
#ifndef MK_LAUNCHES
#define MK_LAUNCHES 1
#endif

__global__ __launch_bounds__(512, 2) void mega(Params p) {
    extern __shared__ __attribute__((aligned(16))) unsigned char shm[];
    LAS unsigned char* lds = (LAS unsigned char*)shm;
    const int tid = threadIdx.x, wid = tid >> 6, lane = tid & 63;
    volatile LAS unsigned* xbw = (volatile LAS unsigned*)(lds + LDS_BYTES - 16);
    if (tid == 0) { xbw[0] = 0u; xbw[1] = 0u; xbw[2] = 0u; xbw[3] = 0u; }
    __syncthreads();
    XcdBarrier bar = xcd_barrier_post((unsigned*)(p.ws + WS_BAR), xbw);
#ifndef PH_MASK
#define PH_MASK 0x7ff
#endif
#define IN(ph) (((PH_MASK >> (ph)) & 1) && p.ph_lo <= (ph) && (ph) < p.ph_hi)
#ifndef DUP_MASK
#define DUP_MASK 0
#endif
#define SEAM(ph) do { if (IN(ph) && IN((ph) + 1)) xcd_barrier(bar); } while (0)
    auto ph0 = [&]() __attribute__((always_inline)) { if (IN(0)) phase_A(p, lds); };
    ph0();
    if constexpr ((DUP_MASK >> 0) & 1) ph0();
    SEAM(0);
    auto ph2 = [&]() __attribute__((always_inline)) { if (IN(2)) phase_modulate(p, 0); };
    ph2();
    if constexpr ((DUP_MASK >> 2) & 1) ph2();
    SEAM(2);
    auto ph3 = [&]() __attribute__((always_inline)) { if (IN(3)) {
        pg8::Gemm g{(const bf16_t*)(p.ws + WS_H), (const bf16_t*)(p.ws + WS_WIN_T), NTOK, NIN_PAD, DM};
        pg8::StaticOrder S; S.init(NTOK, NIN_PAD, (int)gridDim.x, (int)blockIdx.x);
        EpiIn E{(bf16_t*)(p.ws + WS_Q), (bf16_t*)(p.ws + WS_KVS), (bf16_t*)(p.ws + WS_KVW), (bf16_t*)(p.ws + WS_UBF), p.out, (float*)(p.ws + WS_GATES), p.g_qnorm, p.g_knorm};
        pg8::gemm_phase<EpiIn, pg8::StaticOrder, false>(lds, g, S, E, nullptr);
    } };
    ph3();
    if constexpr ((DUP_MASK >> 3) & 1) ph3();
#ifdef DUP_GEMM3_NULL
    if (IN(3)) { pg8::Gemm g{(const bf16_t*)(p.ws + WS_H), (const bf16_t*)(p.ws + WS_WIN_T), NTOK, NIN_PAD, DM};
        pg8::StaticOrder S; S.init(NTOK, NIN_PAD, (int)gridDim.x, (int)blockIdx.x);
        EpiNull E{(float*)(p.ws + WS_PQ)};
        pg8::gemm_phase<EpiNull, pg8::StaticOrder, false>(lds, g, S, E, nullptr); }
#endif
    SEAM(3);
    auto ph4 = [&]() __attribute__((always_inline)) { if (IN(4)) {
        for (int u = blockIdx.x; u < 2176 + 544; u += gridDim.x) { const int grp = u / 5, pos = u - 5 * grp; if (pos < 4) cmp_unit(p, grp * 4 + pos, lds); else pool_unit(p, grp, lds); }
#ifdef DUP_CMP
        for (int u = blockIdx.x; u < 2176; u += gridDim.x) cmp_unit(p, u, lds);
#endif
#ifdef DUP_POOL
        for (int u = blockIdx.x; u < 544; u += gridDim.x) pool_unit(p, u, lds);
#endif
    } };
    ph4();
    if constexpr ((DUP_MASK >> 4) & 1) ph4();
    SEAM(4);
    auto ph5 = [&]() __attribute__((always_inline)) { if (IN(5)) {
        const int G = gridDim.x;
#ifndef NO_P
#pragma unroll 1
        for (int i = blockIdx.x; i < 1024; i += G) {
            const int rnd = i / 256, k = (i % 256) >> 5, bg = i & 31;
            const int qt = (rnd & 1) ? (31 - 8 * rnd - 7 + k) : (31 - 8 * rnd - k);
            attn_unit_P(p, bg >> 2, bg & 3, qt, lds);
        }
#endif
#ifndef NO_S
#pragma unroll 1
        for (int j = blockIdx.x; j < 512; j += G) attn_unit_S(p, j >> 2, j & 3, lds);
#ifdef DUP_ATT_S
#pragma unroll 1
        for (int j = blockIdx.x; j < 512; j += G) attn_unit_S(p, j >> 2, j & 3, lds);
#endif
#endif
    } };
    ph5();
    if constexpr ((DUP_MASK >> 5) & 1) ph5();
    SEAM(5);
    auto ph6 = [&]() __attribute__((always_inline)) { if (IN(6)) {
        pg8::Gemm g{(const bf16_t*)(p.ws + WS_OCAT), (const bf16_t*)(p.ws + WS_WOUT_T), NTOK, DM, DM};
        pg8::StaticOrder S; S.init(NTOK, DM, (int)gridDim.x, (int)blockIdx.x);
        EpiOut E{p.x_prompt, p.x_sample, (const float*)(p.ws + WS_MOD), (bf16_t*)(p.ws + WS_X1)};
        pg8::gemm_phase<EpiOut, pg8::StaticOrder, false>(lds, g, S, E, nullptr);
        constexpr int NTAIL = (NTOK / 256) * (DM / 256) - 2 * 256;
        if ((int)gridDim.x == 256 && (int)blockIdx.x >= NTAIL) { __syncthreads(); transpose_wq(p, NTAIL, lds); phase_B_stream(p, NTAIL, 0, lds); }
        else if ((int)gridDim.x != 256) { __syncthreads(); transpose_wq(p, 0, lds); phase_B_stream(p, 0, 0, lds); }
    } };
    ph6();
    if constexpr ((DUP_MASK >> 6) & 1) ph6();
    SEAM(6);
    auto ph7 = [&]() __attribute__((always_inline)) { if (IN(7)) phase_modulate(p, 1); };
    ph7();
    if constexpr ((DUP_MASK >> 7) & 1) ph7();
    SEAM(7);
    auto ph8 = [&]() __attribute__((always_inline)) { if (IN(8)) {
        pg8::Gemm g{(const bf16_t*)(p.ws + WS_H), (const bf16_t*)(p.ws + WS_WQ_T), NTOK, DM, DM};
        pg8::StaticOrder S; S.init(NTOK, DM, (int)gridDim.x, (int)blockIdx.x);
        EpiPq E{(bf16_t*)(p.ws + WS_PQ)};
        pg8::gemm_phase<EpiPq, pg8::StaticOrder, false>(lds, g, S, E, nullptr);
        constexpr int NTAIL = (NTOK / 256) * (DM / 256) - 2 * 256;
        if ((int)gridDim.x == 256 && (int)blockIdx.x >= NTAIL) { __syncthreads(); phase_B_stream(p, NTAIL, 1, lds); }
        else if ((int)gridDim.x != 256) { __syncthreads(); phase_B_stream(p, 0, 1, lds); }
    } };
    ph8();
    if constexpr ((DUP_MASK >> 8) & 1) ph8();
    SEAM(8);
    auto ph9 = [&]() __attribute__((always_inline)) { if (IN(9)) {
        const int hp = blockIdx.x & 15, ngrp = (gridDim.x + 15 - hp) / 16, rank = blockIdx.x >> 4;
        LAS bf16_t* SK = (LAS bf16_t*)lds;
        { const bf16_t* sk = (const bf16_t*)(p.ws + WS_SUBK) + (size_t)((hp & 1) * 8 + (hp >> 1)) * 128 * 128;
          for (int c = tid; c < 128 * 16; c += 512) { const int r = c >> 4, k8 = (c & 15) * 8; *(LAS u32x4*)(SK + r * 136 + k8) = *(const u32x4*)(sk + r * 128 + k8); } }
        __syncthreads();
        for (int tile = wid * ngrp + rank; tile < 544; tile += ngrp * 8) peer_scores_item(p, tile, hp, lane, SK);
        __syncthreads();
     } };
    ph9();
    if constexpr ((DUP_MASK >> 9) & 1) ph9();
    SEAM(9);
    auto ph10 = [&](bool commit) __attribute__((always_inline)) { if (IN(10)) {
#pragma unroll 1
        for (int tok0 = wid * gridDim.x + blockIdx.x; tok0 < NTOK; tok0 += gridDim.x * 8 * PEER_SLOTS) {
#pragma unroll 1
            for (int s = 0; s < PEER_SLOTS; ++s) { const int tok = tok0 + s * (int)gridDim.x * 8; if (tok < NTOK) peer_token_U(p, tok, lane, lds, s); }
#pragma unroll 1
            for (int s = 0; s < PEER_SLOTS; ++s) { const int tok = tok0 + s * (int)gridDim.x * 8; if (tok < NTOK) peer_token_V(p, tok, lane, lds, s, commit); }
        }
    } };
    if constexpr ((DUP_MASK >> 10) & 1) ph10(false);
    ph10(true);
#undef IN
#undef SEAM
}

extern "C" void kernel_launch(void* const* d_in, const int* in_sizes, int n_in, void* d_out, int out_size, void* d_ws, size_t ws_size, hipStream_t stream) {
    static int grid = 0;
    if (grid == 0) {
        if (n_in != 25 || ws_size < WS_END) { fprintf(stderr, "kernel_launch: unexpected inputs (n_in %d, ws %zu < %zu)\n", n_in, ws_size, (size_t)WS_END); grid = -1; return; }
        int dev = 0, cus = 0, per_cu = 0;
        if (hipGetDevice(&dev) != hipSuccess || hipDeviceGetAttribute(&cus, hipDeviceAttributeMultiprocessorCount, dev) != hipSuccess) { grid = -1; return; }
        if (hipFuncSetAttribute((const void*)mega, hipFuncAttributeMaxDynamicSharedMemorySize, LDS_BYTES) != hipSuccess) { fprintf(stderr, "kernel_launch: hipFuncSetAttribute failed\n"); grid = -1; return; }
        if (hipOccupancyMaxActiveBlocksPerMultiprocessor(&per_cu, (const void*)mega, 512, LDS_BYTES) != hipSuccess || per_cu < 1)
            fprintf(stderr, "kernel_launch: occupancy query reports %d blocks per CU\n", per_cu);
        (void)hipGetLastError();
        grid = cus;
    }
    if (grid < 0) return;
    (void)hipMemsetAsync((char*)d_ws + WS_BAR, 0, XCD_BAR_WORDS * sizeof(unsigned), stream);
    Params p{};
    p.x_prompt = (const float*)d_in[0]; p.x_sample = (const float*)d_in[1]; p.cache_cmp = (const float*)d_in[2]; p.cache_slc = (const float*)d_in[3];
    p.cache_win = (const float*)d_in[4]; p.state_pool = (const float*)d_in[5]; p.page_table = (const int*)d_in[6]; p.c_prompt = (const float*)d_in[7];
    p.c_sample = (const float*)d_in[8]; p.w_ada = (const float*)d_in[9]; p.b_ada = (const float*)d_in[10]; p.g_norm1 = (const float*)d_in[11];
    p.g_norm2 = (const float*)d_in[12]; p.w_in = (const float*)d_in[13]; p.w_out = (const float*)d_in[14]; p.g_qnorm = (const float*)d_in[15];
    p.g_knorm = (const float*)d_in[16]; p.cmp_pe = (const float*)d_in[17]; p.w_cmp = (const float*)d_in[18]; p.w_pool = (const float*)d_in[19];
    p.pool_scale = (const float*)d_in[20]; p.peer_wq = (const float*)d_in[21]; p.peer_subkeys = (const float*)d_in[22]; p.peer_u = (const float*)d_in[23];
    p.peer_v = (const float*)d_in[24];
    p.out = (float*)d_out; p.ws = (unsigned char*)d_ws;
#if MK_LAUNCHES == 1
    p.ph_lo = 0; p.ph_hi = N_PHASES;
    hipLaunchKernelGGL(mega, dim3(grid), dim3(512), LDS_BYTES, stream, p);
#else
    for (int ph = 0; ph < N_PHASES; ++ph) { p.ph_lo = ph; p.ph_hi = ph + 1; hipLaunchKernelGGL(mega, dim3(grid), dim3(512), LDS_BYTES, stream, p); }
#endif
}
```

```cpp
#include <hip/hip_runtime.h>
#include <stdint.h>
#include <stdio.h>

#define DI __device__ __forceinline__
#define LAS __attribute__((address_space(3)))
typedef unsigned short bf16_t;
typedef short bf16x8 __attribute__((ext_vector_type(8)));
typedef short s16x4 __attribute__((ext_vector_type(4)));
typedef float f32x2 __attribute__((ext_vector_type(2)));
typedef float f32x4 __attribute__((ext_vector_type(4)));
typedef float f32x16 __attribute__((ext_vector_type(16)));
typedef unsigned u32x2 __attribute__((ext_vector_type(2)));
typedef unsigned u32x4 __attribute__((ext_vector_type(4)));
typedef __bf16 bf16v2 __attribute__((ext_vector_type(2)));

constexpr int DM = 2048;
constexpr int NP = 16384;
constexpr int NSM = 1024;
constexpr int NTOK = NP + NSM;
constexpr int SEQ = 2048, NB_P = 8, NB_S = 128, TS = 8, PAST = 2048;
constexpr int NIN_PAD = 3840;
constexpr int NEXP = 16384;
constexpr float LOG2E = 1.4426950408889634f;
constexpr float NEGBIG = -1.0e30f;

constexpr size_t O_Y = 0;
constexpr size_t O_CMP_P = 35651584, O_SLC_P = 44040192, O_WIN_P = 52428800, O_POOL_P = 54525952;
constexpr size_t O_CMP_S = 54648832, O_SLC_S = 55173120, O_WIN_S = 55697408, O_POOL_S = 89251840;

constexpr size_t al256(size_t x) { return (x + 255) & ~(size_t)255; }
constexpr size_t WS_BAR = 0;
constexpr size_t WS_WIN_T = 16384;
constexpr size_t WS_WOUT_T = WS_WIN_T + (size_t)NIN_PAD * DM * 2;
constexpr size_t WS_WQ_T = WS_WOUT_T + (size_t)DM * DM * 2;
constexpr size_t WS_WCMP_T = WS_WQ_T + (size_t)DM * DM * 2 + (size_t)12288 * DM * 2;
constexpr size_t WS_WPOOL_T = WS_WCMP_T + (size_t)8 * 128 * 1024 * 2;
constexpr size_t WS_SUBK = WS_WPOOL_T + (size_t)4 * 256 * 256 * 2;
constexpr size_t WS_U = WS_SUBK + (size_t)2 * 8 * 128 * 128 * 2;
constexpr size_t WS_V = WS_U + (size_t)NEXP * DM * 2;
constexpr size_t WS_PEBIAS = WS_V + (size_t)NEXP * DM * 2;
constexpr size_t WS_MOD = WS_PEBIAS + 4096 + (size_t)256 * DM * 2;
constexpr size_t WS_H = WS_MOD + (size_t)256 * 12288 * 4;
constexpr size_t WS_Q = WS_H + (size_t)NTOK * DM * 2;
constexpr size_t WS_X1 = WS_Q;
constexpr size_t WS_KVS = WS_Q + (size_t)NTOK * 1024 * 2;
constexpr size_t WS_KVW = WS_KVS + (size_t)NP * 512 * 2;
constexpr size_t WS_GATES = WS_KVW + (size_t)NP * 512 * 2;
constexpr size_t WS_UBF = WS_GATES + (size_t)NTOK * 48 * 4;
constexpr size_t WS_PART_S = WS_UBF + (size_t)NTOK * 1024 * 2;
constexpr size_t WS_PART_P = WS_PART_S + (size_t)NB_S * 128 * 8 * 128 * 4;
constexpr size_t WS_OCAT = WS_PART_P + (size_t)NB_P * 128 * 8 * 128 * 4;
constexpr size_t WS_PQ = WS_OCAT + (size_t)NTOK * DM * 2;
constexpr size_t WS_TOPV = WS_PQ + (size_t)NTOK * DM * 2;
constexpr size_t WS_TOPI = WS_TOPV + (size_t)NTOK * 256 * 4;
constexpr size_t WS_USCALE = WS_TOPI + (size_t)NTOK * 256 * 4;
constexpr size_t WS_VSCALE = WS_USCALE + (size_t)NEXP * 64;
constexpr size_t WS_END = WS_VSCALE + (size_t)NEXP * 64;

struct Params {
    const float *x_prompt, *x_sample, *cache_cmp, *cache_slc, *cache_win, *state_pool;
    const int* page_table;
    const float *c_prompt, *c_sample, *w_ada, *b_ada, *g_norm1, *g_norm2, *w_in, *w_out, *g_qnorm, *g_knorm, *cmp_pe, *w_cmp, *w_pool, *pool_scale,
        *peer_wq, *peer_subkeys, *peer_u, *peer_v;
    float* out;
    unsigned char* ws;
    int ph_lo, ph_hi;
};

DI unsigned pack_bf2(float lo, float hi) {
    f32x2 v = {lo, hi};
    bf16v2 r = __builtin_convertvector(v, bf16v2);
    return __builtin_bit_cast(unsigned, r);
}
DI float bf_lo(unsigned u) { return __uint_as_float(u << 16); }
DI float bf_hi(unsigned u) { return __uint_as_float(u & 0xffff0000u); }
DI float fast_exp2(float x) { return __builtin_amdgcn_exp2f(x); }
DI float fast_rcp(float x) { return __builtin_amdgcn_rcpf(x); }
DI int crow(int reg, int h) { return (reg & 3) + 8 * (reg >> 2) + 4 * h; }
#define MFMA32(a, b, c) __builtin_amdgcn_mfma_f32_32x32x16_bf16((a), (b), (c), 0, 0, 0)
DI f32x16 zero16() { f32x16 z; for (int i = 0; i < 16; ++i) z[i] = 0.f; return z; }
DI bf16x8 pack_step(const f32x16& x, int s) {
    u32x4 p;
    p[0] = pack_bf2(x[8 * s + 0], x[8 * s + 1]); p[1] = pack_bf2(x[8 * s + 2], x[8 * s + 3]);
    p[2] = pack_bf2(x[8 * s + 4], x[8 * s + 5]); p[3] = pack_bf2(x[8 * s + 6], x[8 * s + 7]);
    return __builtin_bit_cast(bf16x8, p);
}
#define XB_TMO      128
#define XB_XCNT(j)  (256  + 64 * (j))
#define XB_XSUB(j)  (1280 + 64 * (j))
#define XB_XGEN(j)  (2304 + 64 * (j))
#define XB_TOP      3328
#define XB_TOPGEN   3392
#define XCD_BAR_WORDS 3456
#define XB_SPIN_CAP (1u << 22)

__device__ __forceinline__ unsigned xb_ld(unsigned* p)              { return __hip_atomic_load(p, __ATOMIC_RELAXED, __HIP_MEMORY_SCOPE_AGENT); }
__device__ __forceinline__ unsigned xb_add(unsigned* p, unsigned v) { return __hip_atomic_fetch_add(p, v, __ATOMIC_RELAXED, __HIP_MEMORY_SCOPE_AGENT); }
__device__ __forceinline__ unsigned xb_xcc_id() { return (unsigned)__builtin_amdgcn_s_getreg((3 << 11) | 20) & 0xFu; }
#define XB_SPIN(cond, bar) do { unsigned _sp = 0; while (cond) { __builtin_amdgcn_s_sleep(1); \
    if ((++_sp & 255u) == 0u) { if (xb_ld(&(bar)[XB_TMO])) break; if (_sp > XB_SPIN_CAP) { atomicAdd(&(bar)[XB_TMO], 1u); break; } } } } while (0)

struct XcdBarrier {
    unsigned* bar; unsigned x;
    volatile LAS unsigned* st;
};

__device__ __forceinline__ XcdBarrier xcd_barrier_post(unsigned* bar, volatile LAS unsigned* st) {
    XcdBarrier b; b.bar = bar; b.x = xb_xcc_id(); b.st = st;
    if (threadIdx.x == 0) (void)xb_add(&bar[XB_XCNT(b.x)], 1u);
    return b;
}
__device__ __forceinline__ void xcd_barrier_complete(unsigned* bar, unsigned x, unsigned& nloc, unsigned& nx) {
    const unsigned G = gridDim.x * gridDim.y * gridDim.z;
    unsigned sum, cnt, mine, sp = 0u;
    for (;;) {
        sum = 0u; cnt = 0u; mine = 0u;
#pragma unroll
        for (unsigned j = 0; j < 16; ++j) { const unsigned c = xb_ld(&bar[XB_XCNT(j)]); sum += c; cnt += (c > 0u) ? 1u : 0u; mine = (j == x) ? c : mine; }
        if (sum == G) break;
        __builtin_amdgcn_s_sleep(1);
        if ((++sp & 255u) == 0u) { if (xb_ld(&bar[XB_TMO])) break; if (sp > XB_SPIN_CAP) { atomicAdd(&bar[XB_TMO], 1u); break; } }
    }
    nloc = mine > 0u ? mine : 1u; nx = cnt > 0u ? cnt : 1u;
}

__device__ __forceinline__ void xcd_barrier(const XcdBarrier& b) {
    asm volatile("s_waitcnt vmcnt(0)" ::: "memory");
    __syncthreads();
    if (threadIdx.x == 0) {
        unsigned* bar = b.bar;
        __builtin_amdgcn_s_waitcnt(0);
        unsigned nloc = b.st[0], nx = b.st[1];
        if (nloc == 0u) { xcd_barrier_complete(bar, b.x, nloc, nx); b.st[0] = nloc; b.st[1] = nx; }
        const unsigned old = xb_add(&bar[XB_XSUB(b.x)], 1u);
        const unsigned gen = old / nloc;
        if (old + 1u == (gen + 1u) * nloc) {
            __builtin_amdgcn_fence(__ATOMIC_RELEASE, "agent");
            asm volatile("s_waitcnt vmcnt(0)" ::: "memory");
            const unsigned og = xb_add(&bar[XB_TOP], 1u);
            const unsigned tg = og / nx;
            if (og + 1u == (tg + 1u) * nx) xb_add(&bar[XB_TOPGEN], 1u);
            else XB_SPIN(xb_ld(&bar[XB_TOPGEN]) == tg, bar);
            __builtin_amdgcn_fence(__ATOMIC_ACQUIRE, "agent");
            xb_add(&bar[XB_XGEN(b.x)], 1u);
            asm volatile("s_waitcnt vmcnt(0)" ::: "memory");
        } else {
            XB_SPIN(xb_ld(&bar[XB_XGEN(b.x)]) == gen, bar);
            __builtin_amdgcn_fence(__ATOMIC_ACQUIRE, "agent");
            asm volatile("s_waitcnt vmcnt(0)" ::: "memory");
        }
    }
    __syncthreads();
}

namespace pg8 {
#define PG8_LAS __attribute__((address_space(3)))
constexpr int BM = 256, BK = 64, HALF = 128, HTB = HALF * BK * 2  , STAGE_BYTES = 8 * HTB, NXCD = 8, WGM = 8;

__host__ __device__ __forceinline__ int lds_byte(int r, int c) { const int st = (r >> 4) * 2 + (c >> 5), rr = r & 15, cc = c & 31, ob = rr * 64 + cc * 2; return st * 1024 + (ob ^ (((ob >> 9) & 1) << 5)); }
__host__ __device__ __forceinline__ void stage_rc(int b, int& R, int& C) { const int st = b / 1024, sb = b % 1024, swz = sb ^ (((sb >> 9) & 1) << 5); R = (st >> 1) * 16 + swz / 64; C = (st & 1) * 32 + (swz % 64) / 2; }
__host__ __device__ __forceinline__ int perm32(int rho) { const int n = rho >> 4, i = rho & 15; return 8 * (i >> 2) + 4 * n + (i & 3); }

struct Unit { int pm, pn; };
struct Gemm { const bf16_t* A; const bf16_t* Bt; int M, N, K; };

struct StaticOrder {
    int nM, nN, nwg, G, c;
    __host__ __device__ void init(int M, int N, int G_, int c_) { nM = M / BM; nN = N / BM; nwg = nM * nN; G = G_; c = c_; }
    __host__ __device__ bool next(int i, Unit& u) const {
        const long L = (long)i * G + c; if (L >= nwg) return false;
        int wgid = (int)L; { const int q = nwg / NXCD, r = nwg % NXCD, xcd = wgid % NXCD, off = wgid / NXCD; wgid = (xcd < r ? xcd * (q + 1) : r * (q + 1) + (xcd - r) * q) + off; }
        const int nig = WGM * nN, gid = wgid / nig, fm = gid * WGM, gsz = (nM - fm) < WGM ? (nM - fm) : WGM;
        u.pm = fm + ((wgid % nig) % gsz); u.pn = (wgid % nig) / gsz; return true;
    }
    __device__ __forceinline__ void a_ready(const Unit&) const {}
    __device__ __forceinline__ void done(const Unit&) const {}
};
template <class Epi, class Sched, bool STAMP = false>
__device__ __forceinline__ void gemm_phase(PG8_LAS unsigned char* lds, const Gemm g, const Sched& S, const Epi& E, unsigned long long* stamps) {
    const int tid = threadIdx.x, wid = __builtin_amdgcn_readfirstlane(tid >> 6), lane = tid & 63, wr = wid >> 2, wc = wid & 3, fr = lane & 15, fq = lane >> 4;
    const int K = g.K, nt = K / BK;
    int ts_lo = 0, ts_hi = 0, nts = 0; const unsigned long long rt_entry = STAMP ? (unsigned long long)wall_clock64() : 0ull;
#define PG8_STAMP() do { if (STAMP && wid == 0 && nts < 64) { const unsigned long long _c = (unsigned long long)clock64(); \
        ts_lo = (lane == nts) ? (int)(unsigned)_c : ts_lo; ts_hi = (lane == nts) ? (int)(unsigned)(_c >> 32) : ts_hi; ++nts; } } while (0)
    PG8_STAMP();
    unsigned voffA[2], voffB[2];
#pragma unroll
    for (int i = 0; i < 2; ++i) { int R, C; stage_rc(tid * 16 + i * 8192, R, C); const int Rb = Epi::PERM ? ((R & ~31) + perm32(R & 31)) : R;
        voffA[i] = (unsigned)(R * K + C) * 2u; voffB[i] = (unsigned)(Rb * K + C) * 2u; }
    const size_t kstep = (size_t)(BK * 2);
    const size_t hstep = (size_t)HALF * K * 2;
    const size_t tstep = 2 * hstep;
    const unsigned ldsw = (unsigned)wid * 1024u;
    const int aoff = lds_byte(wr * 64 + fr, fq * 8), boff = lds_byte(wc * 32 + fr, fq * 8);
#define PG8_SA(b, h) (((b) * 2 + (h)) * HTB)
#define PG8_SB(b, h) ((4 + (b) * 2 + (h)) * HTB)
#define PG8_STAGE(bufoff, gbase, voff) do { _Pragma("unroll") for (int _i = 0; _i < 2; ++_i) \
        __builtin_amdgcn_global_load_lds((const unsigned*)((const char*)(gbase) + (voff)[_i]), (PG8_LAS unsigned*)(lds + (bufoff) + ldsw + _i * 8192), 16, 0, 0); } while (0)
#define PG8_LDA(dst, b, h) do { _Pragma("unroll") for (int m = 0; m < 4; ++m) _Pragma("unroll") for (int k = 0; k < 2; ++k) dst[m][k] = *(const PG8_LAS bf16x8*)(lds + PG8_SA(b, h) + aoff + m * 2048 + k * 1024); } while (0)
#define PG8_LDB(dst, b, h) do { _Pragma("unroll") for (int n = 0; n < 2; ++n) _Pragma("unroll") for (int k = 0; k < 2; ++k) dst[n][k] = *(const PG8_LAS bf16x8*)(lds + PG8_SB(b, h) + boff + n * 2048 + k * 1024); } while (0)
#define PG8_MMA(ai, bj, At, Bt) do { __builtin_amdgcn_s_setprio(1); _Pragma("unroll") for (int m = 0; m < 4; ++m) _Pragma("unroll") for (int n = 0; n < 2; ++n) _Pragma("unroll") for (int k = 0; k < 2; ++k) \
        acc[ai][bj][m][n] = __builtin_amdgcn_mfma_f32_16x16x32_bf16(Bt[n][k], At[m][k], acc[ai][bj][m][n], 0, 0, 0); __builtin_amdgcn_s_setprio(0); } while (0)
#define PG8_WAIT_V(n) asm volatile("s_waitcnt vmcnt(" #n ")" ::: "memory")
#define PG8_WAIT_L(n) asm volatile("s_waitcnt lgkmcnt(" #n ")" ::: "memory")
#define PG8_BAR __builtin_amdgcn_s_barrier()
#define PG8_SCHED __builtin_amdgcn_sched_barrier(0)
    Unit cur, nxt; int ui = 0;
    if (!S.next(0, cur)) return;
    f32x4 acc[2][2][4][2];
#pragma unroll
    for (int a = 0; a < 2; ++a)
#pragma unroll
        for (int b = 0; b < 2; ++b)
#pragma unroll
            for (int m = 0; m < 4; ++m)
#pragma unroll
                for (int n = 0; n < 2; ++n) acc[a][b][m][n] = (f32x4){0.f, 0.f, 0.f, 0.f};
    bf16x8 At[4][2], B0[2][2], B1[2][2];
    const char* cA = (const char*)g.A + (size_t)cur.pm * tstep; const char* cB = (const char*)g.Bt + (size_t)cur.pn * tstep;
    S.a_ready(cur);
    PG8_STAGE(PG8_SB(0, 0), cB, voffB); PG8_STAGE(PG8_SA(0, 0), cA, voffA); PG8_STAGE(PG8_SB(0, 1), cB + hstep, voffB); PG8_STAGE(PG8_SA(0, 1), cA + hstep, voffA);
    if (wr == 1) PG8_BAR;
    PG8_WAIT_V(4); PG8_BAR;
    PG8_STAGE(PG8_SB(1, 0), cB + kstep, voffB); PG8_STAGE(PG8_SA(1, 0), cA + kstep, voffA); PG8_STAGE(PG8_SB(1, 1), cB + hstep + kstep, voffB);
    PG8_WAIT_V(6); PG8_BAR;
    PG8_STAMP();
    for (;;) {
        const bool has_next = S.next(ui + 1, nxt);
        const char* nA = has_next ? (const char*)g.A + (size_t)nxt.pm * tstep : cA; const char* nB = has_next ? (const char*)g.Bt + (size_t)nxt.pn * tstep : cB;
        for (int t = 0; t < nt; t += 2) {
            const bool last = (t == nt - 2);
            const char* a1 = cA + (size_t)(t + 1) * kstep;
            const char* a2 = last ? nA : cA + (size_t)(t + 2) * kstep; const char* b2 = last ? nB : cB + (size_t)(t + 2) * kstep;
            const char* a3 = a2 + kstep; const char* b3 = b2 + kstep;
            if (last && has_next) S.a_ready(nxt);
            PG8_LDB(B0, 0, 0); PG8_SCHED; PG8_LDA(At, 0, 0); PG8_STAGE(PG8_SA(1, 1), a1 + hstep, voffA);
            PG8_WAIT_L(8); PG8_BAR; PG8_WAIT_L(0); PG8_MMA(0, 0, At, B0); PG8_BAR; PG8_SCHED;
            PG8_LDB(B1, 0, 1); PG8_STAGE(PG8_SB(0, 0), b2, voffB);
            PG8_BAR; PG8_WAIT_L(0); PG8_MMA(0, 1, At, B1); PG8_BAR;
            PG8_LDA(At, 0, 1); PG8_STAGE(PG8_SA(0, 0), a2, voffA);
            PG8_BAR; PG8_WAIT_L(0); PG8_MMA(1, 0, At, B0); PG8_BAR; PG8_SCHED;
            PG8_STAGE(PG8_SB(0, 1), b2 + hstep, voffB);
            PG8_WAIT_V(6); PG8_BAR; PG8_MMA(1, 1, At, B1); PG8_BAR;
            PG8_LDB(B0, 1, 0); PG8_SCHED; PG8_LDA(At, 1, 0); PG8_STAGE(PG8_SA(0, 1), a2 + hstep, voffA);
            PG8_WAIT_L(8); PG8_BAR; PG8_WAIT_L(0); PG8_MMA(0, 0, At, B0); PG8_BAR; PG8_SCHED;
            PG8_LDB(B1, 1, 1); PG8_STAGE(PG8_SB(1, 0), b3, voffB);
            PG8_BAR; PG8_WAIT_L(0); PG8_MMA(0, 1, At, B1); PG8_BAR;
            PG8_LDA(At, 1, 1); PG8_STAGE(PG8_SA(1, 0), a3, voffA);
            PG8_BAR; PG8_WAIT_L(0); PG8_MMA(1, 0, At, B0); PG8_BAR; PG8_SCHED;
            PG8_STAGE(PG8_SB(1, 1), b3 + hstep, voffB);
            PG8_WAIT_V(6); PG8_BAR; PG8_MMA(1, 1, At, B1); PG8_BAR;
        }
        PG8_STAMP();
        if constexpr (!Epi::AFTER_DRAIN) { E(acc, cur, wr, wc, fr, fq); S.done(cur); }
        PG8_STAMP();
        if (!has_next) break;
#pragma unroll
        for (int a = 0; a < 2; ++a)
#pragma unroll
            for (int b = 0; b < 2; ++b)
#pragma unroll
                for (int m = 0; m < 4; ++m)
#pragma unroll
                    for (int n = 0; n < 2; ++n) acc[a][b][m][n] = (f32x4){0.f, 0.f, 0.f, 0.f};
        cur = nxt; cA = nA; cB = nB; ++ui;
    }
    PG8_WAIT_V(0);
    if (wr == 0) PG8_BAR;
    PG8_BAR;
    if constexpr (Epi::AFTER_DRAIN) { E.fused(acc, cur, wr, wc, fr, fq, lds, wid, lane); S.done(cur); }
    PG8_STAMP();
    if (STAMP && wid == 0) { stamps[lane] = lane < nts ? (((unsigned long long)(unsigned)ts_hi << 32) | (unsigned)ts_lo) : 0ull;
        if (lane == 62) stamps[62] = rt_entry; if (lane == 63) stamps[63] = (unsigned long long)wall_clock64(); }
#undef PG8_STAMP
#undef PG8_SA
#undef PG8_SB
#undef PG8_STAGE
#undef PG8_LDA
#undef PG8_LDB
#undef PG8_MMA
#undef PG8_WAIT_V
#undef PG8_WAIT_L
#undef PG8_BAR
#undef PG8_SCHED
}
}
DI f32x4 ld4(const float* p) { return *(const f32x4*)p; }
DI void st4(float* p, f32x4 v) { *(f32x4*)p = v; }
DI void st_bf4(bf16_t* p, f32x4 v) { u32x2 w; w[0] = pack_bf2(v[0], v[1]); w[1] = pack_bf2(v[2], v[3]); *(u32x2*)p = w; }

struct EpiIn {
    static constexpr bool PERM = false, AFTER_DRAIN = false;
    bf16_t *q_bf, *kvs_bf, *kvw_bf, *u_bf; float *out, *gates; const float *g_qnorm, *g_knorm;
    DI void operator()(const f32x4 (&acc)[2][2][4][2], const pg8::Unit& u, int wr, int wc, int fr, int fq) const {
        const int pn = u.pn; const bool isS = u.pm >= 64;
#pragma unroll
        for (int ai = 0; ai < 2; ++ai)
#pragma unroll
            for (int m = 0; m < 4; ++m) {
                const int row = u.pm * 256 + ai * 128 + wr * 64 + m * 16 + fr;
                f32x4 v[2][2];
#pragma unroll
                for (int bj = 0; bj < 2; ++bj)
#pragma unroll
                    for (int n = 0; n < 2; ++n) v[bj][n] = acc[ai][bj][m][n];
                float ss = 0.f;
#pragma unroll
                for (int bj = 0; bj < 2; ++bj)
#pragma unroll
                    for (int n = 0; n < 2; ++n)
#pragma unroll
                        for (int i = 0; i < 4; ++i) ss += v[bj][n][i] * v[bj][n][i];
                ss += __shfl_xor(ss, 16); ss += __shfl_xor(ss, 32);
                const float rstd = __builtin_amdgcn_rsqf(ss * (1.0f / 64.0f) + 1e-6f);
                int sb, st;
                if (isS) { const int sr = row - NP; sb = sr >> 3; st = sr & 7; } else { sb = row >> 11; st = row & 2047; }
                if (pn < 4) {
                    const int head = pn * 4 + wc;
#pragma unroll
                    for (int bj = 0; bj < 2; ++bj)
#pragma unroll
                        for (int n = 0; n < 2; ++n) { const int e0 = 32 * bj + 16 * n + 4 * fq;
                            st_bf4(q_bf + (size_t)row * 1024 + head * 64 + e0, v[bj][n] * (rstd * (0.125f * LOG2E)) * ld4(g_qnorm + e0)); }
                } else if (pn < 10) {
                    const int sec = (pn - 4) >> 1, c = (pn - 4) & 1, g = wc; const bool nrm = (c == 0) && (sec > 0);
#pragma unroll
                    for (int bj = 0; bj < 2; ++bj)
#pragma unroll
                        for (int n = 0; n < 2; ++n) { const int e0 = 32 * bj + 16 * n + 4 * fq; const int cg = c * 256 + g * 64 + e0;
                            f32x4 y = v[bj][n];
                            if (nrm) y = y * rstd * ld4(g_knorm + sec * 64 + e0);
                            if (sec == 0) { st4(out + (isS ? O_CMP_S + (size_t)(row - NP) * 512 : O_CMP_P + (size_t)row * 512) + cg, y); }
                            else if (sec == 1) { st4(out + (isS ? O_SLC_S + (size_t)(row - NP) * 512 : O_SLC_P + (size_t)row * 512) + cg, y);
                                if (!isS) st_bf4(kvs_bf + (size_t)row * 512 + cg, y); }
                            else { if (isS) st4(out + O_WIN_S + ((size_t)sb * 512 + 504 + st) * 512 + cg, y);
                                else { st_bf4(kvw_bf + (size_t)row * 512 + cg, y); if (st >= 1536) st4(out + O_WIN_P + ((size_t)sb * 512 + st - 1536) * 512 + cg, y); } }
                        }
                } else if (pn == 10) {
                    if (wc == 0) {
#pragma unroll
                        for (int bj = 0; bj < 2; ++bj)
#pragma unroll
                            for (int n = 0; n < 2; ++n) { const int e0 = 32 * bj + 16 * n + 4 * fq;
                                if (e0 < 48) { f32x4 y; for (int i = 0; i < 4; ++i) y[i] = fast_rcp(1.0f + fast_exp2(-LOG2E * v[bj][n][i])); st4(gates + (size_t)row * 48 + e0, y); } }
                    }
                } else {
#pragma unroll
                    for (int bj = 0; bj < 2; ++bj)
#pragma unroll
                        for (int n = 0; n < 2; ++n) { const int col = (pn - 11) * 256 + 64 * wc + 32 * bj + 16 * n + 4 * fq;
                            st_bf4(u_bf + (size_t)row * 1024 + col, v[bj][n]);
                            if (isS) st4(out + O_POOL_S + ((size_t)sb * 15 + 7 + st) * 1024 + col, v[bj][n]);
                            else if (st >= 2033) st4(out + O_POOL_P + ((size_t)sb * 15 + st - 2033) * 1024 + col, v[bj][n]); }
                }
            }
    }
};

struct EpiOut {
    static constexpr bool PERM = false, AFTER_DRAIN = false;
    const float *x_prompt, *x_sample, *mod; bf16_t* x1;
    DI void operator()(const f32x4 (&acc)[2][2][4][2], const pg8::Unit& u, int wr, int wc, int fr, int fq) const {
        const int col0 = u.pn * 256 + wc * 32 + 4 * fq;
#pragma unroll
        for (int ai = 0; ai < 2; ++ai)
#pragma unroll
            for (int m = 0; m < 4; ++m) {
                const int row = u.pm * 256 + ai * 128 + wr * 64 + m * 16 + fr;
                const float* xr = row < NP ? x_prompt + (size_t)row * DM : x_sample + (size_t)(row - NP) * DM;
                const int mrow = row < NP ? (row >> 11) : 8 + ((row - NP) >> 3);
                const float* gate = mod + (size_t)mrow * 12288 + 2 * DM;
#pragma unroll
                for (int bj = 0; bj < 2; ++bj)
#pragma unroll
                    for (int n = 0; n < 2; ++n) { const int col = col0 + bj * 128 + n * 16;
                        st_bf4(x1 + (size_t)row * DM + col, ld4(xr + col) + ld4(gate + col) * acc[ai][bj][m][n]); }
            }
    }
};

struct EpiPq {
    static constexpr bool PERM = false, AFTER_DRAIN = false;
    bf16_t* pq;
    DI void operator()(const f32x4 (&acc)[2][2][4][2], const pg8::Unit& u, int wr, int wc, int fr, int fq) const {
        const int col0 = u.pn * 256 + wc * 32 + 4 * fq;
#pragma unroll
        for (int ai = 0; ai < 2; ++ai)
#pragma unroll
            for (int m = 0; m < 4; ++m) {
                const int row = u.pm * 256 + ai * 128 + wr * 64 + m * 16 + fr;
#pragma unroll
                for (int bj = 0; bj < 2; ++bj)
#pragma unroll
                    for (int n = 0; n < 2; ++n) st_bf4(pq + (size_t)row * DM + col0 + bj * 128 + n * 16, acc[ai][bj][m][n]);
            }
    }
};

struct EpiNull {
    static constexpr bool PERM = false, AFTER_DRAIN = false;
    float* sink;
    DI void operator()(const f32x4 (&acc)[2][2][4][2], const pg8::Unit& u, int wr, int wc, int fr, int fq) const {
        float s = 0.f;
#pragma unroll
        for (int ai = 0; ai < 2; ++ai) for (int bj = 0; bj < 2; ++bj) for (int m = 0; m < 4; ++m) for (int n = 0; n < 2; ++n) s += acc[ai][bj][m][n][0] + acc[ai][bj][m][n][3];
        if (s == 12345.678f) sink[threadIdx.x] = s;
    }
};
DI int win_logical(int p) {
    const int pn = p >> 8, pp = p & 255, bj = pp >> 7, wc = (pp >> 5) & 3, r = pp & 31;
    const int lu = 64 * wc + 32 * bj + r;
    if (pn < 10) return 256 * pn + lu;
    if (pn == 10) return lu < 48 ? 2560 + lu : -1;
    return 2608 + 256 * (pn - 11) + lu;
}
template <int KT>
DI void transpose_tile(const float* src, int ldsrc, int k0, int c0, int nvalid, bf16_t* dst, int lddst, int p0, LAS unsigned char* lds) {
    const int tid = threadIdx.x;
    constexpr int TS = 128 * KT + 8;
    LAS bf16_t* T = (LAS bf16_t*)lds;
    f32x4 v[2 * KT];
    const int c4 = (tid & 7) * 4;
#pragma unroll
    for (int i = 0; i < 2 * KT; ++i) {
        const int kk = (tid >> 3) + 64 * i;
        v[i] = (f32x4){0.f, 0.f, 0.f, 0.f};
        if (c0 >= 0 && c4 < nvalid) v[i] = ld4(src + (size_t)(k0 + kk) * ldsrc + c0 + c4);
    }
#pragma unroll
    for (int i = 0; i < 2 * KT; ++i) {
        const int kk = (tid >> 3) + 64 * i;
#pragma unroll
        for (int j = 0; j < 4; ++j) T[(c4 + j) * TS + kk] = (bf16_t)(pack_bf2(v[i][j], 0.f) & 0xffffu);
    }
    __syncthreads();
#pragma unroll
    for (int i = 0; i < KT; ++i) { const int ch = tid + 512 * i, col = ch / (16 * KT), kc = ch % (16 * KT);
      const u32x4 w = *(const LAS u32x4*)(T + col * TS + kc * 8);
      *(u32x4*)(dst + (size_t)(p0 + col) * lddst + k0 + kc * 8) = w; }
    __syncthreads();
}

DI void adaln_item(const Params& p, int slice, LAS unsigned char* lds) {
    const int tid = threadIdx.x, wid = tid >> 6, lane = tid & 63, l31 = lane & 31, hh = lane >> 5, n0 = slice * 96;
    constexpr int RS = 136, ABYTES = 160 * RS * 2, WBYTES = 96 * RS * 2, BUF = ABYTES + WBYTES;
    for (int i = tid; i < 2 * BUF / 16; i += 512) *(LAS u32x4*)(lds + i * 16) = (u32x4){0u, 0u, 0u, 0u};
    const int msub = tid >> 5, k4 = (tid & 31) * 4;
    const float* a0 = (msub < 8 ? p.c_prompt + (size_t)msub * DM : p.c_sample + (size_t)(msub - 8) * DM) + k4;
    const float* aS = p.c_sample + ((long)msub - 8) * DM + k4;
    const float* w0 = p.w_ada + n0;
    f32x4 ra[9], rw0[6], rw1[6];
#define ADA_ISSUE_A(KT) { ra[0] = ld4(a0 + (KT) * 128); _Pragma("unroll") for (int j = 1; j < 9; ++j) { ra[j] = (f32x4){0.f, 0.f, 0.f, 0.f}; if (j < 8 || msub < 8) ra[j] = ld4(aS + (size_t)j * 16 * DM + (KT) * 128); } }
#define ADA_ISSUE_W(RW, KT) { _Pragma("unroll") for (int j = 0; j < 3; ++j) { const int idx_ = tid + 512 * j, kp_ = idx_ / 24, c4_ = (idx_ % 24) * 4; \
        const float* wp_ = w0 + ((size_t)(KT) * 128 + 2 * kp_) * 12288 + c4_; RW[2 * j] = ld4(wp_); RW[2 * j + 1] = ld4(wp_ + 12288); } }
#define ADA_STASH(RW, BUFI) { LAS bf16_t* A_ = (LAS bf16_t*)(lds + (BUFI) * BUF); LAS bf16_t* W_ = (LAS bf16_t*)(lds + (BUFI) * BUF + ABYTES); \
        _Pragma("unroll") for (int j = 0; j < 9; ++j) { if (j < 8 || msub < 8) { f32x4 v = ra[j]; for (int i = 0; i < 4; ++i) v[i] = v[i] * fast_rcp(1.0f + fast_exp2(-LOG2E * v[i])); \
            u32x2 w_; w_[0] = pack_bf2(v[0], v[1]); w_[1] = pack_bf2(v[2], v[3]); *(LAS u32x2*)(A_ + (msub + 16 * j) * RS + k4) = w_; } } \
        _Pragma("unroll") for (int j = 0; j < 3; ++j) { const int idx_ = tid + 512 * j, kp_ = idx_ / 24, c4_ = (idx_ % 24) * 4; \
            _Pragma("unroll") for (int i = 0; i < 4; ++i) *(LAS unsigned*)(W_ + (c4_ + i) * RS + 2 * kp_) = pack_bf2(RW[2 * j][i], RW[2 * j + 1][i]); } }
    f32x16 acc[2]; acc[0] = zero16(); acc[1] = zero16();
    const int t0 = wid, t1 = wid + 8;
    ADA_ISSUE_A(0) ADA_ISSUE_W(rw0, 0) ADA_ISSUE_W(rw1, 1)
    __syncthreads();
#define ADA_COMPUTE(BUFI) { LAS const bf16_t* A = (LAS const bf16_t*)(lds + (BUFI) * BUF); LAS const bf16_t* W = (LAS const bf16_t*)(lds + (BUFI) * BUF + ABYTES); \
        _Pragma("unroll") for (int ks = 0; ks < 8; ++ks) { \
            { const bf16x8 a = *(LAS const bf16x8*)(A + ((t0 % 5) * 32 + l31) * RS + 16 * ks + 8 * hh); const bf16x8 w = *(LAS const bf16x8*)(W + ((t0 / 5) * 32 + l31) * RS + 16 * ks + 8 * hh); acc[0] = MFMA32(a, w, acc[0]); } \
            if (t1 < 15) { const bf16x8 a = *(LAS const bf16x8*)(A + ((t1 % 5) * 32 + l31) * RS + 16 * ks + 8 * hh); const bf16x8 w = *(LAS const bf16x8*)(W + ((t1 / 5) * 32 + l31) * RS + 16 * ks + 8 * hh); acc[1] = MFMA32(a, w, acc[1]); } } }
#pragma unroll 1
    for (int kt = 0; kt < 16; kt += 2) {
        ADA_STASH(rw0, 0)
        __syncthreads();
        ADA_ISSUE_A(kt + 1)
        if (kt + 2 < 16) ADA_ISSUE_W(rw0, kt + 2)
        ADA_COMPUTE(0)
        ADA_STASH(rw1, 1)
        __syncthreads();
        if (kt + 2 < 16) ADA_ISSUE_A(kt + 2)
        if (kt + 3 < 16) ADA_ISSUE_W(rw1, kt + 3)
        ADA_COMPUTE(1)
    }
#undef ADA_COMPUTE
#undef ADA_ISSUE_A
#undef ADA_ISSUE_W
#undef ADA_STASH
    float* mod = (float*)(p.ws + WS_MOD);
    int hh_ = hh, l31_ = l31; asm volatile("" : "+v"(hh_), "+v"(l31_));
#pragma unroll
    for (int q = 0; q < 2; ++q) { const int t = q ? t1 : t0; if (t < 15) { const int n = (t / 5) * 32 + l31_;
        if (n < 96) { const float bias = p.b_ada[n0 + n];
#pragma unroll
            for (int i = 0; i < 16; ++i) { const int m = (t % 5) * 32 + crow(i, hh_); if (m < 136) mod[(size_t)m * 12288 + n0 + n] = acc[q][i] + bias; } } } }
    __syncthreads();
}

DI void phase_A(const Params& p, LAS unsigned char* lds) {
    bf16_t* win_t = (bf16_t*)(p.ws + WS_WIN_T); bf16_t* wout_t = (bf16_t*)(p.ws + WS_WOUT_T); bf16_t* wq_t = (bf16_t*)(p.ws + WS_WQ_T);
    bf16_t* wcmp_t = (bf16_t*)(p.ws + WS_WCMP_T); bf16_t* wpool_t = (bf16_t*)(p.ws + WS_WPOOL_T);
    constexpr int T_ADA = 128, T_IN = 4 * 120, T_OUT = 4 * 64, T_Q = 0  , T_POOL = 4 * 8, T_CMP = 8 * 2 * 2 * 2, T_MISC = 8 + 112;
    constexpr int E0 = T_IN, E1 = E0 + T_OUT, E2 = E1 + T_Q, E3 = E2, E4 = E3 + T_POOL, E5 = E4 + T_CMP, E6 = E5 + T_MISC;
    const int tid = threadIdx.x;
    const int gh = (int)gridDim.x >> 1;
    if ((int)blockIdx.x < gh) {
#pragma unroll 1
        for (int sl = blockIdx.x; sl < T_ADA; sl += gh) adaln_item(p, sl, lds);
        return;
    }
#pragma unroll 1
    for (int it = (int)blockIdx.x - gh; it < E6; it += (int)gridDim.x - gh) {
        if (it < E0) { const int kt = it & 3, pt = it >> 2; const int p0 = pt * 32; const int c0 = win_logical(p0);
            int nv = 32; if (c0 >= 0 && win_logical(p0 + 31) < 0) nv = 16;
            transpose_tile<4>(p.w_in, 3632, kt * 512, c0, nv, win_t, DM, p0, lds); }
        else if (it < E1) { const int j = it - E0, kt = j & 3, pt = j >> 2; transpose_tile<4>(p.w_out, DM, kt * 512, pt * 32, 32, wout_t, DM, pt * 32, lds); }
        else if (it < E2) { const int j = it - E1, kt = j & 3, pt = j >> 2; transpose_tile<4>(p.peer_wq, DM, kt * 512, pt * 32, 32, wq_t, DM, pt * 32, lds); }
        else if (it < E4) { const int j = it - E3, gi = j >> 3, pt = j & 7;
            transpose_tile<2>(p.w_pool + (size_t)gi * 65536, 256, 0, pt * 32, 32, wpool_t + (size_t)gi * 65536, 256, pt * 32, lds); }
        else if (it < E5) { const int j = it - E4, cg = j >> 3, lohi = (j >> 2) & 1, kt = (j >> 1) & 1, pt = j & 1;
            transpose_tile<4>(p.w_cmp + ((size_t)cg * 32 + lohi * 16) * 4096, 64, kt * 512, pt * 32, 32, wcmp_t + (size_t)cg * 131072, 1024, lohi * 64 + pt * 32, lds); }
        else {
            const int j = it - E5;
            if (j < 8) {
                const int cg = j, e = tid & 63, part = tid >> 6, c = cg >> 2, g = cg & 3; float s = 0.f;
                for (int l = 4 * part; l < 4 * part + 4; ++l)
#pragma unroll 8
                    for (int d = 0; d < 64; ++d) s += p.cmp_pe[((c * 32 + l) * 4 + g) * 64 + d] * p.w_cmp[(((size_t)cg * 32 + l) * 64 + d) * 64 + e];
                LAS float* red = (LAS float*)lds; red[tid] = s;
                __syncthreads();
                if (tid < 64) { float t = 0.f; for (int q = 0; q < 8; ++q) t += red[q * 64 + tid]; ((float*)(p.ws + WS_PEBIAS))[cg * 64 + tid] = t; }
                __syncthreads();
            } else {
                const int q = j - 8;
                for (int i = 0; i < 4; ++i) { const size_t f = (size_t)q * 8192 + (size_t)(i * 512 + tid) * 4; const size_t b = f / 7168, rem = f % 7168;
                    st4(p.out + O_POOL_S + b * 15360 + rem, ld4(p.state_pool + b * 15360 + 8 * 1024 + rem)); }
            }
        }
    }
}

DI void transpose_wq(const Params& p, int first_blk, LAS unsigned char* lds) {
    bf16_t* wq_t = (bf16_t*)(p.ws + WS_WQ_T);
#pragma unroll 1
    for (int j = (int)blockIdx.x - first_blk; j < 4 * 64; j += (int)gridDim.x - first_blk) { const int kt = j & 3, pt = j >> 2; transpose_tile<4>(p.peer_wq, DM, kt * 512, pt * 32, 32, wq_t, DM, pt * 32, lds); }
}

DI void phase_B_stream(const Params& p, int first_blk, int part, LAS unsigned char* lds) {
    const int tid = threadIdx.x, wid = tid >> 6, lane = tid & 63;
    const int nw = (gridDim.x - first_blk) * 8, wi = (blockIdx.x - first_blk) * 8 + wid;
    constexpr int C_U = 16384, C_V = 16384, C_SK = 128, C_WIN = 128 * 126, C_END = C_U + C_V + C_SK + C_WIN;
    unsigned char* u4 = p.ws + WS_U; unsigned char* v4 = p.ws + WS_V; bf16_t* sk = (bf16_t*)(p.ws + WS_SUBK);
    unsigned char* su = p.ws + WS_USCALE; unsigned char* sv = p.ws + WS_VSCALE;
    LAS f32x4* T = (LAS f32x4*)(lds + wid * 8192);
    const int nitems = part == 0 ? C_U + C_SK + C_WIN / 2 : C_V + C_WIN / 2;
    for (int it = wi; it < nitems; it += nw) {
        int c;
        if (part == 0) c = it < C_U ? it : (it < C_U + C_SK ? C_U + C_V + (it - C_U) : C_U + C_V + C_SK + (it - C_U - C_SK));
        else c = it < C_V ? C_U + it : C_U + C_V + C_SK + C_WIN / 2 + (it - C_V);
        if (c < C_U + C_V) {
            const bool isV = c >= C_U; const int r = isV ? c - C_U : c;
            const float* src = (isV ? p.peer_v : p.peer_u) + (size_t)r * 2048;
            f32x4 v[8];
#pragma unroll
            for (int j = 0; j < 8; ++j) v[j] = __builtin_nontemporal_load((const f32x4*)(src + j * 256 + lane * 4));
#pragma unroll
            for (int j = 0; j < 8; ++j) T[j * 64 + lane] = v[j];
            asm volatile("s_waitcnt lgkmcnt(0)" ::: "memory");
#pragma unroll
            for (int q = 0; q < 8; ++q) v[q] = T[8 * lane + q];
            asm volatile("s_waitcnt lgkmcnt(0)" ::: "memory");
            float am = 0.f, ss = 0.f;
#pragma unroll
            for (int j = 0; j < 8; ++j) for (int i = 0; i < 4; ++i) { am = fmaxf(am, fabsf(v[j][i])); ss += v[j][i] * v[j][i]; }
#pragma unroll
            for (int o = 32; o >= 1; o >>= 1) { am = fmaxf(am, __shfl_xor(am, o)); ss += __shfl_xor(ss, o); }
            const float scale = fmaxf(fmaxf(0.5f * __builtin_sqrtf(ss * (1.0f / 2048.0f)), am * 0.125f), 1.0e-30f), inv = 1.0f / scale;
#pragma unroll
            for (int j = 0; j < 8; ++j) for (int i = 0; i < 4; ++i) v[j][i] = fminf(fmaxf(v[j][i] * inv, -6.0f), 6.0f);
            u32x4 w;
#pragma unroll
            for (int j = 0; j < 4; ++j) { unsigned d = 0u; const f32x4 a = v[2 * j], c2 = v[2 * j + 1];
                d = __builtin_amdgcn_cvt_scalef32_pk_fp4_f32(d, a[0], a[1], 1.0f, 0); d = __builtin_amdgcn_cvt_scalef32_pk_fp4_f32(d, a[2], a[3], 1.0f, 1);
                d = __builtin_amdgcn_cvt_scalef32_pk_fp4_f32(d, c2[0], c2[1], 1.0f, 2); d = __builtin_amdgcn_cvt_scalef32_pk_fp4_f32(d, c2[2], c2[3], 1.0f, 3);
                w[j] = d; }
            *(u32x4*)((isV ? v4 : u4) + (size_t)r * 1024 + lane * 16) = w;
            if (lane == 0) ((float*)(isV ? sv : su))[r] = scale;
        } else if (c < C_U + C_V + C_SK) { const int r = c - C_U - C_V;
#pragma unroll
            for (int j = 0; j < 8; ++j) st_bf4(sk + (size_t)r * 2048 + j * 256 + lane * 4, ld4(p.peer_subkeys + (size_t)r * 2048 + j * 256 + lane * 4));
        } else { const int r = c - C_U - C_V - C_SK, b = r / 126, q = r % 126;
            const float* src = p.cache_win + (size_t)b * 262144 + 4096 + (size_t)q * 2048; float* dst = p.out + O_WIN_S + (size_t)b * 262144 + (size_t)q * 2048;
            f32x4 v[8];
#pragma unroll
            for (int j = 0; j < 8; ++j) v[j] = __builtin_nontemporal_load((const f32x4*)(src + j * 256 + lane * 4));
#pragma unroll
            for (int j = 0; j < 8; ++j) __builtin_nontemporal_store(v[j], (f32x4*)(dst + j * 256 + lane * 4)); }
    }
}

DI void phase_modulate(const Params& p, int which) {
    const int tid = threadIdx.x, wid = tid >> 6, lane = tid & 63;
    const float* mod = (const float*)(p.ws + WS_MOD); bf16_t* h = (bf16_t*)(p.ws + WS_H);
    const float* gn = which ? p.g_norm2 : p.g_norm1;
    for (int row = wid * gridDim.x + blockIdx.x; row < NTOK; row += gridDim.x * 8) {
        const float* src = row < NP ? p.x_prompt + (size_t)row * DM : p.x_sample + (size_t)(row - NP) * DM;
        const bf16_t* srcb = (const bf16_t*)(p.ws + WS_X1) + (size_t)row * DM;
        const int mrow = row < NP ? (row >> 11) : 8 + ((row - NP) >> 3);
        const float* shift = mod + (size_t)mrow * 12288 + (which ? 3 : 0) * DM; const float* scale = shift + DM;
        f32x4 v[8]; float ss = 0.f;
        if (which) {
#pragma unroll
            for (int j = 0; j < 4; ++j) { const u32x4 q = __builtin_nontemporal_load((const u32x4*)(srcb + j * 512 + lane * 8));
                v[2 * j] = (f32x4){bf_lo(q[0]), bf_hi(q[0]), bf_lo(q[1]), bf_hi(q[1])}; v[2 * j + 1] = (f32x4){bf_lo(q[2]), bf_hi(q[2]), bf_lo(q[3]), bf_hi(q[3])}; } }
        else {
#pragma unroll
            for (int j = 0; j < 4; ++j) { v[2 * j] = __builtin_nontemporal_load((const f32x4*)(src + j * 512 + lane * 8)); v[2 * j + 1] = __builtin_nontemporal_load((const f32x4*)(src + j * 512 + lane * 8 + 4)); } }
#pragma unroll
        for (int j = 0; j < 8; ++j) for (int i = 0; i < 4; ++i) ss += v[j][i] * v[j][i];
#pragma unroll
        for (int o = 32; o >= 1; o >>= 1) ss += __shfl_xor(ss, o);
        const float rstd = __builtin_amdgcn_rsqf(ss * (1.0f / 2048.0f) + 1e-6f);
#pragma unroll
        for (int j = 0; j < 4; ++j) {
            const int c = j * 512 + lane * 8;
            f32x4 a = v[2 * j] * rstd * ld4(gn + c) * (ld4(scale + c) + 1.0f) + ld4(shift + c);
            f32x4 b = v[2 * j + 1] * rstd * ld4(gn + c + 4) * (ld4(scale + c + 4) + 1.0f) + ld4(shift + c + 4);
            u32x4 w; w[0] = pack_bf2(a[0], a[1]); w[1] = pack_bf2(a[2], a[3]); w[2] = pack_bf2(b[0], b[1]); w[3] = pack_bf2(b[2], b[3]);
            *(u32x4*)(h + (size_t)row * DM + c) = w;
        }
    }
}
DI void cmp_unit(const Params& p, int unit, LAS unsigned char* lds) {
    const int tid = threadIdx.x, wid = tid >> 6, lane = tid & 63, l31 = lane & 31, hh = lane >> 5;
    const bool isP = unit >= 2048;
    const int u = isP ? unit - 2048 : unit, b = u >> 4, mh = (u >> 3) & 1, cg = u & 7;
    constexpr int RS = 136;
    constexpr int ABYTES = 64 * RS * 2, WBYTES = 128 * RS * 2, BUF = ABYTES + WBYTES;
    const int d4 = tid & 15, lsl = (tid >> 4) & 1, ch0 = tid >> 5;
    const float* abase[4];
#pragma unroll
    for (int j = 0; j < 4; ++j) {
        const int ch = ch0 + 16 * j, chg = mh * 64 + ch;
        if (isP) abase[j] = p.out + O_CMP_P + ((size_t)b * 2048 + chg * 16 + lsl) * 512 + cg * 64 + d4 * 4;
        else { const int page = p.page_table[b * 16 + (chg >> 3)]; abase[j] = p.cache_cmp + ((size_t)page * 128 + (chg & 7) * 16 + lsl) * 512 + cg * 64 + d4 * 4; }
    }
    const bf16_t* wbase = (const bf16_t*)(p.ws + WS_WCMP_T) + ((size_t)cg * 128 + (tid >> 4)) * 1024 + (tid & 15) * 8;
    f32x4 ra0[4], ra1[4]; u32x4 rw0[4], rw1[4];
#define CMP_ISSUE(RA, RW, S) { _Pragma("unroll") for (int j = 0; j < 4; ++j) { RA[j] = __builtin_nontemporal_load((const f32x4*)(abase[j] + (size_t)(S) * 1024)); RW[j] = *(const u32x4*)(wbase + (size_t)j * 32 * 1024 + (S) * 128); } }
#define CMP_STASH(RA, RW, BUFI) { LAS unsigned char* A_ = lds + (BUFI) * BUF; LAS unsigned char* W_ = A_ + ABYTES; _Pragma("unroll") for (int j = 0; j < 4; ++j) { \
            u32x2 w_; w_[0] = pack_bf2(RA[j][0], RA[j][1]); w_[1] = pack_bf2(RA[j][2], RA[j][3]); \
            *(LAS u32x2*)(A_ + ((ch0 + 16 * j) * RS + lsl * 64 + d4 * 4) * 2) = w_; \
            *(LAS u32x4*)(W_ + (((tid >> 4) + 32 * j) * RS + (tid & 15) * 8) * 2) = RW[j]; } }
    const int mt = wid >> 2, nt = wid & 3;
    f32x16 acc = zero16();
    CMP_ISSUE(ra0, rw0, 0) CMP_ISSUE(ra1, rw1, 1)
#pragma unroll
    for (int s = 0; s < 8; ++s) {
        if (s & 1) CMP_STASH(ra1, rw1, 1) else CMP_STASH(ra0, rw0, 0)
        __syncthreads();
        if (s + 2 < 8) { if (s & 1) CMP_ISSUE(ra1, rw1, s + 2) else CMP_ISSUE(ra0, rw0, s + 2) }
        __builtin_amdgcn_sched_barrier(0);
        LAS const unsigned char* A = lds + (s & 1) * BUF; LAS const unsigned char* W = A + ABYTES;
        LAS const unsigned char* ar = A + ((mt * 32 + l31) * RS + 8 * hh) * 2; LAS const unsigned char* wr = W + ((nt * 32 + l31) * RS + 8 * hh) * 2;
#pragma unroll
        for (int ks = 0; ks < 8; ++ks) { const bf16x8 a = *(LAS const bf16x8*)(ar + ks * 32); const bf16x8 w = *(LAS const bf16x8*)(wr + ks * 32); acc = MFMA32(a, w, acc); }
        __builtin_amdgcn_sched_barrier(0);
    }
#undef CMP_ISSUE
#undef CMP_STASH
    bf16_t* part = (bf16_t*)(p.ws + (isP ? WS_PART_P : WS_PART_S));
#pragma unroll
    for (int i = 0; i < 16; ++i) {
        const int chg = mh * 64 + mt * 32 + crow(i, hh);
        const float nb = __shfl_xor(acc[i], 1);
        if (!(lane & 1)) *(unsigned*)(part + (((size_t)b * 128 + chg) * 8 + cg) * 128 + nt * 32 + l31) = pack_bf2(acc[i], nb);
    }
    __syncthreads();
}

DI void pool_unit(const Params& p, int unit, LAS unsigned char* lds) {
    const int tid = threadIdx.x, wid = tid >> 6, lane = tid & 63;
    const int tile = unit >> 2, gi = unit & 3, w = 2 << gi;
    const int row0 = tile * 128; const bool isS = row0 >= NP;
    const bf16_t* ubf = (const bf16_t*)(p.ws + WS_UBF);
    constexpr int AST = 264;
    LAS bf16_t* A = (LAS bf16_t*)lds;
    LAS bf16_t* E = (LAS bf16_t*)(lds + 128 * AST * 2);
    const bf16_t* wg = (const bf16_t*)(p.ws + WS_WPOOL_T) + (size_t)gi * 65536;
    u32x4 wr[8], wr1[8];
#define POOL_ISSUE_W { _Pragma("unroll") for (int j = 0; j < 8; ++j) { const int ch = tid + 512 * j, n = ch >> 4, k8 = (ch & 15) * 8; wr[j] = *(const u32x4*)(wg + (size_t)n * 256 + k8); wr1[j] = *(const u32x4*)(wg + (size_t)n * 256 + 128 + k8); } }
    if (!isS) {
        const int t0 = row0 & 2047;
        u32x4 q[9];
#pragma unroll
        for (int i = 0; i < 9; ++i) { const int idx = tid + 512 * i, r = idx >> 5, c8 = (idx & 31) * 8;
            q[i] = (u32x4){0u, 0u, 0u, 0u};
            if (idx < 143 * 32 && t0 - 15 + r >= 0) q[i] = *(const u32x4*)(ubf + (size_t)(row0 - 15 + r) * 1024 + gi * 256 + c8); }
        asm volatile("" ::: "memory");
        POOL_ISSUE_W
#pragma unroll
        for (int i = 0; i < 9; ++i) { const int idx = tid + 512 * i, r = idx >> 5, c8 = (idx & 31) * 8;
            if (idx < 143 * 32) *(LAS u32x4*)(E + r * AST + c8) = q[i]; }
        __syncthreads();
#pragma unroll 1
        for (int it = tid; it < 128 * 32; it += 512) {
            const int r = it >> 5, c8 = (it & 31) * 8, t = t0 + r;
            float sum[8]; for (int i = 0; i < 8; ++i) sum[i] = 0.f;
#pragma unroll 4
            for (int j = 0; j < w; ++j) { const u32x4 q = *(LAS const u32x4*)(E + (r + 15 - j) * AST + c8);
                for (int i = 0; i < 4; ++i) { sum[2 * i] += bf_lo(q[i]); sum[2 * i + 1] += bf_hi(q[i]); } }
            const u32x4 qs = *(LAS const u32x4*)(E + (r + 15) * AST + c8);
            const float inv = 1.0f / (float)(t + 1 < w ? t + 1 : w);
            u32x4 o;
            for (int i = 0; i < 4; ++i) o[i] = pack_bf2(sum[2 * i] * inv - bf_lo(qs[i]), sum[2 * i + 1] * inv - bf_hi(qs[i]));
            *(LAS u32x4*)(A + r * AST + c8) = o;
        }
    } else {
        POOL_ISSUE_W
#pragma unroll 1
        for (int it = tid; it < 128 * 32; it += 512) {
            const int r = it >> 5, c8 = (it & 31) * 8, row = row0 + r, col = gi * 256 + c8;
            const int bb = (row - NP) >> 3, t = (row - NP) & 7;
            float sum[8], self[8]; for (int i = 0; i < 8; ++i) { sum[i] = 0.f; self[i] = 0.f; }
#pragma unroll 4
            for (int j = 0; j < w; ++j) {
                const int tt = t - j; float x[8];
                if (tt >= 0) { const u32x4 q = *(const u32x4*)(ubf + (size_t)(row - j) * 1024 + col);
                    for (int i = 0; i < 4; ++i) { x[2 * i] = bf_lo(q[i]); x[2 * i + 1] = bf_hi(q[i]); } }
                else { const float* sp = p.state_pool + ((size_t)bb * 15 + 15 + tt) * 1024 + col; const f32x4 a = ld4(sp), c = ld4(sp + 4);
                    for (int i = 0; i < 4; ++i) { x[i] = a[i]; x[4 + i] = c[i]; } }
                for (int i = 0; i < 8; ++i) sum[i] += x[i];
                if (j == 0) for (int i = 0; i < 8; ++i) self[i] = x[i];
            }
            const float inv = 1.0f / (float)w;
            u32x4 o;
            for (int i = 0; i < 4; ++i) o[i] = pack_bf2(sum[2 * i] * inv - self[2 * i], sum[2 * i + 1] * inv - self[2 * i + 1]);
            *(LAS u32x4*)(A + r * AST + c8) = o;
        }
    }
#undef POOL_ISSUE_W
    __syncthreads();
    const int wm = wid >> 1, wn = wid & 1, l31 = lane & 31, hh = lane >> 5;
    LAS bf16_t* WL = (LAS bf16_t*)(lds + 128 * AST * 2);
    LAS const bf16_t* arow = A + (wm * 32 + l31) * AST + 8 * hh;
    f32x16 acc[4]; for (int i = 0; i < 4; ++i) acc[i] = zero16();
#pragma unroll
    for (int half = 0; half < 2; ++half) {
        if (half) __syncthreads();
#pragma unroll
        for (int j = 0; j < 8; ++j) { const int ch = tid + 512 * j, n = ch >> 4, k8 = (ch & 15) * 8; *(LAS u32x4*)(WL + n * 136 + k8) = wr[j]; }
        __syncthreads();
        if (half == 0) {
#pragma unroll
            for (int j = 0; j < 8; ++j) wr[j] = wr1[j]; }
#pragma unroll
        for (int s = 0; s < 8; ++s) {
            const bf16x8 a = *(LAS const bf16x8*)(arow + (half * 8 + s) * 16);
#pragma unroll
            for (int nt = 0; nt < 4; ++nt) { const bf16x8 wv = *(LAS const bf16x8*)(WL + (wn * 128 + nt * 32 + l31) * 136 + s * 16 + 8 * hh); acc[nt] = MFMA32(wv, a, acc[nt]); }
        }
    }
    __syncthreads();
    LAS bf16_t* O = (LAS bf16_t*)lds;
#pragma unroll
    for (int nt = 0; nt < 4; ++nt)
#pragma unroll
        for (int gq = 0; gq < 4; ++gq) {
            const int nl = wn * 128 + nt * 32 + 8 * gq + 4 * hh;
            const f32x4 ps = ld4(p.pool_scale + gi * 256 + nl);
            u32x2 w; w[0] = pack_bf2(acc[nt][4 * gq] * ps[0], acc[nt][4 * gq + 1] * ps[1]); w[1] = pack_bf2(acc[nt][4 * gq + 2] * ps[2], acc[nt][4 * gq + 3] * ps[3]);
            *(LAS u32x2*)(O + (wm * 32 + l31) * AST + nl) = w;
        }
    __syncthreads();
    bf16_t* ocat = (bf16_t*)(p.ws + WS_OCAT);
#pragma unroll
    for (int j = 0; j < 8; ++j) { const int ch = tid + 512 * j, r = ch >> 5, c8 = (ch & 31) * 8;
        *(u32x4*)(ocat + (size_t)(row0 + r) * DM + 1024 + gi * 256 + c8) = *(LAS const u32x4*)(O + r * AST + c8); }
    __syncthreads();
}
struct AttnSt { float m, l; f32x16 o0, o1; };
DI void attn_init(AttnSt& s) { s.m = NEGBIG; s.l = 0.f; s.o0 = zero16(); s.o1 = zero16(); }
constexpr int KST = 72, VST = 68, CVST = 136;
constexpr int KVBUF = 64 * KST * 2 + 64 * VST * 2;

DI float xhalf_max(float v) { return fmaxf(v, __shfl_xor(v, 32)); }
DI float xhalf_sum(float v) { return v + __shfl_xor(v, 32); }

template <int MODE, bool FULL = false>
DI void attn_tile64(LAS const bf16_t* Kb, LAS const bf16_t* Vt, const bf16x8 (&qf)[4], int rel, float slope2, bool allow, int lane, AttnSt& st) {
    const int l31 = lane & 31, hh = lane >> 5;
    const int relh = rel - 4 * hh;
    float sl = slope2; asm volatile("" : "+v"(sl));
    const float base = allow ? -sl * (float)relh : NEGBIG;
    const f32x2 bA = {0.f, sl}, bB = {2.0f * sl, 3.0f * sl};
    f32x16 sacc[2];
#pragma unroll
    for (int kt = 0; kt < 2; ++kt) {
#pragma unroll
        for (int q4 = 0; q4 < 4; ++q4) {
            const float gb = __builtin_fmaf(sl, (float)(32 * kt + 8 * q4), base);
            const f32x2 g2 = {gb, gb}, lo2 = g2 + bA, hi2 = g2 + bB;
            sacc[kt][4 * q4] = lo2[0]; sacc[kt][4 * q4 + 1] = lo2[1]; sacc[kt][4 * q4 + 2] = hi2[0]; sacc[kt][4 * q4 + 3] = hi2[1];
        }
#pragma unroll
        for (int s = 0; s < 4; ++s) { const bf16x8 a = *(LAS const bf16x8*)(Kb + (32 * kt + l31) * KST + 16 * s + 8 * hh); sacc[kt] = MFMA32(a, qf[s], sacc[kt]); } }
    float mx = NEGBIG;
#pragma unroll
    for (int kt = 0; kt < 2; ++kt)
#pragma unroll
        for (int i = 0; i < 16; ++i) {
            if (!FULL) { const int ci = 32 * kt + (i & 3) + 8 * (i >> 2); bool valid = (ci <= relh); if (MODE == 1) valid = valid && (relh - ci <= 512); sacc[kt][i] = valid ? sacc[kt][i] : NEGBIG; }
            mx = fmaxf(mx, sacc[kt][i]);
        }
    mx = xhalf_max(mx);
    const float m_new = fmaxf(fmaxf(st.m, mx), -1.0e20f);
    const float alpha = fast_exp2(st.m - m_new);
    const f32x2 mneg = {-m_new, -m_new};
    f32x2 rs2 = {0.f, 0.f};
    if (!__all(alpha == 1.0f)) { st.o0 *= alpha; st.o1 *= alpha; }
#pragma unroll
    for (int kt = 0; kt < 2; ++kt) {
#pragma unroll
        for (int i = 0; i < 8; ++i) { f32x2 d = {sacc[kt][2 * i], sacc[kt][2 * i + 1]}; d += mneg; d[0] = fast_exp2(d[0]); d[1] = fast_exp2(d[1]);
            sacc[kt][2 * i] = d[0]; sacc[kt][2 * i + 1] = d[1]; rs2 += d; }
#pragma unroll
        for (int s2 = 0; s2 < 2; ++s2) {
            const bf16x8 pf = pack_step(sacc[kt], s2);
            const int kb = 32 * kt + 16 * s2 + 4 * hh;
#pragma unroll
            for (int dt = 0; dt < 2; ++dt) {
                LAS const bf16_t* vp = Vt + (32 * dt + l31) * VST + kb;
                const s16x4 lo = *(LAS const s16x4*)vp, hi = *(LAS const s16x4*)(vp + 8);
                const bf16x8 vf = __builtin_shufflevector(lo, hi, 0, 1, 2, 3, 4, 5, 6, 7);
                if (dt == 0) st.o0 = MFMA32(vf, pf, st.o0); else st.o1 = MFMA32(vf, pf, st.o1);
            }
        }
        if (kt == 0) __builtin_amdgcn_sched_barrier(0);
    }
    float rs = rs2[0] + rs2[1];
    rs = xhalf_sum(rs);
    st.l = st.l * alpha + rs; st.m = m_new;
}

DI void attn_cmp(LAS const bf16_t* Kc, LAS const bf16_t* Vct, const bf16x8 (&qf)[4], int t, float slope2, int ntile, int lane, f32x16& oc0, f32x16& oc1, float (&imp)[16]) {
    const int l31 = lane & 31, hh = lane >> 5;
    const float c1 = 1.0f;
    int nmax = (t - 31) >> 4; nmax = nmax > 126 ? 126 : nmax;
    const int nmaxh = nmax - 4 * hh;
    const float base = -slope2 * (float)(t - 31 - 64 * hh), s16 = slope2 * 16.0f;
    float mx = NEGBIG;
#pragma unroll
    for (int kt = 0; kt < 4; ++kt) {
        if (kt < ntile) {
            f32x16 sacc = zero16();
#pragma unroll
            for (int s = 0; s < 4; ++s) { const bf16x8 a = *(LAS const bf16x8*)(Kc + (32 * kt + l31) * KST + 16 * s + 8 * hh); sacc = MFMA32(a, qf[s], sacc); }
#pragma unroll
            for (int i = 0; i < 16; ++i) {
                const int ci = 32 * kt + (i & 3) + 8 * (i >> 2);
                const float sc = __builtin_fmaf(sacc[i], c1, __builtin_fmaf(s16, (float)ci, base));
                mx = fmaxf(mx, (ci <= nmaxh) ? sc : NEGBIG);
            }
        }
    }
    mx = fmaxf(xhalf_max(mx), -1.0e20f);
    float sum = 0.f, prevc = 0.f;
    oc0 = zero16(); oc1 = zero16();
#pragma unroll
    for (int j = 0; j < 16; ++j) imp[j] = 0.f;
#pragma unroll
    for (int kt = 0; kt < 4; ++kt) {
        if (kt < ntile) {
            f32x16 sacc = zero16();
#pragma unroll
            for (int s = 0; s < 4; ++s) { const bf16x8 a = *(LAS const bf16x8*)(Kc + (32 * kt + l31) * KST + 16 * s + 8 * hh); sacc = MFMA32(a, qf[s], sacc); }
#pragma unroll
            for (int i = 0; i < 16; ++i) {
                const int ci = 32 * kt + (i & 3) + 8 * (i >> 2);
                float sc = __builtin_fmaf(sacc[i], c1, __builtin_fmaf(s16, (float)ci, base));
                sc = (ci <= nmaxh) ? sc : NEGBIG;
                const float e = fast_exp2(sc - mx); sacc[i] = e; sum += e;
            }
            float co[4];
#pragma unroll
            for (int gq = 0; gq < 4; ++gq) { const float p3 = 0.5f * sacc[4 * gq + 3];
                imp[4 * kt + gq] = sacc[4 * gq] + sacc[4 * gq + 1] + sacc[4 * gq + 2] + p3; co[gq] = __shfl_xor(p3, 32); }
#pragma unroll
            for (int gq = 0; gq < 4; ++gq) imp[4 * kt + gq] += hh ? co[gq] : (gq > 0 ? co[gq - 1] : prevc);
            prevc = co[3];
#pragma unroll
            for (int s2 = 0; s2 < 2; ++s2) {
                const bf16x8 pf = pack_step(sacc, s2);
                const int kb = 32 * kt + 16 * s2 + 4 * hh;
#pragma unroll
                for (int dt = 0; dt < 2; ++dt) {
                    LAS const bf16_t* vp = Vct + (32 * dt + l31) * CVST + kb;
                    const s16x4 lo = *(LAS const s16x4*)vp, hi = *(LAS const s16x4*)(vp + 8);
                    const bf16x8 vf = __builtin_shufflevector(lo, hi, 0, 1, 2, 3, 4, 5, 6, 7);
                    if (dt == 0) oc0 = MFMA32(vf, pf, oc0); else oc1 = MFMA32(vf, pf, oc1);
                }
            }
        }
    }
    sum = xhalf_sum(sum);
    const float inv = 1.0f / fmaxf(sum, 1.0e-30f);
#pragma unroll
    for (int j = 0; j < 16; ++j) imp[j] *= inv;
    oc0 *= inv; oc1 *= inv;
}

DI void load_cmp(const bf16_t* part_b, const float* pebias, const float* gk0, int g, int nkeys, LAS bf16_t* Kc, LAS bf16_t* Vct) {
    const int tid = threadIdx.x, e8 = (tid & 7) * 8, n0 = tid >> 3;
    const f32x4 c0 = ld4(pebias + g * 64 + e8), c1 = ld4(pebias + g * 64 + e8 + 4), h0 = ld4(pebias + (4 + g) * 64 + e8), h1 = ld4(pebias + (4 + g) * 64 + e8 + 4);
    const f32x4 g0 = ld4(gk0 + e8), g1 = ld4(gk0 + e8 + 4);
    u32x4 q[2][4];
#pragma unroll
    for (int it = 0; it < 2; ++it) { const int n = n0 + 64 * it;
#pragma unroll
        for (int j = 0; j < 4; ++j) q[it][j] = (u32x4){0u, 0u, 0u, 0u};
        if (n < nkeys && n <= 126) {
            const bf16_t* lo = part_b + ((size_t)n * 8) * 128; const bf16_t* hi = part_b + ((size_t)(n + 1) * 8) * 128 + 64;
            q[it][0] = *(const u32x4*)(lo + g * 128 + e8); q[it][1] = *(const u32x4*)(hi + g * 128 + e8);
            q[it][2] = *(const u32x4*)(lo + (4 + g) * 128 + e8); q[it][3] = *(const u32x4*)(hi + (4 + g) * 128 + e8);
        } }
#pragma unroll
    for (int it = 0; it < 2; ++it) { const int n = n0 + 64 * it;
        if (n < nkeys) {
            float xk[8], xv[8];
            if (n <= 126) { for (int i = 0; i < 4; ++i) {
                    xk[2 * i] = bf_lo(q[it][0][i]) + bf_lo(q[it][1][i]) + (i < 2 ? c0[2 * i] : c1[2 * i - 4]); xk[2 * i + 1] = bf_hi(q[it][0][i]) + bf_hi(q[it][1][i]) + (i < 2 ? c0[2 * i + 1] : c1[2 * i - 3]);
                    xv[2 * i] = bf_lo(q[it][2][i]) + bf_lo(q[it][3][i]) + (i < 2 ? h0[2 * i] : h1[2 * i - 4]); xv[2 * i + 1] = bf_hi(q[it][2][i]) + bf_hi(q[it][3][i]) + (i < 2 ? h0[2 * i + 1] : h1[2 * i - 3]); } }
            else { for (int i = 0; i < 8; ++i) { xk[i] = 0.f; xv[i] = 0.f; } }
            float ss = 0.f; for (int i = 0; i < 8; ++i) ss += xk[i] * xk[i];
            ss += __shfl_xor(ss, 1); ss += __shfl_xor(ss, 2); ss += __shfl_xor(ss, 4);
            const float rstd = __builtin_amdgcn_rsqf(ss * (1.0f / 64.0f) + 1e-6f);
            u32x4 w; for (int i = 0; i < 2; ++i) { w[i] = pack_bf2(xk[2 * i] * rstd * g0[2 * i], xk[2 * i + 1] * rstd * g0[2 * i + 1]); w[2 + i] = pack_bf2(xk[4 + 2 * i] * rstd * g1[2 * i], xk[5 + 2 * i] * rstd * g1[2 * i + 1]); }
            *(LAS u32x4*)(Kc + n * KST + e8) = w;
            for (int i = 0; i < 8; ++i) Vct[(e8 + i) * CVST + n] = (bf16_t)(pack_bf2(xv[i], 0.f) & 0xffffu);
        } }
}

DI void attn_unit_P(const Params& p, int b, int g, int qt, LAS unsigned char* lds) {
    const int tid = threadIdx.x, wid = tid >> 6, lane = tid & 63, l31 = lane & 31, hh = lane >> 5;
    const int r = wid & 3, qh = wid >> 2, head = 4 * g + r;
    const int ql = 32 * qh + l31, t = 64 * qt + ql, row = b * 2048 + t;
    const float slope2 = fast_exp2(-0.5f * (float)(head + 1)) * LOG2E;
    const bf16_t* qbf = (const bf16_t*)(p.ws + WS_Q);
    bf16x8 qf[4];
#pragma unroll
    for (int s = 0; s < 4; ++s) qf[s] = *(const bf16x8*)(qbf + (size_t)row * 1024 + head * 64 + 16 * s + 8 * hh);
    LAS bf16_t* Kc = (LAS bf16_t*)lds; LAS bf16_t* Vct = (LAS bf16_t*)(lds + 128 * KST * 2);
    LAS float* impbuf = (LAS float*)(lds + 2 * KVBUF);
    LAS float* impsum = impbuf + 4 * 64 * 33;
    LAS unsigned* selm = (LAS unsigned*)(impsum + 64 * 33);
    const float* gt = (const float*)(p.ws + WS_GATES) + (size_t)row * 48 + head * 3;
    const float g0 = gt[0], g1 = gt[1], g2 = gt[2];
    LAS float* cacc = (LAS float*)(lds + 81920 + wid * 8704) + l31 * 68 + 4 * hh;
    {
        int n_hi = 4 * qt + 2; n_hi = n_hi > 126 ? 126 : n_hi; const int ntile = (n_hi >> 5) + 1;
        load_cmp((const bf16_t*)(p.ws + WS_PART_P) + (size_t)b * 131072, (const float*)(p.ws + WS_PEBIAS), p.g_knorm, g, 32 * ntile, Kc, Vct);
        if (tid < 65) selm[tid] = 0u;
        __syncthreads();
        float imp[16]; f32x16 oc0, oc1;
        attn_cmp(Kc, Vct, qf, t, slope2, ntile, lane, oc0, oc1, imp);
#pragma unroll
        for (int gq = 0; gq < 4; ++gq) { *(LAS f32x4*)(cacc + 8 * gq) = (f32x4){oc0[4 * gq], oc0[4 * gq + 1], oc0[4 * gq + 2], oc0[4 * gq + 3]} * g0; *(LAS f32x4*)(cacc + 32 + 8 * gq) = (f32x4){oc1[4 * gq], oc1[4 * gq + 1], oc1[4 * gq + 2], oc1[4 * gq + 3]} * g0; }
#pragma unroll
        for (int j = 0; j < 16; ++j) impbuf[(r * 64 + ql) * 33 + 8 * (j >> 2) + 2 * (j & 3) + hh] = imp[j];
        __syncthreads();
    }
    unsigned mysel, un;
    if (qt >= 16) {
        const int q = tid >> 3, sub = tid & 7;
#pragma unroll
        for (int j = 0; j < 4; ++j) { const int s = sub * 4 + j; impsum[q * 33 + s] = (impbuf[(0 * 64 + q) * 33 + s] + impbuf[(1 * 64 + q) * 33 + s]) + (impbuf[(2 * 64 + q) * 33 + s] + impbuf[(3 * 64 + q) * 33 + s]); }
        __syncthreads();
        unsigned bits = 0u;
        for (int j = 0; j < 4; ++j) { const int s = sub * 4 + j;
            if (s >= 1 && s <= qt - 2) { const float v = impsum[q * 33 + s]; int cnt = 0;
                for (int s2 = 1; s2 <= qt - 2; ++s2) { const float v2 = impsum[q * 33 + s2]; cnt += (v2 > v || (v2 == v && s2 < s)) ? 1 : 0; }
                if (cnt < 13) bits |= 1u << s; } }
        bits |= __shfl_xor(bits, 1); bits |= __shfl_xor(bits, 2); bits |= __shfl_xor(bits, 4);
        bits |= 1u | (1u << qt) | (1u << (qt - 1));
        if (sub == 0) { selm[q] = bits; atomicOr((unsigned*)(selm + 64), bits); }
        __syncthreads();
        mysel = selm[ql]; un = selm[64];
    } else { mysel = (2u << qt) - 1u; un = mysel; }
    const bf16_t* kvs = (const bf16_t*)(p.ws + WS_KVS); const bf16_t* kvw = (const bf16_t*)(p.ws + WS_KVW);
    const bool ldK = tid < 256; const int v = tid & 255;
#pragma unroll 1
    for (int br = 0; br < 2; ++br) {
        const bf16_t* src = br ? kvw : kvs;
        const int k_lo = br ? (qt > 8 ? qt - 8 : 0) : 0;
        const unsigned tmask = br ? 0xffffffffu : un;
        AttnSt st; attn_init(st);
        u32x4 r0, r1, r2, r3;
#define P_ISSUE(RA, RB, TILE) { const size_t base = ((size_t)b * 2048 + 64 * (TILE)) * 512 + g * 64; \
            if (ldK) { RA = *(const u32x4*)(src + base + (size_t)(v >> 3) * 512 + (v & 7) * 8); RB = *(const u32x4*)(src + base + (size_t)((v >> 3) + 32) * 512 + (v & 7) * 8); } \
            else { RA = *(const u32x4*)(src + base + 256 + (size_t)(2 * (v >> 3)) * 512 + (v & 7) * 8); RB = *(const u32x4*)(src + base + 256 + (size_t)(2 * (v >> 3) + 1) * 512 + (v & 7) * 8); } }
#define P_STASH(RA, RB, KB_, VT_) { if (ldK) { *(LAS u32x4*)(KB_ + (v >> 3) * KST + (v & 7) * 8) = RA; *(LAS u32x4*)(KB_ + ((v >> 3) + 32) * KST + (v & 7) * 8) = RB; } \
            else { _Pragma("unroll") for (int j = 0; j < 4; ++j) { const unsigned a_ = RA[j], c_ = RB[j]; \
                    *(LAS unsigned*)(VT_ + ((v & 7) * 8 + 2 * j) * VST + 2 * (v >> 3)) = (a_ & 0xffffu) | (c_ << 16); \
                    *(LAS unsigned*)(VT_ + ((v & 7) * 8 + 2 * j + 1) * VST + 2 * (v >> 3)) = (a_ >> 16) | (c_ & 0xffff0000u); } } }
#define P_NEXT(FROM) ({ int n_ = (FROM) - 1; while (n_ >= k_lo && !((tmask >> n_) & 1u)) --n_; n_; })
#define P_TILE(KT, KB_, VT_) { const bool allow = br ? true : (((mysel >> (KT)) & 1u) != 0u); \
            if (__any(allow)) { \
                if (br) { if ((KT) < qt && (KT) + 8 > qt) attn_tile64<1, true>(KB_, VT_, qf, t - 64 * (KT), slope2, allow, lane, st); else attn_tile64<1, false>(KB_, VT_, qf, t - 64 * (KT), slope2, allow, lane, st); } \
                else { if ((KT) < qt) attn_tile64<0, true>(KB_, VT_, qf, t - 64 * (KT), slope2, allow, lane, st); else attn_tile64<0, false>(KB_, VT_, qf, t - 64 * (KT), slope2, allow, lane, st); } } }
        int kA = P_NEXT(qt + 1), kB = kA >= k_lo ? P_NEXT(kA) : -1;
        if (kA >= k_lo) P_ISSUE(r0, r1, kA)
        if (kB >= k_lo) P_ISSUE(r2, r3, kB)
        int sb = 0;
        while (kA >= k_lo) {
            LAS bf16_t* Ka = (LAS bf16_t*)(lds + (2 * sb) * KVBUF); LAS bf16_t* Va = Ka + 64 * KST;
            LAS bf16_t* Kb2 = (LAS bf16_t*)(lds + (2 * sb + 1) * KVBUF); LAS bf16_t* Vb2 = Kb2 + 64 * KST;
            P_STASH(r0, r1, Ka, Va)
            if (kB >= k_lo) P_STASH(r2, r3, Kb2, Vb2)
            __syncthreads();
            const int nA = kB >= k_lo ? P_NEXT(kB) : -1, nB = nA >= k_lo ? P_NEXT(nA) : -1;
            if (nA >= k_lo) P_ISSUE(r0, r1, nA)
            if (nB >= k_lo) P_ISSUE(r2, r3, nB)
            P_TILE(kA, Ka, Va)
            if (kB >= k_lo) P_TILE(kB, Kb2, Vb2)
            kA = nA; kB = nB; sb ^= 1;
        }
#undef P_ISSUE
#undef P_STASH
#undef P_NEXT
#undef P_TILE
        const float sc = (br ? g2 : g1) / fmaxf(st.l, 1.0e-30f);
#pragma unroll
        for (int gq = 0; gq < 4; ++gq) { f32x4 a_ = *(LAS const f32x4*)(cacc + 8 * gq), c_ = *(LAS const f32x4*)(cacc + 32 + 8 * gq);
            a_ += (f32x4){st.o0[4 * gq], st.o0[4 * gq + 1], st.o0[4 * gq + 2], st.o0[4 * gq + 3]} * sc; c_ += (f32x4){st.o1[4 * gq], st.o1[4 * gq + 1], st.o1[4 * gq + 2], st.o1[4 * gq + 3]} * sc;
            *(LAS f32x4*)(cacc + 8 * gq) = a_; *(LAS f32x4*)(cacc + 32 + 8 * gq) = c_; }
        __syncthreads();
    }
    bf16_t* ocat = (bf16_t*)(p.ws + WS_OCAT) + (size_t)row * DM + head * 64;
#pragma unroll
    for (int gq = 0; gq < 4; ++gq) {
        const f32x4 a = *(LAS const f32x4*)(cacc + 8 * gq), c = *(LAS const f32x4*)(cacc + 32 + 8 * gq);
        st_bf4(ocat + 8 * gq + 4 * hh, a); st_bf4(ocat + 32 + 8 * gq + 4 * hh, c);
    }
}
DI const char* uniform_ptr(const void* p) {
    const unsigned long long v = (unsigned long long)p;
    const unsigned lo = __builtin_amdgcn_readfirstlane((unsigned)v), hi = __builtin_amdgcn_readfirstlane((unsigned)(v >> 32));
    return (const char*)(((unsigned long long)hi << 32) | lo);
}
DI void wave_load_kv(const float* base, int nvalid, LAS bf16_t* Kb, LAS bf16_t* Vt, int lane) {
    const int sub = lane >> 4, seg = lane & 15;
    const char* ub = uniform_ptr(base);
    const unsigned loffK = (unsigned)(sub * 512 + seg * 4) * 4u, loffV = (unsigned)(sub * 1024 + 256 + seg * 4) * 4u;
    f32x4 vk[16], vv[16];
#pragma unroll
    for (int ps = 0; ps < 16; ++ps) { vk[ps] = (f32x4){0.f, 0.f, 0.f, 0.f}; if (ps * 4 + sub < nvalid) vk[ps] = __builtin_nontemporal_load((const f32x4*)(ub + (size_t)ps * 8192 + loffK)); }
#define S_LOAD_V(PS) { const int kp = (PS) * 4 + sub; vv[2 * (PS)] = (f32x4){0.f, 0.f, 0.f, 0.f}; vv[2 * (PS) + 1] = (f32x4){0.f, 0.f, 0.f, 0.f}; \
        if (2 * kp < nvalid) vv[2 * (PS)] = __builtin_nontemporal_load((const f32x4*)(ub + (size_t)(PS) * 16384 + loffV)); \
        if (2 * kp + 1 < nvalid) vv[2 * (PS) + 1] = __builtin_nontemporal_load((const f32x4*)(ub + (size_t)(PS) * 16384 + 2048 + loffV)); }
#pragma unroll
    for (int ps = 0; ps < 4; ++ps) S_LOAD_V(ps)
#pragma unroll
    for (int ps = 0; ps < 16; ++ps) { u32x2 w; w[0] = pack_bf2(vk[ps][0], vk[ps][1]); w[1] = pack_bf2(vk[ps][2], vk[ps][3]);
        *(LAS u32x2*)(Kb + (ps * 4 + sub) * KST + seg * 4) = w; }
    asm volatile("" ::: "memory");
#pragma unroll
    for (int ps = 4; ps < 8; ++ps) S_LOAD_V(ps)
#undef S_LOAD_V
#pragma unroll
    for (int ps = 0; ps < 8; ++ps) { const int kp = ps * 4 + sub;
#pragma unroll
        for (int j = 0; j < 4; ++j) *(LAS unsigned*)(Vt + (seg * 4 + j) * VST + 2 * kp) = pack_bf2(vv[2 * ps][j], vv[2 * ps + 1][j]); }
}

DI void attn_unit_S(const Params& p, int b, int g, LAS unsigned char* lds) {
    const int tid = threadIdx.x, wid = tid >> 6, lane = tid & 63, l31 = lane & 31, hh = lane >> 5;
    const int r = l31 >> 3, qi = l31 & 7, head = 4 * g + r, t = PAST + qi, row = NP + b * 8 + qi;
    const float slope2 = fast_exp2(-0.5f * (float)(head + 1)) * LOG2E;
    const bf16_t* qbf = (const bf16_t*)(p.ws + WS_Q);
    bf16x8 qf[4];
#pragma unroll
    for (int s = 0; s < 4; ++s) qf[s] = *(const bf16x8*)(qbf + (size_t)row * 1024 + head * 64 + 16 * s + 8 * hh);
    LAS bf16_t* Kc = (LAS bf16_t*)lds; LAS bf16_t* Vct = (LAS bf16_t*)(lds + 128 * KST * 2);
    LAS bf16_t* Kb = (LAS bf16_t*)(lds + wid * KVBUF); LAS bf16_t* Vt = Kb + 64 * KST;
    LAS float* impS = (LAS float*)(lds + 8 * KVBUF) + (wid & 3) * 8 * 33;
    LAS float* ocb = (LAS float*)(lds + 8 * KVBUF + 8 * 8 * 33 * 4);
    LAS float* mo = (LAS float*)lds;
    LAS float* mm = mo + 8 * 2048; LAS float* ml = mm + 256;
    load_cmp((const bf16_t*)(p.ws + WS_PART_S) + (size_t)b * 131072, (const float*)(p.ws + WS_PEBIAS), p.g_knorm, g, 128, Kc, Vct);
    __syncthreads();
    unsigned mysel;
    {
        if (wid < 4) {
            float imp[16]; f32x16 oc0, oc1;
            attn_cmp(Kc, Vct, qf, t, slope2, 4, lane, oc0, oc1, imp);
#pragma unroll
            for (int j = 0; j < 16; ++j) { float v = imp[j]; v += __shfl_xor(v, 8); v += __shfl_xor(v, 16); imp[j] = v; }
            if (l31 < 8) {
#pragma unroll
                for (int j = 0; j < 16; ++j) impS[qi * 33 + 8 * (j >> 2) + 2 * (j & 3) + hh] = imp[j];
            }
            if (wid == 0) {
#pragma unroll
                for (int i = 0; i < 16; ++i) { ocb[(crow(i, hh)) * 32 + l31] = oc0[i]; ocb[(32 + crow(i, hh)) * 32 + l31] = oc1[i]; }
            }
        }
        __syncthreads();
        const int q2 = lane & 7, part = lane >> 3;
        unsigned bits = 0u;
        for (int j = 0; j < 4; ++j) { const int s = part * 4 + j;
            if (s >= 1 && s <= 30) { const float v = impS[q2 * 33 + s]; int cnt = 0;
                for (int s2 = 1; s2 <= 30; ++s2) { const float v2 = impS[q2 * 33 + s2]; cnt += (v2 > v || (v2 == v && s2 < s)) ? 1 : 0; }
                if (cnt < 13) bits |= 1u << s; } }
        bits |= __shfl_xor(bits, 8); bits |= __shfl_xor(bits, 16); bits |= __shfl_xor(bits, 32);
        bits |= 1u | (1u << 31);
        mysel = __shfl(bits, qi);
    }
    unsigned un = mysel;
    un |= __shfl_xor(un, 1); un |= __shfl_xor(un, 2); un |= __shfl_xor(un, 4);
    un = __builtin_amdgcn_readfirstlane(un);
    float res[4];
    const int mq = tid & 31, md = tid >> 5;
    const int mrow = NP + b * 8 + (mq & 7), mhead = 4 * g + (mq >> 3);
    const float* gt = (const float*)(p.ws + WS_GATES) + (size_t)mrow * 48 + mhead * 3;
    { const float g0 = gt[0]; for (int i = 0; i < 4; ++i) res[i] = g0 * ocb[(4 * md + i) * 32 + mq]; }
#pragma unroll 1
    for (int br = 0; br < 2; ++br) {
        AttnSt st; attn_init(st);
        {
            int s = -1, cnt = 0, j = wid - 8;
            for (;;) {
                const float* base; int nvalid = 64, rel; bool allow = true;
                if (br == 0) {
                    bool found = false;
                    while (++s <= 32) { if (s < 32 && !((un >> s) & 1u)) continue; if ((cnt++ & 7) == wid) { found = true; break; } }
                    if (!found) break;
                    if (s < 32) { const int page = p.page_table[b * 16 + (s >> 1)];
                        base = p.cache_slc + ((size_t)page * 128 + (s & 1) * 64) * 512 + g * 64; allow = ((mysel >> s) & 1u) != 0u; }
                    else { base = p.out + O_SLC_S + (size_t)b * 8 * 512 + g * 64; nvalid = 8; }
                    rel = t - 64 * s;
                } else {
                    j += 8; if (j >= 9) break;
                    if (j < 8) base = p.cache_win + ((size_t)b * 512 + 64 * j) * 512 + g * 64;
                    else { base = p.out + O_WIN_S + ((size_t)b * 512 + 504) * 512 + g * 64; nvalid = 8; }
                    rel = t - (1536 + 64 * j);
                }
                wave_load_kv(base, nvalid, Kb, Vt, lane);
                asm volatile("s_waitcnt lgkmcnt(0)" ::: "memory");
                if (br) { if (j >= 1 && j < 8) attn_tile64<1, true>(Kb, Vt, qf, rel, slope2, allow, lane, st); else attn_tile64<1, false>(Kb, Vt, qf, rel, slope2, allow, lane, st); }
                else { if (s < 32) attn_tile64<0, true>(Kb, Vt, qf, rel, slope2, allow, lane, st); else attn_tile64<0, false>(Kb, Vt, qf, rel, slope2, allow, lane, st); }
                asm volatile("s_waitcnt lgkmcnt(0)" ::: "memory");
            }
        }
        __syncthreads();
#pragma unroll
        for (int i = 0; i < 16; ++i) { mo[wid * 2048 + crow(i, hh) * 32 + l31] = st.o0[i]; mo[wid * 2048 + (32 + crow(i, hh)) * 32 + l31] = st.o1[i]; }
        if (hh == 0) { mm[wid * 32 + l31] = st.m; ml[wid * 32 + l31] = st.l; }
        __syncthreads();
        {
            float M = NEGBIG;
            for (int w = 0; w < 8; ++w) M = fmaxf(M, mm[w * 32 + mq]);
            float L = 0.f, acc[4] = {0.f, 0.f, 0.f, 0.f};
            for (int w = 0; w < 8; ++w) { const float f = fast_exp2(mm[w * 32 + mq] - M); L += ml[w * 32 + mq] * f;
                for (int i = 0; i < 4; ++i) acc[i] += mo[w * 2048 + (4 * md + i) * 32 + mq] * f; }
            const float sc = gt[1 + br] / fmaxf(L, 1.0e-30f);
            for (int i = 0; i < 4; ++i) res[i] += acc[i] * sc;
        }
        __syncthreads();
    }
    f32x4 o = {res[0], res[1], res[2], res[3]};
    st_bf4((bf16_t*)(p.ws + WS_OCAT) + (size_t)mrow * DM + mhead * 64 + 4 * md, o);
}
DI unsigned f2sortable(float f) { const unsigned u = __float_as_uint(f); return (u & 0x80000000u) ? ~u : (u | 0x80000000u); }
DI float sortable2f(unsigned s) { const unsigned u = (s & 0x80000000u) ? (s & 0x7fffffffu) : ~s; return __uint_as_float(u); }

#define PEER_CE(a, b) { const unsigned hi_ = (a) > (b) ? (a) : (b), lo_ = (a) > (b) ? (b) : (a); (a) = hi_; (b) = lo_; }
template <int B> DI void peer_sort16(unsigned (&x)[64]) {
#pragma unroll
    for (int k = 2; k <= 16; k <<= 1)
#pragma unroll
        for (int j = k >> 1; j > 0; j >>= 1)
#pragma unroll
            for (int i = 0; i < 16; ++i) { const int l = i ^ j; if (l > i) { if ((i & k) == 0) PEER_CE(x[B + i], x[B + l]) else PEER_CE(x[B + l], x[B + i]) } }
}
DI void peer_merge16(unsigned (&t)[16]) {
#pragma unroll
    for (int j = 8; j > 0; j >>= 1)
#pragma unroll
        for (int i = 0; i < 16; ++i) { const int l = i ^ j; if (l > i) PEER_CE(t[i], t[l]) }
}
DI void peer_scores_item(const Params& p, int tile, int hp, int lane, LAS const bf16_t* SK) {
    const int h = hp >> 1, pp = hp & 1, l31 = lane & 31, hh = lane >> 5;
    const bf16_t* pq = (const bf16_t*)(p.ws + WS_PQ) + (size_t)(tile * 32 + l31) * DM + h * 256 + pp * 128 + 8 * hh;
    bf16x8 qv[8];
#pragma unroll
    for (int s = 0; s < 8; ++s) qv[s] = *(const bf16x8*)(pq + 16 * s);
    f32x16 acc[4]; for (int i = 0; i < 4; ++i) acc[i] = zero16();
#pragma unroll
    for (int s = 0; s < 8; ++s) {
#pragma unroll
        for (int kt = 0; kt < 4; ++kt) { const bf16x8 kv = *(LAS const bf16x8*)(SK + (kt * 32 + l31) * 136 + 16 * s + 8 * hh); acc[kt] = MFMA32(kv, qv[s], acc[kt]); }
    }
    unsigned x[64];
#pragma unroll
    for (int kt = 0; kt < 4; ++kt)
#pragma unroll
        for (int i = 0; i < 16; ++i) { const int key = 32 * kt + crow(i, hh); x[kt * 16 + i] = (f2sortable(acc[kt][i]) & ~127u) | (unsigned)(127 - key); }
    unsigned win[16], w2[16];
    peer_sort16<0>(x); peer_sort16<16>(x);
#pragma unroll
    for (int i = 0; i < 16; ++i) win[i] = x[i] > x[31 - i] ? x[i] : x[31 - i];
    peer_merge16(win);
    peer_sort16<32>(x); peer_sort16<48>(x);
#pragma unroll
    for (int i = 0; i < 16; ++i) w2[i] = x[32 + i] > x[63 - i] ? x[32 + i] : x[63 - i];
    peer_merge16(w2);
#pragma unroll
    for (int i = 0; i < 8; ++i) { const unsigned a = win[i] > w2[15 - i] ? win[i] : w2[15 - i], b = win[15 - i] > w2[i] ? win[15 - i] : w2[i]; win[i] = a; win[15 - i] = b; }
    peer_merge16(win);
#pragma unroll
    for (int i = 0; i < 16; ++i) w2[i] = (unsigned)__shfl_xor((int)win[i], 32);
#pragma unroll
    for (int i = 0; i < 8; ++i) { const unsigned a = win[i] > w2[15 - i] ? win[i] : w2[15 - i], b = win[15 - i] > w2[i] ? win[15 - i] : w2[i]; win[i] = a; win[15 - i] = b; }
    peer_merge16(win);
    if (hh == 0) {
        int l31_ = l31; asm volatile("" : "+v"(l31_));
        float* tv = (float*)(p.ws + WS_TOPV) + ((size_t)(tile * 32 + l31_) * 16 + hp) * 16;
        unsigned char* ti = p.ws + WS_TOPI + ((size_t)(tile * 32 + l31_) * 16 + hp) * 16;
        u32x4 kb = {0u, 0u, 0u, 0u};
#pragma unroll
        for (int j = 0; j < 4; ++j) {
            f32x4 v;
            for (int i = 0; i < 4; ++i) { const unsigned w = win[4 * j + i]; v[i] = sortable2f(w & ~127u); kb[j] |= (127u - (w & 127u)) << (8 * i); }
            st4(tv + 4 * j, v);
        }
        *(u32x4*)ti = kb;
    }
}

DI float wave_sum(float v) {
#pragma unroll
    for (int o = 32; o >= 1; o >>= 1) v += __shfl_xor(v, o);
    return v;
}
DI float gelu_exact(float x) { return 0.5f * x * (1.0f + erff(x * 0.70710678118654752f)); }

#define PEER_DOT4(B) { const bf16v2 f = __builtin_amdgcn_cvt_scalef32_pk_bf16_fp4(ub[kk][i], 1.0f, B); acc = __builtin_amdgcn_fdot2_f32_bf16(f, __builtin_bit_cast(bf16v2, hp[4 * i + B]), acc, false); }
#define PEER_AXPY4(B) { const f32x2 f = __builtin_amdgcn_cvt_scalef32_pk_f32_fp4(vb[kk][i], 1.0f, B); ov[8 * i + 2 * B] = __builtin_fmaf(f[0], ws[kk], ov[8 * i + 2 * B]); ov[8 * i + 2 * B + 1] = __builtin_fmaf(f[1], ws[kk], ov[8 * i + 2 * B + 1]); }
constexpr int PEER_SLOTS = 9;
DI void peer_token_U(const Params& p, int tok, int lane, LAS unsigned char* lds, int slot) {
    const float* tv = (const float*)(p.ws + WS_TOPV) + (size_t)tok * 256;
    const unsigned char* ti = p.ws + WS_TOPI + (size_t)tok * 256;
    const int hd = lane >> 3, sub = lane & 7;
    unsigned x[7];
#pragma unroll
    for (int i = 0; i < 7; ++i) {
        const int j = sub + 8 * i;
        int ca, cb;
        if (j < 16) { ca = 0; cb = j; } else if (j < 24) { ca = 1; cb = j - 16; } else if (j < 29) { ca = 2; cb = j - 24; } else if (j < 33) { ca = 3; cb = j - 29; }
        else if (j < 36) { ca = 4; cb = j - 33; } else if (j < 38) { ca = 5; cb = j - 36; } else if (j < 40) { ca = 6; cb = j - 38; } else if (j < 42) { ca = 7; cb = j - 40; }
        else { ca = 8 + (j - 42); cb = 0; }
        x[i] = 0u;
        if (j < 50) { const float v = tv[hd * 32 + ca] + tv[hd * 32 + 16 + cb]; x[i] = (f2sortable(v) & ~255u) | (unsigned)(255 - (ca * 16 + cb)); }
    }
    unsigned prev = 0xffffffffu, w0 = 0u, w1 = 0u;
#pragma unroll
    for (int rnd = 0; rnd < 16; ++rnd) {
        unsigned best = 0u;
#pragma unroll
        for (int j = 0; j < 7; ++j) { const unsigned c = x[j] < prev ? x[j] : 0u; best = best > c ? best : c; }
#pragma unroll
        for (int o = 1; o <= 4; o <<= 1) { const unsigned ot = (unsigned)__shfl_xor((int)best, o); best = best > ot ? best : ot; }
        if (sub == (rnd >> 1)) { if (rnd & 1) w1 = best; else w0 = best; }
        prev = best;
    }
    const float sc0 = sortable2f(w0 & ~255u), sc1 = sortable2f(w1 & ~255u);
    const int id0 = 255 - (int)(w0 & 255u), id1 = 255 - (int)(w1 & 255u);
    const int e0 = (int)ti[hd * 32 + (id0 >> 4)] * 128 + (int)ti[hd * 32 + 16 + (id0 & 15)];
    const int e1 = (int)ti[hd * 32 + (id1 >> 4)] * 128 + (int)ti[hd * 32 + 16 + (id1 & 15)];
    float mx = fmaxf(sc0, sc1);
#pragma unroll
    for (int o = 1; o <= 4; o <<= 1) mx = fmaxf(mx, __shfl_xor(mx, o));
    float p0 = fast_exp2((sc0 - mx) * LOG2E), p1 = fast_exp2((sc1 - mx) * LOG2E);
    float sm = p0 + p1;
#pragma unroll
    for (int o = 1; o <= 4; o <<= 1) sm += __shfl_xor(sm, o);
    const float isum = 1.0f / sm; p0 *= isum; p1 *= isum;
    const bf16_t* h2 = (const bf16_t*)(p.ws + WS_H) + (size_t)tok * DM;
    unsigned hp[16];
    { LAS bf16_t* HT = (LAS bf16_t*)(lds + 81920 + (threadIdx.x >> 6) * 9216);
      u32x4 q[4];
#pragma unroll
      for (int c = 0; c < 4; ++c) q[c] = *(const u32x4*)(h2 + c * 512 + lane * 8);
#pragma unroll
      for (int c = 0; c < 4; ++c) *(LAS u32x4*)(HT + (c * 16 + (lane >> 2)) * 40 + (lane & 3) * 8) = q[c];
      asm volatile("s_waitcnt lgkmcnt(0)" ::: "memory");
#pragma unroll
      for (int c = 0; c < 4; ++c) { const u32x4 r = *(LAS const u32x4*)(HT + lane * 40 + 8 * c); for (int i = 0; i < 4; ++i) hp[4 * c + i] = r[i]; }
      asm volatile("s_waitcnt lgkmcnt(0)" ::: "memory"); }
    const unsigned char* U = p.ws + WS_U; const float* su = (const float*)(p.ws + WS_USCALE); const float* sv = (const float*)(p.ws + WS_VSCALE);
    LAS float* gl = (LAS float*)(lds + (threadIdx.x >> 6) * 1024); LAS float* gs = gl + 128; LAS float* wl = (LAS float*)(lds + 8192 + (threadIdx.x >> 6) * 9216 + slot * 1024);
    { u32x2 ee; ee[0] = (unsigned)e0; ee[1] = (unsigned)e1; *(LAS u32x2*)((LAS unsigned char*)wl + 512 + lane * 8) = ee; }
    gl[2 * lane] = p0 * sv[e0]; gl[2 * lane + 1] = p1 * sv[e1]; gs[2 * lane] = su[e0]; gs[2 * lane + 1] = su[e1];
    asm volatile("s_waitcnt lgkmcnt(0)" ::: "memory");
    const int kkl = (lane >> 2) & 15;
#pragma unroll 1
    for (int k0 = 0; k0 < 128; k0 += 16) {
        u32x4 ub[16]; float d[16];
#pragma unroll
        for (int kk = 0; kk < 16; ++kk) { const int e = __builtin_amdgcn_readlane((kk & 1) ? e1 : e0, (k0 + kk) >> 1);
            ub[kk] = *(const u32x4*)(U + (size_t)e * 1024 + lane * 16); }
#pragma unroll
        for (int kk = 0; kk < 16; ++kk) { float acc = 0.f;
            if (kk > 0) asm volatile("" : "+v"(ub[kk][0]), "+v"(ub[kk][1]), "+v"(ub[kk][2]), "+v"(ub[kk][3]), "+v"(d[kk - 1]));
#pragma unroll
            for (int i = 0; i < 4; ++i)
                { PEER_DOT4(0) PEER_DOT4(1) PEER_DOT4(2) PEER_DOT4(3) }
            d[kk] = acc; }
        float r8[8], r4[4], r2[2], r1;
        { const bool up = (lane & 32) != 0;
#pragma unroll
          for (int i = 0; i < 8; ++i) { const float keep = up ? d[8 + i] : d[i], send = up ? d[i] : d[8 + i]; r8[i] = keep + __shfl_xor(send, 32); } }
        { const bool up = (lane & 16) != 0;
#pragma unroll
          for (int i = 0; i < 4; ++i) { const float keep = up ? r8[4 + i] : r8[i], send = up ? r8[i] : r8[4 + i]; r4[i] = keep + __shfl_xor(send, 16); } }
        { const bool up = (lane & 8) != 0;
#pragma unroll
          for (int i = 0; i < 2; ++i) { const float keep = up ? r4[2 + i] : r4[i], send = up ? r4[i] : r4[2 + i]; r2[i] = keep + __shfl_xor(send, 8); } }
        { const bool up = (lane & 4) != 0; const float keep = up ? r2[1] : r2[0], send = up ? r2[0] : r2[1]; r1 = keep + __shfl_xor(send, 4); }
        r1 += __shfl_xor(r1, 2); r1 += __shfl_xor(r1, 1);
        const float wgt = gl[k0 + kkl] * gelu_exact(r1 * gs[k0 + kkl]);
        if ((lane & 3) == 0) wl[k0 + kkl] = wgt;
    }
    asm volatile("s_waitcnt lgkmcnt(0)" ::: "memory");
}

DI void peer_token_V(const Params& p, int tok, int lane, LAS unsigned char* lds, int slot, bool commit) {
    const unsigned char* V = p.ws + WS_V;
    LAS const float* wl = (LAS const float*)(lds + 8192 + (threadIdx.x >> 6) * 9216 + slot * 1024);
    int e0, e1; { const u32x2 ee = *(LAS const u32x2*)((LAS const unsigned char*)wl + 512 + lane * 8); e0 = (int)ee[0]; e1 = (int)ee[1]; }
    asm volatile("s_waitcnt lgkmcnt(0)" ::: "memory");
    float ov[32];
#pragma unroll
    for (int i = 0; i < 32; ++i) ov[i] = 0.f;
#pragma unroll 1
    for (int k0 = 0; k0 < 128; k0 += 16) {
        u32x4 vb[16]; float ws[16];
#pragma unroll
        for (int kk = 0; kk < 16; ++kk) { const int e = __builtin_amdgcn_readlane((kk & 1) ? e1 : e0, (k0 + kk) >> 1);
            vb[kk] = *(const u32x4*)(V + (size_t)e * 1024 + lane * 16);
            ws[kk] = wl[k0 + kk]; }
#pragma unroll
        for (int kk = 0; kk < 16; ++kk) {
            if (kk > 0) asm volatile("" : "+v"(vb[kk][0]), "+v"(vb[kk][1]), "+v"(vb[kk][2]), "+v"(vb[kk][3]), "+v"(ov[31]), "+v"(ov[15]));
#pragma unroll
            for (int i = 0; i < 4; ++i)
                { PEER_AXPY4(0) PEER_AXPY4(1) PEER_AXPY4(2) PEER_AXPY4(3) }
        }
    }
    asm volatile("s_waitcnt lgkmcnt(0)" ::: "memory");
    LAS float* T = (LAS float*)(lds + 81920 + (threadIdx.x >> 6) * 9216);
#pragma unroll
    for (int c = 0; c < 8; ++c) *(LAS f32x4*)(T + lane * 36 + 4 * c) = (f32x4){ov[4 * c], ov[4 * c + 1], ov[4 * c + 2], ov[4 * c + 3]};
    asm volatile("s_waitcnt lgkmcnt(0)" ::: "memory");
    const int mrow = tok < NP ? (tok >> 11) : 8 + ((tok - NP) >> 3);
    const float* gate = (const float*)(p.ws + WS_MOD) + (size_t)mrow * 12288 + 5 * DM;
    float* y = p.out + (size_t)tok * DM; const bf16_t* x1 = (const bf16_t*)(p.ws + WS_X1) + (size_t)tok * DM;
#pragma unroll
    for (int c = 0; c < 8; ++c) {
        const int col = c * 256 + lane * 4;
        const f32x4 o = *(LAS const f32x4*)(T + (c * 8 + (lane >> 3)) * 36 + (lane & 7) * 4);
        const u32x2 xb = *(const u32x2*)(x1 + col); f32x4 a = {bf_lo(xb[0]), bf_hi(xb[0]), bf_lo(xb[1]), bf_hi(xb[1])}; const f32x4 ga = ld4(gate + col);
        for (int i = 0; i < 4; ++i) a[i] += ga[i] * o[i];
        st4((commit ? y : (float*)(p.ws + WS_OCAT) + (size_t)tok * DM) + col, a);
    }
    asm volatile("s_waitcnt lgkmcnt(0)" ::: "memory");
}
constexpr int LDS_BYTES = 163840 - 64;
constexpr int N_PHASES = 11;
#ifndef MK_LAUNCHES
#define MK_LAUNCHES 1
#endif

__global__ __launch_bounds__(512, 2) void mega(Params p) {
    extern __shared__ __attribute__((aligned(16))) unsigned char shm[];
    LAS unsigned char* lds = (LAS unsigned char*)shm;
    const int tid = threadIdx.x, wid = tid >> 6, lane = tid & 63;
    volatile LAS unsigned* xbw = (volatile LAS unsigned*)(lds + LDS_BYTES - 16);
    if (tid == 0) { xbw[0] = 0u; xbw[1] = 0u; xbw[2] = 0u; xbw[3] = 0u; }
    __syncthreads();
    XcdBarrier bar = xcd_barrier_post((unsigned*)(p.ws + WS_BAR), xbw);
#ifndef PH_MASK
#define PH_MASK 0x7ff
#endif
#define IN(ph) (((PH_MASK >> (ph)) & 1) && p.ph_lo <= (ph) && (ph) < p.ph_hi)
#ifndef DUP_MASK
#define DUP_MASK 0
#endif
#define SEAM(ph) do { if (IN(ph) && IN((ph) + 1)) xcd_barrier(bar); } while (0)
    auto ph0 = [&]() __attribute__((always_inline)) { if (IN(0)) phase_A(p, lds); };
    ph0();
    if constexpr ((DUP_MASK >> 0) & 1) ph0();
    SEAM(0);
    auto ph2 = [&]() __attribute__((always_inline)) { if (IN(2)) phase_modulate(p, 0); };
    ph2();
    if constexpr ((DUP_MASK >> 2) & 1) ph2();
    SEAM(2);
    auto ph3 = [&]() __attribute__((always_inline)) { if (IN(3)) {
        pg8::Gemm g{(const bf16_t*)(p.ws + WS_H), (const bf16_t*)(p.ws + WS_WIN_T), NTOK, NIN_PAD, DM};
        pg8::StaticOrder S; S.init(NTOK, NIN_PAD, (int)gridDim.x, (int)blockIdx.x);
        EpiIn E{(bf16_t*)(p.ws + WS_Q), (bf16_t*)(p.ws + WS_KVS), (bf16_t*)(p.ws + WS_KVW), (bf16_t*)(p.ws + WS_UBF), p.out, (float*)(p.ws + WS_GATES), p.g_qnorm, p.g_knorm};
        pg8::gemm_phase<EpiIn, pg8::StaticOrder, false>(lds, g, S, E, nullptr);
    } };
    ph3();
    if constexpr ((DUP_MASK >> 3) & 1) ph3();
#ifdef DUP_GEMM3_NULL
    if (IN(3)) { pg8::Gemm g{(const bf16_t*)(p.ws + WS_H), (const bf16_t*)(p.ws + WS_WIN_T), NTOK, NIN_PAD, DM};
        pg8::StaticOrder S; S.init(NTOK, NIN_PAD, (int)gridDim.x, (int)blockIdx.x);
        EpiNull E{(float*)(p.ws + WS_PQ)};
        pg8::gemm_phase<EpiNull, pg8::StaticOrder, false>(lds, g, S, E, nullptr); }
#endif
    SEAM(3);
    auto ph4 = [&]() __attribute__((always_inline)) { if (IN(4)) {
        for (int u = blockIdx.x; u < 2176 + 544; u += gridDim.x) { const int grp = u / 5, pos = u - 5 * grp; if (pos < 4) cmp_unit(p, grp * 4 + pos, lds); else pool_unit(p, grp, lds); }
#ifdef DUP_CMP
        for (int u = blockIdx.x; u < 2176; u += gridDim.x) cmp_unit(p, u, lds);
#endif
#ifdef DUP_POOL
        for (int u = blockIdx.x; u < 544; u += gridDim.x) pool_unit(p, u, lds);
#endif
    } };
    ph4();
    if constexpr ((DUP_MASK >> 4) & 1) ph4();
    SEAM(4);
    auto ph5 = [&]() __attribute__((always_inline)) { if (IN(5)) {
        const int G = gridDim.x;
#ifndef NO_P
#pragma unroll 1
        for (int i = blockIdx.x; i < 1024; i += G) {
            const int rnd = i / 256, k = (i % 256) >> 5, bg = i & 31;
            const int qt = (rnd & 1) ? (31 - 8 * rnd - 7 + k) : (31 - 8 * rnd - k);
            attn_unit_P(p, bg >> 2, bg & 3, qt, lds);
        }
#endif
#ifndef NO_S
#pragma unroll 1
        for (int j = blockIdx.x; j < 512; j += G) attn_unit_S(p, j >> 2, j & 3, lds);
#ifdef DUP_ATT_S
#pragma unroll 1
        for (int j = blockIdx.x; j < 512; j += G) attn_unit_S(p, j >> 2, j & 3, lds);
#endif
#endif
    } };
    ph5();
    if constexpr ((DUP_MASK >> 5) & 1) ph5();
    SEAM(5);
    auto ph6 = [&]() __attribute__((always_inline)) { if (IN(6)) {
        pg8::Gemm g{(const bf16_t*)(p.ws + WS_OCAT), (const bf16_t*)(p.ws + WS_WOUT_T), NTOK, DM, DM};
        pg8::StaticOrder S; S.init(NTOK, DM, (int)gridDim.x, (int)blockIdx.x);
        EpiOut E{p.x_prompt, p.x_sample, (const float*)(p.ws + WS_MOD), (bf16_t*)(p.ws + WS_X1)};
        pg8::gemm_phase<EpiOut, pg8::StaticOrder, false>(lds, g, S, E, nullptr);
        constexpr int NTAIL = (NTOK / 256) * (DM / 256) - 2 * 256;
        if ((int)gridDim.x == 256 && (int)blockIdx.x >= NTAIL) { __syncthreads(); transpose_wq(p, NTAIL, lds); phase_B_stream(p, NTAIL, 0, lds); }
        else if ((int)gridDim.x != 256) { __syncthreads(); transpose_wq(p, 0, lds); phase_B_stream(p, 0, 0, lds); }
    } };
    ph6();
    if constexpr ((DUP_MASK >> 6) & 1) ph6();
    SEAM(6);
    auto ph7 = [&]() __attribute__((always_inline)) { if (IN(7)) phase_modulate(p, 1); };
    ph7();
    if constexpr ((DUP_MASK >> 7) & 1) ph7();
    SEAM(7);
    auto ph8 = [&]() __attribute__((always_inline)) { if (IN(8)) {
        pg8::Gemm g{(const bf16_t*)(p.ws + WS_H), (const bf16_t*)(p.ws + WS_WQ_T), NTOK, DM, DM};
        pg8::StaticOrder S; S.init(NTOK, DM, (int)gridDim.x, (int)blockIdx.x);
        EpiPq E{(bf16_t*)(p.ws + WS_PQ)};
        pg8::gemm_phase<EpiPq, pg8::StaticOrder, false>(lds, g, S, E, nullptr);
        constexpr int NTAIL = (NTOK / 256) * (DM / 256) - 2 * 256;
        if ((int)gridDim.x == 256 && (int)blockIdx.x >= NTAIL) { __syncthreads(); phase_B_stream(p, NTAIL, 1, lds); }
        else if ((int)gridDim.x != 256) { __syncthreads(); phase_B_stream(p, 0, 1, lds); }
    } };
    ph8();
    if constexpr ((DUP_MASK >> 8) & 1) ph8();
    SEAM(8);
    auto ph9 = [&]() __attribute__((always_inline)) { if (IN(9)) {
        const int hp = blockIdx.x & 15, ngrp = (gridDim.x + 15 - hp) / 16, rank = blockIdx.x >> 4;
        LAS bf16_t* SK = (LAS bf16_t*)lds;
        { const bf16_t* sk = (const bf16_t*)(p.ws + WS_SUBK) + (size_t)((hp & 1) * 8 + (hp >> 1)) * 128 * 128;
          for (int c = tid; c < 128 * 16; c += 512) { const int r = c >> 4, k8 = (c & 15) * 8; *(LAS u32x4*)(SK + r * 136 + k8) = *(const u32x4*)(sk + r * 128 + k8); } }
        __syncthreads();
        for (int tile = wid * ngrp + rank; tile < 544; tile += ngrp * 8) peer_scores_item(p, tile, hp, lane, SK);
        __syncthreads();
     } };
    ph9();
    if constexpr ((DUP_MASK >> 9) & 1) ph9();
    SEAM(9);
    auto ph10 = [&](bool commit) __attribute__((always_inline)) { if (IN(10)) {
#pragma unroll 1
        for (int tok0 = wid * gridDim.x + blockIdx.x; tok0 < NTOK; tok0 += gridDim.x * 8 * PEER_SLOTS) {
#pragma unroll 1
            for (int s = 0; s < PEER_SLOTS; ++s) { const int tok = tok0 + s * (int)gridDim.x * 8; if (tok < NTOK) peer_token_U(p, tok, lane, lds, s); }
#pragma unroll 1
            for (int s = 0; s < PEER_SLOTS; ++s) { const int tok = tok0 + s * (int)gridDim.x * 8; if (tok < NTOK) peer_token_V(p, tok, lane, lds, s, commit); }
        }
    } };
    if constexpr ((DUP_MASK >> 10) & 1) ph10(false);
    ph10(true);
#undef IN
#undef SEAM
}

extern "C" void kernel_launch(void* const* d_in, const int* in_sizes, int n_in, void* d_out, int out_size, void* d_ws, size_t ws_size, hipStream_t stream) {
    static int grid = 0;
    if (grid == 0) {
        if (n_in != 25 || ws_size < WS_END) { fprintf(stderr, "kernel_launch: unexpected inputs (n_in %d, ws %zu < %zu)\n", n_in, ws_size, (size_t)WS_END); grid = -1; return; }
        int dev = 0, cus = 0, per_cu = 0;
        if (hipGetDevice(&dev) != hipSuccess || hipDeviceGetAttribute(&cus, hipDeviceAttributeMultiprocessorCount, dev) != hipSuccess) { grid = -1; return; }
        if (hipFuncSetAttribute((const void*)mega, hipFuncAttributeMaxDynamicSharedMemorySize, LDS_BYTES) != hipSuccess) { fprintf(stderr, "kernel_launch: hipFuncSetAttribute failed\n"); grid = -1; return; }
        if (hipOccupancyMaxActiveBlocksPerMultiprocessor(&per_cu, (const void*)mega, 512, LDS_BYTES) != hipSuccess || per_cu < 1)
            fprintf(stderr, "kernel_launch: occupancy query reports %d blocks per CU\n", per_cu);
        (void)hipGetLastError();
        grid = cus;
    }
    if (grid < 0) return;
    (void)hipMemsetAsync((char*)d_ws + WS_BAR, 0, XCD_BAR_WORDS * sizeof(unsigned), stream);
    Params p{};
    p.x_prompt = (const float*)d_in[0]; p.x_sample = (const float*)d_in[1]; p.cache_cmp = (const float*)d_in[2]; p.cache_slc = (const float*)d_in[3];
    p.cache_win = (const float*)d_in[4]; p.state_pool = (const float*)d_in[5]; p.page_table = (const int*)d_in[6]; p.c_prompt = (const float*)d_in[7];
    p.c_sample = (const float*)d_in[8]; p.w_ada = (const float*)d_in[9]; p.b_ada = (const float*)d_in[10]; p.g_norm1 = (const float*)d_in[11];
    p.g_norm2 = (const float*)d_in[12]; p.w_in = (const float*)d_in[13]; p.w_out = (const float*)d_in[14]; p.g_qnorm = (const float*)d_in[15];
    p.g_knorm = (const float*)d_in[16]; p.cmp_pe = (const float*)d_in[17]; p.w_cmp = (const float*)d_in[18]; p.w_pool = (const float*)d_in[19];
    p.pool_scale = (const float*)d_in[20]; p.peer_wq = (const float*)d_in[21]; p.peer_subkeys = (const float*)d_in[22]; p.peer_u = (const float*)d_in[23];
    p.peer_v = (const float*)d_in[24];
    p.out = (float*)d_out; p.ws = (unsigned char*)d_ws;
#if MK_LAUNCHES == 1
    p.ph_lo = 0; p.ph_hi = N_PHASES;
    hipLaunchKernelGGL(mega, dim3(grid), dim3(512), LDS_BYTES, stream, p);
#else
    for (int ph = 0; ph < N_PHASES; ++ph) { p.ph_lo = ph; p.ph_hi = ph + 1; hipLaunchKernelGGL(mega, dim3(grid), dim3(512), LDS_BYTES, stream, p); }
#endif
}
```

```cpp
#include <hip/hip_runtime.h>
#include <stdint.h>
#include <stdio.h>

#define DI __device__ __forceinline__
#define LAS __attribute__((address_space(3)))
typedef unsigned short bf16_t;
typedef short bf16x8 __attribute__((ext_vector_type(8)));
typedef short s16x4 __attribute__((ext_vector_type(4)));
typedef float f32x2 __attribute__((ext_vector_type(2)));
typedef float f32x4 __attribute__((ext_vector_type(4)));
typedef float f32x16 __attribute__((ext_vector_type(16)));
typedef unsigned u32x2 __attribute__((ext_vector_type(2)));
typedef unsigned u32x4 __attribute__((ext_vector_type(4)));
typedef __bf16 bf16v2 __attribute__((ext_vector_type(2)));

constexpr int DM = 2048;
constexpr int NP = 16384;
constexpr int NSM = 1024;
constexpr int NTOK = NP + NSM;
constexpr int SEQ = 2048, NB_P = 8, NB_S = 128, TS = 8, PAST = 2048;
constexpr int NIN_PAD = 3840;
constexpr int NEXP = 16384;
constexpr float LOG2E = 1.4426950408889634f;
constexpr float NEGBIG = -1.0e30f;

constexpr size_t O_Y = 0;
constexpr size_t O_CMP_P = 35651584, O_SLC_P = 44040192, O_WIN_P = 52428800, O_POOL_P = 54525952;
constexpr size_t O_CMP_S = 54648832, O_SLC_S = 55173120, O_WIN_S = 55697408, O_POOL_S = 89251840;

constexpr size_t al256(size_t x) { return (x + 255) & ~(size_t)255; }
constexpr size_t WS_BAR = 0;
constexpr size_t WS_WIN_T = 16384;
constexpr size_t WS_WOUT_T = WS_WIN_T + (size_t)NIN_PAD * DM * 2;
constexpr size_t WS_WQ_T = WS_WOUT_T + (size_t)DM * DM * 2;
constexpr size_t WS_WCMP_T = WS_WQ_T + (size_t)DM * DM * 2 + (size_t)12288 * DM * 2;
constexpr size_t WS_WPOOL_T = WS_WCMP_T + (size_t)8 * 128 * 1024 * 2;
constexpr size_t WS_SUBK = WS_WPOOL_T + (size_t)4 * 256 * 256 * 2;
constexpr size_t WS_U = WS_SUBK + (size_t)2 * 8 * 128 * 128 * 2;
constexpr size_t WS_V = WS_U + (size_t)NEXP * DM * 2;
constexpr size_t WS_PEBIAS = WS_V + (size_t)NEXP * DM * 2;
constexpr size_t WS_MOD = WS_PEBIAS + 4096 + (size_t)256 * DM * 2;
constexpr size_t WS_H = WS_MOD + (size_t)256 * 12288 * 4;
constexpr size_t WS_Q = WS_H + (size_t)NTOK * DM * 2;
constexpr size_t WS_X1 = WS_Q;
constexpr size_t WS_KVS = WS_Q + (size_t)NTOK * 1024 * 2;
constexpr size_t WS_KVW = WS_KVS + (size_t)NP * 512 * 2;
constexpr size_t WS_GATES = WS_KVW + (size_t)NP * 512 * 2;
constexpr size_t WS_UBF = WS_GATES + (size_t)NTOK * 48 * 4;
constexpr size_t WS_PART_S = WS_UBF + (size_t)NTOK * 1024 * 2;
constexpr size_t WS_PART_P = WS_PART_S + (size_t)NB_S * 128 * 8 * 128 * 4;
constexpr size_t WS_OCAT = WS_PART_P + (size_t)NB_P * 128 * 8 * 128 * 4;
constexpr size_t WS_PQ = WS_OCAT + (size_t)NTOK * DM * 2;
constexpr size_t WS_TOPV = WS_PQ + (size_t)NTOK * DM * 2;
constexpr size_t WS_TOPI = WS_TOPV + (size_t)NTOK * 256 * 4;
constexpr size_t WS_USCALE = WS_TOPI + (size_t)NTOK * 256 * 4;
constexpr size_t WS_VSCALE = WS_USCALE + (size_t)NEXP * 64;
constexpr size_t WS_END = WS_VSCALE + (size_t)NEXP * 64;

struct Params {
    const float *x_prompt, *x_sample, *cache_cmp, *cache_slc, *cache_win, *state_pool;
    const int* page_table;
    const float *c_prompt, *c_sample, *w_ada, *b_ada, *g_norm1, *g_norm2, *w_in, *w_out, *g_qnorm, *g_knorm, *cmp_pe, *w_cmp, *w_pool, *pool_scale,
        *peer_wq, *peer_subkeys, *peer_u, *peer_v;
    float* out;
    unsigned char* ws;
    int ph_lo, ph_hi;
};

DI unsigned pack_bf2(float lo, float hi) {
    f32x2 v = {lo, hi};
    bf16v2 r = __builtin_convertvector(v, bf16v2);
    return __builtin_bit_cast(unsigned, r);
}
DI float bf_lo(unsigned u) { return __uint_as_float(u << 16); }
DI float bf_hi(unsigned u) { return __uint_as_float(u & 0xffff0000u); }
DI float fast_exp2(float x) { return __builtin_amdgcn_exp2f(x); }
DI float fast_rcp(float x) { return __builtin_amdgcn_rcpf(x); }
DI int crow(int reg, int h) { return (reg & 3) + 8 * (reg >> 2) + 4 * h; }
#define MFMA32(a, b, c) __builtin_amdgcn_mfma_f32_32x32x16_bf16((a), (b), (c), 0, 0, 0)
DI f32x16 zero16() { f32x16 z; for (int i = 0; i < 16; ++i) z[i] = 0.f; return z; }
DI bf16x8 pack_step(const f32x16& x, int s) {
    u32x4 p;
    p[0] = pack_bf2(x[8 * s + 0], x[8 * s + 1]); p[1] = pack_bf2(x[8 * s + 2], x[8 * s + 3]);
    p[2] = pack_bf2(x[8 * s + 4], x[8 * s + 5]); p[3] = pack_bf2(x[8 * s + 6], x[8 * s + 7]);
    return __builtin_bit_cast(bf16x8, p);
}
#define XB_TMO      128
#define XB_XCNT(j)  (256  + 64 * (j))
#define XB_XSUB(j)  (1280 + 64 * (j))
#define XB_XGEN(j)  (2304 + 64 * (j))
#define XB_TOP      3328
#define XB_TOPGEN   3392
#define XCD_BAR_WORDS 3456
#define XB_SPIN_CAP (1u << 22)

__device__ __forceinline__ unsigned xb_ld(unsigned* p)              { return __hip_atomic_load(p, __ATOMIC_RELAXED, __HIP_MEMORY_SCOPE_AGENT); }
__device__ __forceinline__ unsigned xb_add(unsigned* p, unsigned v) { return __hip_atomic_fetch_add(p, v, __ATOMIC_RELAXED, __HIP_MEMORY_SCOPE_AGENT); }
__device__ __forceinline__ unsigned xb_xcc_id() { return (unsigned)__builtin_amdgcn_s_getreg((3 << 11) | 20) & 0xFu; }
#define XB_SPIN(cond, bar) do { unsigned _sp = 0; while (cond) { __builtin_amdgcn_s_sleep(1); \
    if ((++_sp & 255u) == 0u) { if (xb_ld(&(bar)[XB_TMO])) break; if (_sp > XB_SPIN_CAP) { atomicAdd(&(bar)[XB_TMO], 1u); break; } } } } while (0)

struct XcdBarrier {
    unsigned* bar; unsigned x;
    volatile LAS unsigned* st;
};

__device__ __forceinline__ XcdBarrier xcd_barrier_post(unsigned* bar, volatile LAS unsigned* st) {
    XcdBarrier b; b.bar = bar; b.x = xb_xcc_id(); b.st = st;
    if (threadIdx.x == 0) (void)xb_add(&bar[XB_XCNT(b.x)], 1u);
    return b;
}
__device__ __forceinline__ void xcd_barrier_complete(unsigned* bar, unsigned x, unsigned& nloc, unsigned& nx) {
    const unsigned G = gridDim.x * gridDim.y * gridDim.z;
    unsigned sum, cnt, mine, sp = 0u;
    for (;;) {
        sum = 0u; cnt = 0u; mine = 0u;
#pragma unroll
        for (unsigned j = 0; j < 16; ++j) { const unsigned c = xb_ld(&bar[XB_XCNT(j)]); sum += c; cnt += (c > 0u) ? 1u : 0u; mine = (j == x) ? c : mine; }
        if (sum == G) break;
        __builtin_amdgcn_s_sleep(1);
        if ((++sp & 255u) == 0u) { if (xb_ld(&bar[XB_TMO])) break; if (sp > XB_SPIN_CAP) { atomicAdd(&bar[XB_TMO], 1u); break; } }
    }
    nloc = mine > 0u ? mine : 1u; nx = cnt > 0u ? cnt : 1u;
}

__device__ __forceinline__ void xcd_barrier(const XcdBarrier& b) {
    asm volatile("s_waitcnt vmcnt(0)" ::: "memory");
    __syncthreads();
    if (threadIdx.x == 0) {
        unsigned* bar = b.bar;
        __builtin_amdgcn_s_waitcnt(0);
        unsigned nloc = b.st[0], nx = b.st[1];
        if (nloc == 0u) { xcd_barrier_complete(bar, b.x, nloc, nx); b.st[0] = nloc; b.st[1] = nx; }
        const unsigned old = xb_add(&bar[XB_XSUB(b.x)], 1u);
        const unsigned gen = old / nloc;
        if (old + 1u == (gen + 1u) * nloc) {
            __builtin_amdgcn_fence(__ATOMIC_RELEASE, "agent");
            asm volatile("s_waitcnt vmcnt(0)" ::: "memory");
            const unsigned og = xb_add(&bar[XB_TOP], 1u);
            const unsigned tg = og / nx;
            if (og + 1u == (tg + 1u) * nx) xb_add(&bar[XB_TOPGEN], 1u);
            else XB_SPIN(xb_ld(&bar[XB_TOPGEN]) == tg, bar);
            __builtin_amdgcn_fence(__ATOMIC_ACQUIRE, "agent");
            xb_add(&bar[XB_XGEN(b.x)], 1u);
            asm volatile("s_waitcnt vmcnt(0)" ::: "memory");
        } else {
            XB_SPIN(xb_ld(&bar[XB_XGEN(b.x)]) == gen, bar);
            __builtin_amdgcn_fence(__ATOMIC_ACQUIRE, "agent");
            asm volatile("s_waitcnt vmcnt(0)" ::: "memory");
        }
    }
    __syncthreads();
}

namespace pg8 {
#define PG8_LAS __attribute__((address_space(3)))
constexpr int BM = 256, BK = 64, HALF = 128, HTB = HALF * BK * 2  , STAGE_BYTES = 8 * HTB, NXCD = 8, WGM = 8;

__host__ __device__ __forceinline__ int lds_byte(int r, int c) { const int st = (r >> 4) * 2 + (c >> 5), rr = r & 15, cc = c & 31, ob = rr * 64 + cc * 2; return st * 1024 + (ob ^ (((ob >> 9) & 1) << 5)); }
__host__ __device__ __forceinline__ void stage_rc(int b, int& R, int& C) { const int st = b / 1024, sb = b % 1024, swz = sb ^ (((sb >> 9) & 1) << 5); R = (st >> 1) * 16 + swz / 64; C = (st & 1) * 32 + (swz % 64) / 2; }
__host__ __device__ __forceinline__ int perm32(int rho) { const int n = rho >> 4, i = rho & 15; return 8 * (i >> 2) + 4 * n + (i & 3); }

struct Unit { int pm, pn; };
struct Gemm { const bf16_t* A; const bf16_t* Bt; int M, N, K; };

struct StaticOrder {
    int nM, nN, nwg, G, c;
    __host__ __device__ void init(int M, int N, int G_, int c_) { nM = M / BM; nN = N / BM; nwg = nM * nN; G = G_; c = c_; }
    __host__ __device__ bool next(int i, Unit& u) const {
        const long L = (long)i * G + c; if (L >= nwg) return false;
        int wgid = (int)L; { const int q = nwg / NXCD, r = nwg % NXCD, xcd = wgid % NXCD, off = wgid / NXCD; wgid = (xcd < r ? xcd * (q + 1) : r * (q + 1) + (xcd - r) * q) + off; }
        const int nig = WGM * nN, gid = wgid / nig, fm = gid * WGM, gsz = (nM - fm) < WGM ? (nM - fm) : WGM;
        u.pm = fm + ((wgid % nig) % gsz); u.pn = (wgid % nig) / gsz; return true;
    }
    __device__ __forceinline__ void a_ready(const Unit&) const {}
    __device__ __forceinline__ void done(const Unit&) const {}
};
template <class Epi, class Sched, bool STAMP = false>
__device__ __forceinline__ void gemm_phase(PG8_LAS unsigned char* lds, const Gemm g, const Sched& S, const Epi& E, unsigned long long* stamps) {
    const int tid = threadIdx.x, wid = __builtin_amdgcn_readfirstlane(tid >> 6), lane = tid & 63, wr = wid >> 2, wc = wid & 3, fr = lane & 15, fq = lane >> 4;
    const int K = g.K, nt = K / BK;
    int ts_lo = 0, ts_hi = 0, nts = 0; const unsigned long long rt_entry = STAMP ? (unsigned long long)wall_clock64() : 0ull;
#define PG8_STAMP() do { if (STAMP && wid == 0 && nts < 64) { const unsigned long long _c = (unsigned long long)clock64(); \
        ts_lo = (lane == nts) ? (int)(unsigned)_c : ts_lo; ts_hi = (lane == nts) ? (int)(unsigned)(_c >> 32) : ts_hi; ++nts; } } while (0)
    PG8_STAMP();
    unsigned voffA[2], voffB[2];
#pragma unroll
    for (int i = 0; i < 2; ++i) { int R, C; stage_rc(tid * 16 + i * 8192, R, C); const int Rb = Epi::PERM ? ((R & ~31) + perm32(R & 31)) : R;
        voffA[i] = (unsigned)(R * K + C) * 2u; voffB[i] = (unsigned)(Rb * K + C) * 2u; }
    const size_t kstep = (size_t)(BK * 2);
    const size_t hstep = (size_t)HALF * K * 2;
    const size_t tstep = 2 * hstep;
    const unsigned ldsw = (unsigned)wid * 1024u;
    const int aoff = lds_byte(wr * 64 + fr, fq * 8), boff = lds_byte(wc * 32 + fr, fq * 8);
#define PG8_SA(b, h) (((b) * 2 + (h)) * HTB)
#define PG8_SB(b, h) ((4 + (b) * 2 + (h)) * HTB)
#define PG8_STAGE(bufoff, gbase, voff) do { _Pragma("unroll") for (int _i = 0; _i < 2; ++_i) \
        __builtin_amdgcn_global_load_lds((const unsigned*)((const char*)(gbase) + (voff)[_i]), (PG8_LAS unsigned*)(lds + (bufoff) + ldsw + _i * 8192), 16, 0, 0); } while (0)
#define PG8_LDA(dst, b, h) do { _Pragma("unroll") for (int m = 0; m < 4; ++m) _Pragma("unroll") for (int k = 0; k < 2; ++k) dst[m][k] = *(const PG8_LAS bf16x8*)(lds + PG8_SA(b, h) + aoff + m * 2048 + k * 1024); } while (0)
#define PG8_LDB(dst, b, h) do { _Pragma("unroll") for (int n = 0; n < 2; ++n) _Pragma("unroll") for (int k = 0; k < 2; ++k) dst[n][k] = *(const PG8_LAS bf16x8*)(lds + PG8_SB(b, h) + boff + n * 2048 + k * 1024); } while (0)
#define PG8_MMA(ai, bj, At, Bt) do { __builtin_amdgcn_s_setprio(1); _Pragma("unroll") for (int m = 0; m < 4; ++m) _Pragma("unroll") for (int n = 0; n < 2; ++n) _Pragma("unroll") for (int k = 0; k < 2; ++k) \
        acc[ai][bj][m][n] = __builtin_amdgcn_mfma_f32_16x16x32_bf16(Bt[n][k], At[m][k], acc[ai][bj][m][n], 0, 0, 0); __builtin_amdgcn_s_setprio(0); } while (0)
#define PG8_WAIT_V(n) asm volatile("s_waitcnt vmcnt(" #n ")" ::: "memory")
#define PG8_WAIT_L(n) asm volatile("s_waitcnt lgkmcnt(" #n ")" ::: "memory")
#define PG8_BAR __builtin_amdgcn_s_barrier()
#define PG8_SCHED __builtin_amdgcn_sched_barrier(0)
    Unit cur, nxt; int ui = 0;
    if (!S.next(0, cur)) return;
    f32x4 acc[2][2][4][2];
#pragma unroll
    for (int a = 0; a < 2; ++a)
#pragma unroll
        for (int b = 0; b < 2; ++b)
#pragma unroll
            for (int m = 0; m < 4; ++m)
#pragma unroll
                for (int n = 0; n < 2; ++n) acc[a][b][m][n] = (f32x4){0.f, 0.f, 0.f, 0.f};
    bf16x8 At[4][2], B0[2][2], B1[2][2];
    const char* cA = (const char*)g.A + (size_t)cur.pm * tstep; const char* cB = (const char*)g.Bt + (size_t)cur.pn * tstep;
    S.a_ready(cur);
    PG8_STAGE(PG8_SB(0, 0), cB, voffB); PG8_STAGE(PG8_SA(0, 0), cA, voffA); PG8_STAGE(PG8_SB(0, 1), cB + hstep, voffB); PG8_STAGE(PG8_SA(0, 1), cA + hstep, voffA);
    if (wr == 1) PG8_BAR;
    PG8_WAIT_V(4); PG8_BAR;
    PG8_STAGE(PG8_SB(1, 0), cB + kstep, voffB); PG8_STAGE(PG8_SA(1, 0), cA + kstep, voffA); PG8_STAGE(PG8_SB(1, 1), cB + hstep + kstep, voffB);
    PG8_WAIT_V(6); PG8_BAR;
    PG8_STAMP();
    for (;;) {
        const bool has_next = S.next(ui + 1, nxt);
        const char* nA = has_next ? (const char*)g.A + (size_t)nxt.pm * tstep : cA; const char* nB = has_next ? (const char*)g.Bt + (size_t)nxt.pn * tstep : cB;
        for (int t = 0; t < nt; t += 2) {
            const bool last = (t == nt - 2);
            const char* a1 = cA + (size_t)(t + 1) * kstep;
            const char* a2 = last ? nA : cA + (size_t)(t + 2) * kstep; const char* b2 = last ? nB : cB + (size_t)(t + 2) * kstep;
            const char* a3 = a2 + kstep; const char* b3 = b2 + kstep;
            if (last && has_next) S.a_ready(nxt);
            PG8_LDB(B0, 0, 0); PG8_SCHED; PG8_LDA(At, 0, 0); PG8_STAGE(PG8_SA(1, 1), a1 + hstep, voffA);
            PG8_WAIT_L(8); PG8_BAR; PG8_WAIT_L(0); PG8_MMA(0, 0, At, B0); PG8_BAR; PG8_SCHED;
            PG8_LDB(B1, 0, 1); PG8_STAGE(PG8_SB(0, 0), b2, voffB);
            PG8_BAR; PG8_WAIT_L(0); PG8_MMA(0, 1, At, B1); PG8_BAR;
            PG8_LDA(At, 0, 1); PG8_STAGE(PG8_SA(0, 0), a2, voffA);
            PG8_BAR; PG8_WAIT_L(0); PG8_MMA(1, 0, At, B0); PG8_BAR; PG8_SCHED;
            PG8_STAGE(PG8_SB(0, 1), b2 + hstep, voffB);
            PG8_WAIT_V(6); PG8_BAR; PG8_MMA(1, 1, At, B1); PG8_BAR;
            PG8_LDB(B0, 1, 0); PG8_SCHED; PG8_LDA(At, 1, 0); PG8_STAGE(PG8_SA(0, 1), a2 + hstep, voffA);
            PG8_WAIT_L(8); PG8_BAR; PG8_WAIT_L(0); PG8_MMA(0, 0, At, B0); PG8_BAR; PG8_SCHED;
            PG8_LDB(B1, 1, 1); PG8_STAGE(PG8_SB(1, 0), b3, voffB);
            PG8_BAR; PG8_WAIT_L(0); PG8_MMA(0, 1, At, B1); PG8_BAR;
            PG8_LDA(At, 1, 1); PG8_STAGE(PG8_SA(1, 0), a3, voffA);
            PG8_BAR; PG8_WAIT_L(0); PG8_MMA(1, 0, At, B0); PG8_BAR; PG8_SCHED;
            PG8_STAGE(PG8_SB(1, 1), b3 + hstep, voffB);
            PG8_WAIT_V(6); PG8_BAR; PG8_MMA(1, 1, At, B1); PG8_BAR;
        }
        PG8_STAMP();
        if constexpr (!Epi::AFTER_DRAIN) { E(acc, cur, wr, wc, fr, fq); S.done(cur); }
        PG8_STAMP();
        if (!has_next) break;
#pragma unroll
        for (int a = 0; a < 2; ++a)
#pragma unroll
            for (int b = 0; b < 2; ++b)
#pragma unroll
                for (int m = 0; m < 4; ++m)
#pragma unroll
                    for (int n = 0; n < 2; ++n) acc[a][b][m][n] = (f32x4){0.f, 0.f, 0.f, 0.f};
        cur = nxt; cA = nA; cB = nB; ++ui;
    }
    PG8_WAIT_V(0);
    if (wr == 0) PG8_BAR;
    PG8_BAR;
    if constexpr (Epi::AFTER_DRAIN) { E.fused(acc, cur, wr, wc, fr, fq, lds, wid, lane); S.done(cur); }
    PG8_STAMP();
    if (STAMP && wid == 0) { stamps[lane] = lane < nts ? (((unsigned long long)(unsigned)ts_hi << 32) | (unsigned)ts_lo) : 0ull;
        if (lane == 62) stamps[62] = rt_entry; if (lane == 63) stamps[63] = (unsigned long long)wall_clock64(); }
#undef PG8_STAMP
#undef PG8_SA
#undef PG8_SB
#undef PG8_STAGE
#undef PG8_LDA
#undef PG8_LDB
#undef PG8_MMA
#undef PG8_WAIT_V
#undef PG8_WAIT_L
#undef PG8_BAR
#undef PG8_SCHED
}
}
DI f32x4 ld4(const float* p) { return *(const f32x4*)p; }
DI void st4(float* p, f32x4 v) { *(f32x4*)p = v; }
DI void st_bf4(bf16_t* p, f32x4 v) { u32x2 w; w[0] = pack_bf2(v[0], v[1]); w[1] = pack_bf2(v[2], v[3]); *(u32x2*)p = w; }

struct EpiIn {
    static constexpr bool PERM = false, AFTER_DRAIN = false;
    bf16_t *q_bf, *kvs_bf, *kvw_bf, *u_bf; float *out, *gates; const float *g_qnorm, *g_knorm;
    DI void operator()(const f32x4 (&acc)[2][2][4][2], const pg8::Unit& u, int wr, int wc, int fr, int fq) const {
        const int pn = u.pn; const bool isS = u.pm >= 64;
#pragma unroll
        for (int ai = 0; ai < 2; ++ai)
#pragma unroll
            for (int m = 0; m < 4; ++m) {
                const int row = u.pm * 256 + ai * 128 + wr * 64 + m * 16 + fr;
                f32x4 v[2][2];
#pragma unroll
                for (int bj = 0; bj < 2; ++bj)
#pragma unroll
                    for (int n = 0; n < 2; ++n) v[bj][n] = acc[ai][bj][m][n];
                float ss = 0.f;
#pragma unroll
                for (int bj = 0; bj < 2; ++bj)
#pragma unroll
                    for (int n = 0; n < 2; ++n)
#pragma unroll
                        for (int i = 0; i < 4; ++i) ss += v[bj][n][i] * v[bj][n][i];
                ss += __shfl_xor(ss, 16); ss += __shfl_xor(ss, 32);
                const float rstd = __builtin_amdgcn_rsqf(ss * (1.0f / 64.0f) + 1e-6f);
                int sb, st;
                if (isS) { const int sr = row - NP; sb = sr >> 3; st = sr & 7; } else { sb = row >> 11; st = row & 2047; }
                if (pn < 4) {
                    const int head = pn * 4 + wc;
#pragma unroll
                    for (int bj = 0; bj < 2; ++bj)
#pragma unroll
                        for (int n = 0; n < 2; ++n) { const int e0 = 32 * bj + 16 * n + 4 * fq;
                            st_bf4(q_bf + (size_t)row * 1024 + head * 64 + e0, v[bj][n] * (rstd * (0.125f * LOG2E)) * ld4(g_qnorm + e0)); }
                } else if (pn < 10) {
                    const int sec = (pn - 4) >> 1, c = (pn - 4) & 1, g = wc; const bool nrm = (c == 0) && (sec > 0);
#pragma unroll
                    for (int bj = 0; bj < 2; ++bj)
#pragma unroll
                        for (int n = 0; n < 2; ++n) { const int e0 = 32 * bj + 16 * n + 4 * fq; const int cg = c * 256 + g * 64 + e0;
                            f32x4 y = v[bj][n];
                            if (nrm) y = y * rstd * ld4(g_knorm + sec * 64 + e0);
                            if (sec == 0) { st4(out + (isS ? O_CMP_S + (size_t)(row - NP) * 512 : O_CMP_P + (size_t)row * 512) + cg, y); }
                            else if (sec == 1) { st4(out + (isS ? O_SLC_S + (size_t)(row - NP) * 512 : O_SLC_P + (size_t)row * 512) + cg, y);
                                if (!isS) st_bf4(kvs_bf + (size_t)row * 512 + cg, y); }
                            else { if (isS) st4(out + O_WIN_S + ((size_t)sb * 512 + 504 + st) * 512 + cg, y);
                                else { st_bf4(kvw_bf + (size_t)row * 512 + cg, y); if (st >= 1536) st4(out + O_WIN_P + ((size_t)sb * 512 + st - 1536) * 512 + cg, y); } }
                        }
                } else if (pn == 10) {
                    if (wc == 0) {
#pragma unroll
                        for (int bj = 0; bj < 2; ++bj)
#pragma unroll
                            for (int n = 0; n < 2; ++n) { const int e0 = 32 * bj + 16 * n + 4 * fq;
                                if (e0 < 48) { f32x4 y; for (int i = 0; i < 4; ++i) y[i] = fast_rcp(1.0f + fast_exp2(-LOG2E * v[bj][n][i])); st4(gates + (size_t)row * 48 + e0, y); } }
                    }
                } else {
#pragma unroll
                    for (int bj = 0; bj < 2; ++bj)
#pragma unroll
                        for (int n = 0; n < 2; ++n) { const int col = (pn - 11) * 256 + 64 * wc + 32 * bj + 16 * n + 4 * fq;
                            st_bf4(u_bf + (size_t)row * 1024 + col, v[bj][n]);
                            if (isS) st4(out + O_POOL_S + ((size_t)sb * 15 + 7 + st) * 1024 + col, v[bj][n]);
                            else if (st >= 2033) st4(out + O_POOL_P + ((size_t)sb * 15 + st - 2033) * 1024 + col, v[bj][n]); }
                }
            }
    }
};

struct EpiOut {
    static constexpr bool PERM = false, AFTER_DRAIN = false;
    const float *x_prompt, *x_sample, *mod; bf16_t* x1;
    DI void operator()(const f32x4 (&acc)[2][2][4][2], const pg8::Unit& u, int wr, int wc, int fr, int fq) const {
        const int col0 = u.pn * 256 + wc * 32 + 4 * fq;
#pragma unroll
        for (int ai = 0; ai < 2; ++ai)
#pragma unroll
            for (int m = 0; m < 4; ++m) {
                const int row = u.pm * 256 + ai * 128 + wr * 64 + m * 16 + fr;
                const float* xr = row < NP ? x_prompt + (size_t)row * DM : x_sample + (size_t)(row - NP) * DM;
                const int mrow = row < NP ? (row >> 11) : 8 + ((row - NP) >> 3);
                const float* gate = mod + (size_t)mrow * 12288 + 2 * DM;
#pragma unroll
                for (int bj = 0; bj < 2; ++bj)
#pragma unroll
                    for (int n = 0; n < 2; ++n) { const int col = col0 + bj * 128 + n * 16;
                        st_bf4(x1 + (size_t)row * DM + col, ld4(xr + col) + ld4(gate + col) * acc[ai][bj][m][n]); }
            }
    }
};

struct EpiPq {
    static constexpr bool PERM = false, AFTER_DRAIN = false;
    bf16_t* pq;
    DI void operator()(const f32x4 (&acc)[2][2][4][2], const pg8::Unit& u, int wr, int wc, int fr, int fq) const {
        const int col0 = u.pn * 256 + wc * 32 + 4 * fq;
#pragma unroll
        for (int ai = 0; ai < 2; ++ai)
#pragma unroll
            for (int m = 0; m < 4; ++m) {
                const int row = u.pm * 256 + ai * 128 + wr * 64 + m * 16 + fr;
#pragma unroll
                for (int bj = 0; bj < 2; ++bj)
#pragma unroll
                    for (int n = 0; n < 2; ++n) st_bf4(pq + (size_t)row * DM + col0 + bj * 128 + n * 16, acc[ai][bj][m][n]);
            }
    }
};

struct EpiNull {
    static constexpr bool PERM = false, AFTER_DRAIN = false;
    float* sink;
    DI void operator()(const f32x4 (&acc)[2][2][4][2], const pg8::Unit& u, int wr, int wc, int fr, int fq) const {
        float s = 0.f;
#pragma unroll
        for (int ai = 0; ai < 2; ++ai) for (int bj = 0; bj < 2; ++bj) for (int m = 0; m < 4; ++m) for (int n = 0; n < 2; ++n) s += acc[ai][bj][m][n][0] + acc[ai][bj][m][n][3];
        if (s == 12345.678f) sink[threadIdx.x] = s;
    }
};
DI int win_logical(int p) {
    const int pn = p >> 8, pp = p & 255, bj = pp >> 7, wc = (pp >> 5) & 3, r = pp & 31;
    const int lu = 64 * wc + 32 * bj + r;
    if (pn < 10) return 256 * pn + lu;
    if (pn == 10) return lu < 48 ? 2560 + lu : -1;
    return 2608 + 256 * (pn - 11) + lu;
}
template <int KT>
DI void transpose_tile(const float* src, int ldsrc, int k0, int c0, int nvalid, bf16_t* dst, int lddst, int p0, LAS unsigned char* lds) {
    const int tid = threadIdx.x;
    constexpr int TS = 128 * KT + 8;
    LAS bf16_t* T = (LAS bf16_t*)lds;
    f32x4 v[2 * KT];
    const int c4 = (tid & 7) * 4;
#pragma unroll
    for (int i = 0; i < 2 * KT; ++i) {
        const int kk = (tid >> 3) + 64 * i;
        v[i] = (f32x4){0.f, 0.f, 0.f, 0.f};
        if (c0 >= 0 && c4 < nvalid) v[i] = ld4(src + (size_t)(k0 + kk) * ldsrc + c0 + c4);
    }
#pragma unroll
    for (int i = 0; i < 2 * KT; ++i) {
        const int kk = (tid >> 3) + 64 * i;
#pragma unroll
        for (int j = 0; j < 4; ++j) T[(c4 + j) * TS + kk] = (bf16_t)(pack_bf2(v[i][j], 0.f) & 0xffffu);
    }
    __syncthreads();
#pragma unroll
    for (int i = 0; i < KT; ++i) { const int ch = tid + 512 * i, col = ch / (16 * KT), kc = ch % (16 * KT);
      const u32x4 w = *(const LAS u32x4*)(T + col * TS + kc * 8);
      *(u32x4*)(dst + (size_t)(p0 + col) * lddst + k0 + kc * 8) = w; }
    __syncthreads();
}

DI void adaln_item(const Params& p, int slice, LAS unsigned char* lds) {
    const int tid = threadIdx.x, wid = tid >> 6, lane = tid & 63, l31 = lane & 31, hh = lane >> 5, n0 = slice * 96;
    constexpr int RS = 136, ABYTES = 160 * RS * 2, WBYTES = 96 * RS * 2, BUF = ABYTES + WBYTES;
    for (int i = tid; i < 2 * BUF / 16; i += 512) *(LAS u32x4*)(lds + i * 16) = (u32x4){0u, 0u, 0u, 0u};
    const int msub = tid >> 5, k4 = (tid & 31) * 4;
    const float* a0 = (msub < 8 ? p.c_prompt + (size_t)msub * DM : p.c_sample + (size_t)(msub - 8) * DM) + k4;
    const float* aS = p.c_sample + ((long)msub - 8) * DM + k4;
    const float* w0 = p.w_ada + n0;
    f32x4 ra[9], rw0[6], rw1[6];
#define ADA_ISSUE_A(KT) { ra[0] = ld4(a0 + (KT) * 128); _Pragma("unroll") for (int j = 1; j < 9; ++j) { ra[j] = (f32x4){0.f, 0.f, 0.f, 0.f}; if (j < 8 || msub < 8) ra[j] = ld4(aS + (size_t)j * 16 * DM + (KT) * 128); } }
#define ADA_ISSUE_W(RW, KT) { _Pragma("unroll") for (int j = 0; j < 3; ++j) { const int idx_ = tid + 512 * j, kp_ = idx_ / 24, c4_ = (idx_ % 24) * 4; \
        const float* wp_ = w0 + ((size_t)(KT) * 128 + 2 * kp_) * 12288 + c4_; RW[2 * j] = ld4(wp_); RW[2 * j + 1] = ld4(wp_ + 12288); } }
#define ADA_STASH(RW, BUFI) { LAS bf16_t* A_ = (LAS bf16_t*)(lds + (BUFI) * BUF); LAS bf16_t* W_ = (LAS bf16_t*)(lds + (BUFI) * BUF + ABYTES); \
        _Pragma("unroll") for (int j = 0; j < 9; ++j) { if (j < 8 || msub < 8) { f32x4 v = ra[j]; for (int i = 0; i < 4; ++i) v[i] = v[i] * fast_rcp(1.0f + fast_exp2(-LOG2E * v[i])); \
            u32x2 w_; w_[0] = pack_bf2(v[0], v[1]); w_[1] = pack_bf2(v[2], v[3]); *(LAS u32x2*)(A_ + (msub + 16 * j) * RS + k4) = w_; } } \
        _Pragma("unroll") for (int j = 0; j < 3; ++j) { const int idx_ = tid + 512 * j, kp_ = idx_ / 24, c4_ = (idx_ % 24) * 4; \
            _Pragma("unroll") for (int i = 0; i < 4; ++i) *(LAS unsigned*)(W_ + (c4_ + i) * RS + 2 * kp_) = pack_bf2(RW[2 * j][i], RW[2 * j + 1][i]); } }
    f32x16 acc[2]; acc[0] = zero16(); acc[1] = zero16();
    const int t0 = wid, t1 = wid + 8;
    ADA_ISSUE_A(0) ADA_ISSUE_W(rw0, 0) ADA_ISSUE_W(rw1, 1)
    __syncthreads();
#define ADA_COMPUTE(BUFI) { LAS const bf16_t* A = (LAS const bf16_t*)(lds + (BUFI) * BUF); LAS const bf16_t* W = (LAS const bf16_t*)(lds + (BUFI) * BUF + ABYTES); \
        _Pragma("unroll") for (int ks = 0; ks < 8; ++ks) { \
            { const bf16x8 a = *(LAS const bf16x8*)(A + ((t0 % 5) * 32 + l31) * RS + 16 * ks + 8 * hh); const bf16x8 w = *(LAS const bf16x8*)(W + ((t0 / 5) * 32 + l31) * RS + 16 * ks + 8 * hh); acc[0] = MFMA32(a, w, acc[0]); } \
            if (t1 < 15) { const bf16x8 a = *(LAS const bf16x8*)(A + ((t1 % 5) * 32 + l31) * RS + 16 * ks + 8 * hh); const bf16x8 w = *(LAS const bf16x8*)(W + ((t1 / 5) * 32 + l31) * RS + 16 * ks + 8 * hh); acc[1] = MFMA32(a, w, acc[1]); } } }
#pragma unroll 1
    for (int kt = 0; kt < 16; kt += 2) {
        ADA_STASH(rw0, 0)
        __syncthreads();
        ADA_ISSUE_A(kt + 1)
        if (kt + 2 < 16) ADA_ISSUE_W(rw0, kt + 2)
        ADA_COMPUTE(0)
        ADA_STASH(rw1, 1)
        __syncthreads();
        if (kt + 2 < 16) ADA_ISSUE_A(kt + 2)
        if (kt + 3 < 16) ADA_ISSUE_W(rw1, kt + 3)
        ADA_COMPUTE(1)
    }
#undef ADA_COMPUTE
#undef ADA_ISSUE_A
#undef ADA_ISSUE_W
#undef ADA_STASH
    float* mod = (float*)(p.ws + WS_MOD);
    int hh_ = hh, l31_ = l31; asm volatile("" : "+v"(hh_), "+v"(l31_));
#pragma unroll
    for (int q = 0; q < 2; ++q) { const int t = q ? t1 : t0; if (t < 15) { const int n = (t / 5) * 32 + l31_;
        if (n < 96) { const float bias = p.b_ada[n0 + n];
#pragma unroll
            for (int i = 0; i < 16; ++i) { const int m = (t % 5) * 32 + crow(i, hh_); if (m < 136) mod[(size_t)m * 12288 + n0 + n] = acc[q][i] + bias; } } } }
    __syncthreads();
}

DI void phase_A(const Params& p, LAS unsigned char* lds) {
    bf16_t* win_t = (bf16_t*)(p.ws + WS_WIN_T); bf16_t* wout_t = (bf16_t*)(p.ws + WS_WOUT_T); bf16_t* wq_t = (bf16_t*)(p.ws + WS_WQ_T);
    bf16_t* wcmp_t = (bf16_t*)(p.ws + WS_WCMP_T); bf16_t* wpool_t = (bf16_t*)(p.ws + WS_WPOOL_T);
    constexpr int T_ADA = 128, T_IN = 4 * 120, T_OUT = 4 * 64, T_Q = 0  , T_POOL = 4 * 8, T_CMP = 8 * 2 * 2 * 2, T_MISC = 8 + 112;
    constexpr int E0 = T_IN, E1 = E0 + T_OUT, E2 = E1 + T_Q, E3 = E2, E4 = E3 + T_POOL, E5 = E4 + T_CMP, E6 = E5 + T_MISC;
    const int tid = threadIdx.x;
    const int gh = (int)gridDim.x >> 1;
    if ((int)blockIdx.x < gh) {
#pragma unroll 1
        for (int sl = blockIdx.x; sl < T_ADA; sl += gh) adaln_item(p, sl, lds);
        return;
    }
#pragma unroll 1
    for (int it = (int)blockIdx.x - gh; it < E6; it += (int)gridDim.x - gh) {
        if (it < E0) { const int kt = it & 3, pt = it >> 2; const int p0 = pt * 32; const int c0 = win_logical(p0);
            int nv = 32; if (c0 >= 0 && win_logical(p0 + 31) < 0) nv = 16;
            transpose_tile<4>(p.w_in, 3632, kt * 512, c0, nv, win_t, DM, p0, lds); }
        else if (it < E1) { const int j = it - E0, kt = j & 3, pt = j >> 2; transpose_tile<4>(p.w_out, DM, kt * 512, pt * 32, 32, wout_t, DM, pt * 32, lds); }
        else if (it < E2) { const int j = it - E1, kt = j & 3, pt = j >> 2; transpose_tile<4>(p.peer_wq, DM, kt * 512, pt * 32, 32, wq_t, DM, pt * 32, lds); }
        else if (it < E4) { const int j = it - E3, gi = j >> 3, pt = j & 7;
            transpose_tile<2>(p.w_pool + (size_t)gi * 65536, 256, 0, pt * 32, 32, wpool_t + (size_t)gi * 65536, 256, pt * 32, lds); }
        else if (it < E5) { const int j = it - E4, cg = j >> 3, lohi = (j >> 2) & 1, kt = (j >> 1) & 1, pt = j & 1;
            transpose_tile<4>(p.w_cmp + ((size_t)cg * 32 + lohi * 16) * 4096, 64, kt * 512, pt * 32, 32, wcmp_t + (size_t)cg * 131072, 1024, lohi * 64 + pt * 32, lds); }
        else {
            const int j = it - E5;
            if (j < 8) {
                const int cg = j, e = tid & 63, part = tid >> 6, c = cg >> 2, g = cg & 3; float s = 0.f;
                for (int l = 4 * part; l < 4 * part + 4; ++l)
#pragma unroll 8
                    for (int d = 0; d < 64; ++d) s += p.cmp_pe[((c * 32 + l) * 4 + g) * 64 + d] * p.w_cmp[(((size_t)cg * 32 + l) * 64 + d) * 64 + e];
                LAS float* red = (LAS float*)lds; red[tid] = s;
                __syncthreads();
                if (tid < 64) { float t = 0.f; for (int q = 0; q < 8; ++q) t += red[q * 64 + tid]; ((float*)(p.ws + WS_PEBIAS))[cg * 64 + tid] = t; }
                __syncthreads();
            } else {
                const int q = j - 8;
                for (int i = 0; i < 4; ++i) { const size_t f = (size_t)q * 8192 + (size_t)(i * 512 + tid) * 4; const size_t b = f / 7168, rem = f % 7168;
                    st4(p.out + O_POOL_S + b * 15360 + rem, ld4(p.state_pool + b * 15360 + 8 * 1024 + rem)); }
            }
        }
    }
}

DI void transpose_wq(const Params& p, int first_blk, LAS unsigned char* lds) {
    bf16_t* wq_t = (bf16_t*)(p.ws + WS_WQ_T);
#pragma unroll 1
    for (int j = (int)blockIdx.x - first_blk; j < 4 * 64; j += (int)gridDim.x - first_blk) { const int kt = j & 3, pt = j >> 2; transpose_tile<4>(p.peer_wq, DM, kt * 512, pt * 32, 32, wq_t, DM, pt * 32, lds); }
}

DI void phase_B_stream(const Params& p, int first_blk, int part, LAS unsigned char* lds) {
    const int tid = threadIdx.x, wid = tid >> 6, lane = tid & 63;
    const int nw = (gridDim.x - first_blk) * 8, wi = (blockIdx.x - first_blk) * 8 + wid;
    constexpr int C_U = 16384, C_V = 16384, C_SK = 128, C_WIN = 128 * 126, C_END = C_U + C_V + C_SK + C_WIN;
    unsigned char* u4 = p.ws + WS_U; unsigned char* v4 = p.ws + WS_V; bf16_t* sk = (bf16_t*)(p.ws + WS_SUBK);
    unsigned char* su = p.ws + WS_USCALE; unsigned char* sv = p.ws + WS_VSCALE;
    LAS f32x4* T = (LAS f32x4*)(lds + wid * 8192);
    const int nitems = part == 0 ? C_U + C_SK + C_WIN / 2 : C_V + C_WIN / 2;
    for (int it = wi; it < nitems; it += nw) {
        int c;
        if (part == 0) c = it < C_U ? it : (it < C_U + C_SK ? C_U + C_V + (it - C_U) : C_U + C_V + C_SK + (it - C_U - C_SK));
        else c = it < C_V ? C_U + it : C_U + C_V + C_SK + C_WIN / 2 + (it - C_V);
        if (c < C_U + C_V) {
            const bool isV = c >= C_U; const int r = isV ? c - C_U : c;
            const float* src = (isV ? p.peer_v : p.peer_u) + (size_t)r * 2048;
            f32x4 v[8];
#pragma unroll
            for (int j = 0; j < 8; ++j) v[j] = __builtin_nontemporal_load((const f32x4*)(src + j * 256 + lane * 4));
#pragma unroll
            for (int j = 0; j < 8; ++j) T[j * 64 + lane] = v[j];
            asm volatile("s_waitcnt lgkmcnt(0)" ::: "memory");
#pragma unroll
            for (int q = 0; q < 8; ++q) v[q] = T[8 * lane + q];
            asm volatile("s_waitcnt lgkmcnt(0)" ::: "memory");
            float am = 0.f, ss = 0.f;
#pragma unroll
            for (int j = 0; j < 8; ++j) for (int i = 0; i < 4; ++i) { am = fmaxf(am, fabsf(v[j][i])); ss += v[j][i] * v[j][i]; }
#pragma unroll
            for (int o = 32; o >= 1; o >>= 1) { am = fmaxf(am, __shfl_xor(am, o)); ss += __shfl_xor(ss, o); }
            const float scale = fmaxf(fmaxf(0.5f * __builtin_sqrtf(ss * (1.0f / 2048.0f)), am * 0.125f), 1.0e-30f), inv = 1.0f / scale;
#pragma unroll
            for (int j = 0; j < 8; ++j) for (int i = 0; i < 4; ++i) v[j][i] = fminf(fmaxf(v[j][i] * inv, -6.0f), 6.0f);
            u32x4 w;
#pragma unroll
            for (int j = 0; j < 4; ++j) { unsigned d = 0u; const f32x4 a = v[2 * j], c2 = v[2 * j + 1];
                d = __builtin_amdgcn_cvt_scalef32_pk_fp4_f32(d, a[0], a[1], 1.0f, 0); d = __builtin_amdgcn_cvt_scalef32_pk_fp4_f32(d, a[2], a[3], 1.0f, 1);
                d = __builtin_amdgcn_cvt_scalef32_pk_fp4_f32(d, c2[0], c2[1], 1.0f, 2); d = __builtin_amdgcn_cvt_scalef32_pk_fp4_f32(d, c2[2], c2[3], 1.0f, 3);
                w[j] = d; }
            *(u32x4*)((isV ? v4 : u4) + (size_t)r * 1024 + lane * 16) = w;
            if (lane == 0) ((float*)(isV ? sv : su))[r] = scale;
        } else if (c < C_U + C_V + C_SK) { const int r = c - C_U - C_V;
#pragma unroll
            for (int j = 0; j < 8; ++j) st_bf4(sk + (size_t)r * 2048 + j * 256 + lane * 4, ld4(p.peer_subkeys + (size_t)r * 2048 + j * 256 + lane * 4));
        } else { const int r = c - C_U - C_V - C_SK, b = r / 126, q = r % 126;
            const float* src = p.cache_win + (size_t)b * 262144 + 4096 + (size_t)q * 2048; float* dst = p.out + O_WIN_S + (size_t)b * 262144 + (size_t)q * 2048;
            f32x4 v[8];
#pragma unroll
            for (int j = 0; j < 8; ++j) v[j] = __builtin_nontemporal_load((const f32x4*)(src + j * 256 + lane * 4));
#pragma unroll
            for (int j = 0; j < 8; ++j) __builtin_nontemporal_store(v[j], (f32x4*)(dst + j * 256 + lane * 4)); }
    }
}

DI void phase_modulate(const Params& p, int which) {
    const int tid = threadIdx.x, wid = tid >> 6, lane = tid & 63;
    const float* mod = (const float*)(p.ws + WS_MOD); bf16_t* h = (bf16_t*)(p.ws + WS_H);
    const float* gn = which ? p.g_norm2 : p.g_norm1;
    f32x4 cm[8], sh[8];
    auto load_mod = [&](int mrow) __attribute__((always_inline)) {
        const float* shift = mod + (size_t)mrow * 12288 + (which ? 3 : 0) * DM; const float* scale = shift + DM;
#pragma unroll
        for (int j = 0; j < 4; ++j) { const int c = j * 512 + lane * 8;
            cm[2 * j] = ld4(gn + c) * (ld4(scale + c) + 1.0f); cm[2 * j + 1] = ld4(gn + c + 4) * (ld4(scale + c + 4) + 1.0f);
            sh[2 * j] = ld4(shift + c); sh[2 * j + 1] = ld4(shift + c + 4); } };
    auto do_row = [&](int row) __attribute__((always_inline)) {
        const float* src = row < NP ? p.x_prompt + (size_t)row * DM : p.x_sample + (size_t)(row - NP) * DM;
        const bf16_t* srcb = (const bf16_t*)(p.ws + WS_X1) + (size_t)row * DM;
        f32x4 v[8]; float ss = 0.f;
        if (which) {
#pragma unroll
            for (int j = 0; j < 4; ++j) { const u32x4 q = __builtin_nontemporal_load((const u32x4*)(srcb + j * 512 + lane * 8));
                v[2 * j] = (f32x4){bf_lo(q[0]), bf_hi(q[0]), bf_lo(q[1]), bf_hi(q[1])}; v[2 * j + 1] = (f32x4){bf_lo(q[2]), bf_hi(q[2]), bf_lo(q[3]), bf_hi(q[3])}; } }
        else {
#pragma unroll
            for (int j = 0; j < 4; ++j) { v[2 * j] = __builtin_nontemporal_load((const f32x4*)(src + j * 512 + lane * 8)); v[2 * j + 1] = __builtin_nontemporal_load((const f32x4*)(src + j * 512 + lane * 8 + 4)); } }
#pragma unroll
        for (int j = 0; j < 8; ++j) for (int i = 0; i < 4; ++i) ss += v[j][i] * v[j][i];
#pragma unroll
        for (int o = 32; o >= 1; o >>= 1) ss += __shfl_xor(ss, o);
        const float rstd = __builtin_amdgcn_rsqf(ss * (1.0f / 2048.0f) + 1e-6f);
#pragma unroll
        for (int j = 0; j < 4; ++j) {
            const int c = j * 512 + lane * 8;
            const f32x4 a = v[2 * j] * rstd * cm[2 * j] + sh[2 * j], b = v[2 * j + 1] * rstd * cm[2 * j + 1] + sh[2 * j + 1];
            u32x4 w; w[0] = pack_bf2(a[0], a[1]); w[1] = pack_bf2(a[2], a[3]); w[2] = pack_bf2(b[0], b[1]); w[3] = pack_bf2(b[2], b[3]);
            *(u32x4*)(h + (size_t)row * DM + c) = w;
        } };
    const int nwv = (int)gridDim.x * 8, gw = (int)blockIdx.x * 8 + wid;
#pragma unroll 1
    for (int ch = gw; ch < NP / 8; ch += nwv) {
        load_mod((ch * 8) >> 11);
#pragma unroll 1
        for (int r = 0; r < 8; ++r) do_row(ch * 8 + r);
    }
#pragma unroll 1
    for (int s_ = wid * (int)gridDim.x + (int)blockIdx.x; s_ < NTOK - NP; s_ += nwv) { load_mod(8 + (s_ >> 3)); do_row(NP + s_); }
}
DI void cmp_unit(const Params& p, int unit, LAS unsigned char* lds) {
    const int tid = threadIdx.x, wid = tid >> 6, lane = tid & 63, l31 = lane & 31, hh = lane >> 5;
    const bool isP = unit >= 2048;
    const int u = isP ? unit - 2048 : unit, b = u >> 4, mh = (u >> 3) & 1, cg = u & 7;
    constexpr int RS = 136;
    constexpr int ABYTES = 64 * RS * 2, WBYTES = 128 * RS * 2, BUF = ABYTES + WBYTES;
    const int d4 = tid & 15, lsl = (tid >> 4) & 1, ch0 = tid >> 5;
    const float* abase[4];
#pragma unroll
    for (int j = 0; j < 4; ++j) {
        const int ch = ch0 + 16 * j, chg = mh * 64 + ch;
        if (isP) abase[j] = p.out + O_CMP_P + ((size_t)b * 2048 + chg * 16 + lsl) * 512 + cg * 64 + d4 * 4;
        else { const int page = p.page_table[b * 16 + (chg >> 3)]; abase[j] = p.cache_cmp + ((size_t)page * 128 + (chg & 7) * 16 + lsl) * 512 + cg * 64 + d4 * 4; }
    }
    const bf16_t* wbase = (const bf16_t*)(p.ws + WS_WCMP_T) + ((size_t)cg * 128 + (tid >> 4)) * 1024 + (tid & 15) * 8;
    f32x4 ra0[4], ra1[4]; u32x4 rw0[4], rw1[4];
#define CMP_ISSUE(RA, RW, S) { _Pragma("unroll") for (int j = 0; j < 4; ++j) { RA[j] = __builtin_nontemporal_load((const f32x4*)(abase[j] + (size_t)(S) * 1024)); RW[j] = *(const u32x4*)(wbase + (size_t)j * 32 * 1024 + (S) * 128); } }
#define CMP_STASH(RA, RW, BUFI) { LAS unsigned char* A_ = lds + (BUFI) * BUF; LAS unsigned char* W_ = A_ + ABYTES; _Pragma("unroll") for (int j = 0; j < 4; ++j) { \
            u32x2 w_; w_[0] = pack_bf2(RA[j][0], RA[j][1]); w_[1] = pack_bf2(RA[j][2], RA[j][3]); \
            *(LAS u32x2*)(A_ + ((ch0 + 16 * j) * RS + lsl * 64 + d4 * 4) * 2) = w_; \
            *(LAS u32x4*)(W_ + (((tid >> 4) + 32 * j) * RS + (tid & 15) * 8) * 2) = RW[j]; } }
    const int mt = wid >> 2, nt = wid & 3;
    f32x16 acc = zero16();
    CMP_ISSUE(ra0, rw0, 0) CMP_ISSUE(ra1, rw1, 1)
#pragma unroll
    for (int s = 0; s < 8; ++s) {
        if (s & 1) CMP_STASH(ra1, rw1, 1) else CMP_STASH(ra0, rw0, 0)
        __syncthreads();
        if (s + 2 < 8) { if (s & 1) CMP_ISSUE(ra1, rw1, s + 2) else CMP_ISSUE(ra0, rw0, s + 2) }
        __builtin_amdgcn_sched_barrier(0);
        LAS const unsigned char* A = lds + (s & 1) * BUF; LAS const unsigned char* W = A + ABYTES;
        LAS const unsigned char* ar = A + ((mt * 32 + l31) * RS + 8 * hh) * 2; LAS const unsigned char* wr = W + ((nt * 32 + l31) * RS + 8 * hh) * 2;
#pragma unroll
        for (int ks = 0; ks < 8; ++ks) { const bf16x8 a = *(LAS const bf16x8*)(ar + ks * 32); const bf16x8 w = *(LAS const bf16x8*)(wr + ks * 32); acc = MFMA32(a, w, acc); }
        __builtin_amdgcn_sched_barrier(0);
    }
#undef CMP_ISSUE
#undef CMP_STASH
    bf16_t* part = (bf16_t*)(p.ws + (isP ? WS_PART_P : WS_PART_S));
#pragma unroll
    for (int i = 0; i < 16; ++i) {
        const int chg = mh * 64 + mt * 32 + crow(i, hh);
        const float nb = __shfl_xor(acc[i], 1);
        if (!(lane & 1)) *(unsigned*)(part + (((size_t)b * 128 + chg) * 8 + cg) * 128 + nt * 32 + l31) = pack_bf2(acc[i], nb);
    }
    __syncthreads();
}

DI void pool_unit(const Params& p, int unit, LAS unsigned char* lds) {
    const int tid = threadIdx.x, wid = tid >> 6, lane = tid & 63;
    const int tile = unit >> 2, gi = unit & 3, w = 2 << gi;
    const int row0 = tile * 128; const bool isS = row0 >= NP;
    const bf16_t* ubf = (const bf16_t*)(p.ws + WS_UBF);
    constexpr int AST = 264;
    LAS bf16_t* A = (LAS bf16_t*)lds;
    LAS bf16_t* E = (LAS bf16_t*)(lds + 128 * AST * 2);
    const bf16_t* wg = (const bf16_t*)(p.ws + WS_WPOOL_T) + (size_t)gi * 65536;
    u32x4 wr[8], wr1[8];
#define POOL_ISSUE_W { _Pragma("unroll") for (int j = 0; j < 8; ++j) { const int ch = tid + 512 * j, n = ch >> 4, k8 = (ch & 15) * 8; wr[j] = *(const u32x4*)(wg + (size_t)n * 256 + k8); wr1[j] = *(const u32x4*)(wg + (size_t)n * 256 + 128 + k8); } }
    if (!isS) {
        const int t0 = row0 & 2047;
        u32x4 q[9];
#pragma unroll
        for (int i = 0; i < 9; ++i) { const int idx = tid + 512 * i, r = idx >> 5, c8 = (idx & 31) * 8;
            q[i] = (u32x4){0u, 0u, 0u, 0u};
            if (idx < 143 * 32 && t0 - 15 + r >= 0) q[i] = *(const u32x4*)(ubf + (size_t)(row0 - 15 + r) * 1024 + gi * 256 + c8); }
        asm volatile("" ::: "memory");
        POOL_ISSUE_W
#pragma unroll
        for (int i = 0; i < 9; ++i) { const int idx = tid + 512 * i, r = idx >> 5, c8 = (idx & 31) * 8;
            if (idx < 143 * 32) *(LAS u32x4*)(E + r * AST + c8) = q[i]; }
        __syncthreads();
#pragma unroll 1
        for (int it = tid; it < 128 * 32; it += 512) {
            const int r = it >> 5, c8 = (it & 31) * 8, t = t0 + r;
            float sum[8]; for (int i = 0; i < 8; ++i) sum[i] = 0.f;
#pragma unroll 4
            for (int j = 0; j < w; ++j) { const u32x4 q = *(LAS const u32x4*)(E + (r + 15 - j) * AST + c8);
                for (int i = 0; i < 4; ++i) { sum[2 * i] += bf_lo(q[i]); sum[2 * i + 1] += bf_hi(q[i]); } }
            const u32x4 qs = *(LAS const u32x4*)(E + (r + 15) * AST + c8);
            const float inv = 1.0f / (float)(t + 1 < w ? t + 1 : w);
            u32x4 o;
            for (int i = 0; i < 4; ++i) o[i] = pack_bf2(sum[2 * i] * inv - bf_lo(qs[i]), sum[2 * i + 1] * inv - bf_hi(qs[i]));
            *(LAS u32x4*)(A + r * AST + c8) = o;
        }
    } else {
        POOL_ISSUE_W
#pragma unroll 1
        for (int it = tid; it < 128 * 32; it += 512) {
            const int r = it >> 5, c8 = (it & 31) * 8, row = row0 + r, col = gi * 256 + c8;
            const int bb = (row - NP) >> 3, t = (row - NP) & 7;
            float sum[8], self[8]; for (int i = 0; i < 8; ++i) { sum[i] = 0.f; self[i] = 0.f; }
#pragma unroll 4
            for (int j = 0; j < w; ++j) {
                const int tt = t - j; float x[8];
                if (tt >= 0) { const u32x4 q = *(const u32x4*)(ubf + (size_t)(row - j) * 1024 + col);
                    for (int i = 0; i < 4; ++i) { x[2 * i] = bf_lo(q[i]); x[2 * i + 1] = bf_hi(q[i]); } }
                else { const float* sp = p.state_pool + ((size_t)bb * 15 + 15 + tt) * 1024 + col; const f32x4 a = ld4(sp), c = ld4(sp + 4);
                    for (int i = 0; i < 4; ++i) { x[i] = a[i]; x[4 + i] = c[i]; } }
                for (int i = 0; i < 8; ++i) sum[i] += x[i];
                if (j == 0) for (int i = 0; i < 8; ++i) self[i] = x[i];
            }
            const float inv = 1.0f / (float)w;
            u32x4 o;
            for (int i = 0; i < 4; ++i) o[i] = pack_bf2(sum[2 * i] * inv - self[2 * i], sum[2 * i + 1] * inv - self[2 * i + 1]);
            *(LAS u32x4*)(A + r * AST + c8) = o;
        }
    }
#undef POOL_ISSUE_W
    __syncthreads();
    const int wm = wid >> 1, wn = wid & 1, l31 = lane & 31, hh = lane >> 5;
    LAS bf16_t* WL = (LAS bf16_t*)(lds + 128 * AST * 2);
    LAS const bf16_t* arow = A + (wm * 32 + l31) * AST + 8 * hh;
    f32x16 acc[4]; for (int i = 0; i < 4; ++i) acc[i] = zero16();
#pragma unroll
    for (int half = 0; half < 2; ++half) {
        if (half) __syncthreads();
#pragma unroll
        for (int j = 0; j < 8; ++j) { const int ch = tid + 512 * j, n = ch >> 4, k8 = (ch & 15) * 8; *(LAS u32x4*)(WL + n * 136 + k8) = wr[j]; }
        __syncthreads();
        if (half == 0) {
#pragma unroll
            for (int j = 0; j < 8; ++j) wr[j] = wr1[j]; }
#pragma unroll
        for (int s = 0; s < 8; ++s) {
            const bf16x8 a = *(LAS const bf16x8*)(arow + (half * 8 + s) * 16);
#pragma unroll
            for (int nt = 0; nt < 4; ++nt) { const bf16x8 wv = *(LAS const bf16x8*)(WL + (wn * 128 + nt * 32 + l31) * 136 + s * 16 + 8 * hh); acc[nt] = MFMA32(wv, a, acc[nt]); }
        }
    }
    __syncthreads();
    LAS bf16_t* O = (LAS bf16_t*)lds;
#pragma unroll
    for (int nt = 0; nt < 4; ++nt)
#pragma unroll
        for (int gq = 0; gq < 4; ++gq) {
            const int nl = wn * 128 + nt * 32 + 8 * gq + 4 * hh;
            const f32x4 ps = ld4(p.pool_scale + gi * 256 + nl);
            u32x2 w; w[0] = pack_bf2(acc[nt][4 * gq] * ps[0], acc[nt][4 * gq + 1] * ps[1]); w[1] = pack_bf2(acc[nt][4 * gq + 2] * ps[2], acc[nt][4 * gq + 3] * ps[3]);
            *(LAS u32x2*)(O + (wm * 32 + l31) * AST + nl) = w;
        }
    __syncthreads();
    bf16_t* ocat = (bf16_t*)(p.ws + WS_OCAT);
#pragma unroll
    for (int j = 0; j < 8; ++j) { const int ch = tid + 512 * j, r = ch >> 5, c8 = (ch & 31) * 8;
        *(u32x4*)(ocat + (size_t)(row0 + r) * DM + 1024 + gi * 256 + c8) = *(LAS const u32x4*)(O + r * AST + c8); }
    __syncthreads();
}
struct AttnSt { float m, l; f32x16 o0, o1; };
DI void attn_init(AttnSt& s) { s.m = NEGBIG; s.l = 0.f; s.o0 = zero16(); s.o1 = zero16(); }
constexpr int KST = 72, VST = 68, CVST = 136;
constexpr int KVBUF = 64 * KST * 2 + 64 * VST * 2;

DI float xhalf_max(float v) { return fmaxf(v, __shfl_xor(v, 32)); }
DI float xhalf_sum(float v) { return v + __shfl_xor(v, 32); }

template <int MODE, bool FULL = false>
DI void attn_tile64(LAS const bf16_t* Kb, LAS const bf16_t* Vt, const bf16x8 (&qf)[4], int rel, float slope2, bool allow, int lane, AttnSt& st) {
    const int l31 = lane & 31, hh = lane >> 5;
    const int relh = rel - 4 * hh;
    float sl = slope2; asm volatile("" : "+v"(sl));
    const float base = allow ? -sl * (float)relh : NEGBIG;
    const f32x2 bA = {0.f, sl}, bB = {2.0f * sl, 3.0f * sl};
    f32x16 sacc[2];
#pragma unroll
    for (int kt = 0; kt < 2; ++kt) {
#pragma unroll
        for (int q4 = 0; q4 < 4; ++q4) {
            const float gb = __builtin_fmaf(sl, (float)(32 * kt + 8 * q4), base);
            const f32x2 g2 = {gb, gb}, lo2 = g2 + bA, hi2 = g2 + bB;
            sacc[kt][4 * q4] = lo2[0]; sacc[kt][4 * q4 + 1] = lo2[1]; sacc[kt][4 * q4 + 2] = hi2[0]; sacc[kt][4 * q4 + 3] = hi2[1];
        }
#pragma unroll
        for (int s = 0; s < 4; ++s) { const bf16x8 a = *(LAS const bf16x8*)(Kb + (32 * kt + l31) * KST + 16 * s + 8 * hh); sacc[kt] = MFMA32(a, qf[s], sacc[kt]); } }
    float mx = NEGBIG;
#pragma unroll
    for (int kt = 0; kt < 2; ++kt)
#pragma unroll
        for (int i = 0; i < 16; ++i) {
            if (!FULL) { const int ci = 32 * kt + (i & 3) + 8 * (i >> 2); bool valid = (ci <= relh); if (MODE == 1) valid = valid && (relh - ci <= 512); sacc[kt][i] = valid ? sacc[kt][i] : NEGBIG; }
            mx = fmaxf(mx, sacc[kt][i]);
        }
    mx = xhalf_max(mx);
    const float m_new = fmaxf(fmaxf(st.m, mx), -1.0e20f);
    const float alpha = fast_exp2(st.m - m_new);
    const f32x2 mneg = {-m_new, -m_new};
    f32x2 rs2 = {0.f, 0.f};
    if (!__all(alpha == 1.0f)) { st.o0 *= alpha; st.o1 *= alpha; }
#pragma unroll
    for (int kt = 0; kt < 2; ++kt) {
#pragma unroll
        for (int i = 0; i < 8; ++i) { f32x2 d = {sacc[kt][2 * i], sacc[kt][2 * i + 1]}; d += mneg; d[0] = fast_exp2(d[0]); d[1] = fast_exp2(d[1]);
            sacc[kt][2 * i] = d[0]; sacc[kt][2 * i + 1] = d[1]; rs2 += d; }
#pragma unroll
        for (int s2 = 0; s2 < 2; ++s2) {
            const bf16x8 pf = pack_step(sacc[kt], s2);
            const int kb = 32 * kt + 16 * s2 + 4 * hh;
#pragma unroll
            for (int dt = 0; dt < 2; ++dt) {
                LAS const bf16_t* vp = Vt + (32 * dt + l31) * VST + kb;
                const s16x4 lo = *(LAS const s16x4*)vp, hi = *(LAS const s16x4*)(vp + 8);
                const bf16x8 vf = __builtin_shufflevector(lo, hi, 0, 1, 2, 3, 4, 5, 6, 7);
                if (dt == 0) st.o0 = MFMA32(vf, pf, st.o0); else st.o1 = MFMA32(vf, pf, st.o1);
            }
        }
        if (kt == 0) __builtin_amdgcn_sched_barrier(0);
    }
    float rs = rs2[0] + rs2[1];
    rs = xhalf_sum(rs);
    st.l = st.l * alpha + rs; st.m = m_new;
}

DI void attn_cmp(LAS const bf16_t* Kc, LAS const bf16_t* Vct, const bf16x8 (&qf)[4], int t, float slope2, int ntile, int lane, f32x16& oc0, f32x16& oc1, float (&imp)[16]) {
    const int l31 = lane & 31, hh = lane >> 5;
    const float c1 = 1.0f;
    int nmax = (t - 31) >> 4; nmax = nmax > 126 ? 126 : nmax;
    const int nmaxh = nmax - 4 * hh;
    const float base = -slope2 * (float)(t - 31 - 64 * hh), s16 = slope2 * 16.0f;
    float mx = NEGBIG;
#pragma unroll
    for (int kt = 0; kt < 4; ++kt) {
        if (kt < ntile) {
            f32x16 sacc = zero16();
#pragma unroll
            for (int s = 0; s < 4; ++s) { const bf16x8 a = *(LAS const bf16x8*)(Kc + (32 * kt + l31) * KST + 16 * s + 8 * hh); sacc = MFMA32(a, qf[s], sacc); }
#pragma unroll
            for (int i = 0; i < 16; ++i) {
                const int ci = 32 * kt + (i & 3) + 8 * (i >> 2);
                const float sc = __builtin_fmaf(sacc[i], c1, __builtin_fmaf(s16, (float)ci, base));
                mx = fmaxf(mx, (ci <= nmaxh) ? sc : NEGBIG);
            }
        }
    }
    mx = fmaxf(xhalf_max(mx), -1.0e20f);
    float sum = 0.f, prevc = 0.f;
    oc0 = zero16(); oc1 = zero16();
#pragma unroll
    for (int j = 0; j < 16; ++j) imp[j] = 0.f;
#pragma unroll
    for (int kt = 0; kt < 4; ++kt) {
        if (kt < ntile) {
            f32x16 sacc = zero16();
#pragma unroll
            for (int s = 0; s < 4; ++s) { const bf16x8 a = *(LAS const bf16x8*)(Kc + (32 * kt + l31) * KST + 16 * s + 8 * hh); sacc = MFMA32(a, qf[s], sacc); }
#pragma unroll
            for (int i = 0; i < 16; ++i) {
                const int ci = 32 * kt + (i & 3) + 8 * (i >> 2);
                float sc = __builtin_fmaf(sacc[i], c1, __builtin_fmaf(s16, (float)ci, base));
                sc = (ci <= nmaxh) ? sc : NEGBIG;
                const float e = fast_exp2(sc - mx); sacc[i] = e; sum += e;
            }
            float co[4];
#pragma unroll
            for (int gq = 0; gq < 4; ++gq) { const float p3 = 0.5f * sacc[4 * gq + 3];
                imp[4 * kt + gq] = sacc[4 * gq] + sacc[4 * gq + 1] + sacc[4 * gq + 2] + p3; co[gq] = __shfl_xor(p3, 32); }
#pragma unroll
            for (int gq = 0; gq < 4; ++gq) imp[4 * kt + gq] += hh ? co[gq] : (gq > 0 ? co[gq - 1] : prevc);
            prevc = co[3];
#pragma unroll
            for (int s2 = 0; s2 < 2; ++s2) {
                const bf16x8 pf = pack_step(sacc, s2);
                const int kb = 32 * kt + 16 * s2 + 4 * hh;
#pragma unroll
                for (int dt = 0; dt < 2; ++dt) {
                    LAS const bf16_t* vp = Vct + (32 * dt + l31) * CVST + kb;
                    const s16x4 lo = *(LAS const s16x4*)vp, hi = *(LAS const s16x4*)(vp + 8);
                    const bf16x8 vf = __builtin_shufflevector(lo, hi, 0, 1, 2, 3, 4, 5, 6, 7);
                    if (dt == 0) oc0 = MFMA32(vf, pf, oc0); else oc1 = MFMA32(vf, pf, oc1);
                }
            }
        }
    }
    sum = xhalf_sum(sum);
    const float inv = 1.0f / fmaxf(sum, 1.0e-30f);
#pragma unroll
    for (int j = 0; j < 16; ++j) imp[j] *= inv;
    oc0 *= inv; oc1 *= inv;
}

DI void load_cmp(const bf16_t* part_b, const float* pebias, const float* gk0, int g, int nkeys, LAS bf16_t* Kc, LAS bf16_t* Vct) {
    const int tid = threadIdx.x, e8 = (tid & 7) * 8, n0 = tid >> 3;
    const f32x4 c0 = ld4(pebias + g * 64 + e8), c1 = ld4(pebias + g * 64 + e8 + 4), h0 = ld4(pebias + (4 + g) * 64 + e8), h1 = ld4(pebias + (4 + g) * 64 + e8 + 4);
    const f32x4 g0 = ld4(gk0 + e8), g1 = ld4(gk0 + e8 + 4);
    u32x4 q[2][4];
#pragma unroll
    for (int it = 0; it < 2; ++it) { const int n = n0 + 64 * it;
#pragma unroll
        for (int j = 0; j < 4; ++j) q[it][j] = (u32x4){0u, 0u, 0u, 0u};
        if (n < nkeys && n <= 126) {
            const bf16_t* lo = part_b + ((size_t)n * 8) * 128; const bf16_t* hi = part_b + ((size_t)(n + 1) * 8) * 128 + 64;
            q[it][0] = *(const u32x4*)(lo + g * 128 + e8); q[it][1] = *(const u32x4*)(hi + g * 128 + e8);
            q[it][2] = *(const u32x4*)(lo + (4 + g) * 128 + e8); q[it][3] = *(const u32x4*)(hi + (4 + g) * 128 + e8);
        } }
#pragma unroll
    for (int it = 0; it < 2; ++it) { const int n = n0 + 64 * it;
        if (n < nkeys) {
            float xk[8], xv[8];
            if (n <= 126) { for (int i = 0; i < 4; ++i) {
                    xk[2 * i] = bf_lo(q[it][0][i]) + bf_lo(q[it][1][i]) + (i < 2 ? c0[2 * i] : c1[2 * i - 4]); xk[2 * i + 1] = bf_hi(q[it][0][i]) + bf_hi(q[it][1][i]) + (i < 2 ? c0[2 * i + 1] : c1[2 * i - 3]);
                    xv[2 * i] = bf_lo(q[it][2][i]) + bf_lo(q[it][3][i]) + (i < 2 ? h0[2 * i] : h1[2 * i - 4]); xv[2 * i + 1] = bf_hi(q[it][2][i]) + bf_hi(q[it][3][i]) + (i < 2 ? h0[2 * i + 1] : h1[2 * i - 3]); } }
            else { for (int i = 0; i < 8; ++i) { xk[i] = 0.f; xv[i] = 0.f; } }
            float ss = 0.f; for (int i = 0; i < 8; ++i) ss += xk[i] * xk[i];
            ss += __shfl_xor(ss, 1); ss += __shfl_xor(ss, 2); ss += __shfl_xor(ss, 4);
            const float rstd = __builtin_amdgcn_rsqf(ss * (1.0f / 64.0f) + 1e-6f);
            u32x4 w; for (int i = 0; i < 2; ++i) { w[i] = pack_bf2(xk[2 * i] * rstd * g0[2 * i], xk[2 * i + 1] * rstd * g0[2 * i + 1]); w[2 + i] = pack_bf2(xk[4 + 2 * i] * rstd * g1[2 * i], xk[5 + 2 * i] * rstd * g1[2 * i + 1]); }
            *(LAS u32x4*)(Kc + n * KST + e8) = w;
            for (int i = 0; i < 8; ++i) Vct[(e8 + i) * CVST + n] = (bf16_t)(pack_bf2(xv[i], 0.f) & 0xffffu);
        } }
}

DI void attn_unit_P(const Params& p, int b, int g, int qt, LAS unsigned char* lds) {
    const int tid = threadIdx.x, wid = tid >> 6, lane = tid & 63, l31 = lane & 31, hh = lane >> 5;
    const int r = wid & 3, qh = wid >> 2, head = 4 * g + r;
    const int ql = 32 * qh + l31, t = 64 * qt + ql, row = b * 2048 + t;
    const float slope2 = fast_exp2(-0.5f * (float)(head + 1)) * LOG2E;
    const bf16_t* qbf = (const bf16_t*)(p.ws + WS_Q);
    bf16x8 qf[4];
#pragma unroll
    for (int s = 0; s < 4; ++s) qf[s] = *(const bf16x8*)(qbf + (size_t)row * 1024 + head * 64 + 16 * s + 8 * hh);
    LAS bf16_t* Kc = (LAS bf16_t*)lds; LAS bf16_t* Vct = (LAS bf16_t*)(lds + 128 * KST * 2);
    LAS float* impbuf = (LAS float*)(lds + 2 * KVBUF);
    LAS float* impsum = impbuf + 4 * 64 * 33;
    LAS unsigned* selm = (LAS unsigned*)(impsum + 64 * 33);
    const float* gt = (const float*)(p.ws + WS_GATES) + (size_t)row * 48 + head * 3;
    const float g0 = gt[0], g1 = gt[1], g2 = gt[2];
    LAS float* cacc = (LAS float*)(lds + 81920 + wid * 8704) + l31 * 68 + 4 * hh;
    {
        int n_hi = 4 * qt + 2; n_hi = n_hi > 126 ? 126 : n_hi; const int ntile = (n_hi >> 5) + 1;
        load_cmp((const bf16_t*)(p.ws + WS_PART_P) + (size_t)b * 131072, (const float*)(p.ws + WS_PEBIAS), p.g_knorm, g, 32 * ntile, Kc, Vct);
        if (tid < 65) selm[tid] = 0u;
        __syncthreads();
        float imp[16]; f32x16 oc0, oc1;
        attn_cmp(Kc, Vct, qf, t, slope2, ntile, lane, oc0, oc1, imp);
#pragma unroll
        for (int gq = 0; gq < 4; ++gq) { *(LAS f32x4*)(cacc + 8 * gq) = (f32x4){oc0[4 * gq], oc0[4 * gq + 1], oc0[4 * gq + 2], oc0[4 * gq + 3]} * g0; *(LAS f32x4*)(cacc + 32 + 8 * gq) = (f32x4){oc1[4 * gq], oc1[4 * gq + 1], oc1[4 * gq + 2], oc1[4 * gq + 3]} * g0; }
#pragma unroll
        for (int j = 0; j < 16; ++j) impbuf[(r * 64 + ql) * 33 + 8 * (j >> 2) + 2 * (j & 3) + hh] = imp[j];
        __syncthreads();
    }
    unsigned mysel, un;
    if (qt >= 16) {
        const int q = tid >> 3, sub = tid & 7;
#pragma unroll
        for (int j = 0; j < 4; ++j) { const int s = sub * 4 + j; impsum[q * 33 + s] = (impbuf[(0 * 64 + q) * 33 + s] + impbuf[(1 * 64 + q) * 33 + s]) + (impbuf[(2 * 64 + q) * 33 + s] + impbuf[(3 * 64 + q) * 33 + s]); }
        __syncthreads();
        unsigned bits = 0u;
        for (int j = 0; j < 4; ++j) { const int s = sub * 4 + j;
            if (s >= 1 && s <= qt - 2) { const float v = impsum[q * 33 + s]; int cnt = 0;
                for (int s2 = 1; s2 <= qt - 2; ++s2) { const float v2 = impsum[q * 33 + s2]; cnt += (v2 > v || (v2 == v && s2 < s)) ? 1 : 0; }
                if (cnt < 13) bits |= 1u << s; } }
        bits |= __shfl_xor(bits, 1); bits |= __shfl_xor(bits, 2); bits |= __shfl_xor(bits, 4);
        bits |= 1u | (1u << qt) | (1u << (qt - 1));
        if (sub == 0) { selm[q] = bits; atomicOr((unsigned*)(selm + 64), bits); }
        __syncthreads();
        mysel = selm[ql]; un = selm[64];
    } else { mysel = (2u << qt) - 1u; un = mysel; }
    const bf16_t* kvs = (const bf16_t*)(p.ws + WS_KVS); const bf16_t* kvw = (const bf16_t*)(p.ws + WS_KVW);
    const bool ldK = tid < 256; const int v = tid & 255;
#pragma unroll 1
    for (int br = 0; br < 2; ++br) {
        const bf16_t* src = br ? kvw : kvs;
        const int k_lo = br ? (qt > 8 ? qt - 8 : 0) : 0;
        const unsigned tmask = br ? 0xffffffffu : un;
        AttnSt st; attn_init(st);
        u32x4 r0, r1, r2, r3;
#define P_ISSUE(RA, RB, TILE) { const size_t base = ((size_t)b * 2048 + 64 * (TILE)) * 512 + g * 64; \
            if (ldK) { RA = *(const u32x4*)(src + base + (size_t)(v >> 3) * 512 + (v & 7) * 8); RB = *(const u32x4*)(src + base + (size_t)((v >> 3) + 32) * 512 + (v & 7) * 8); } \
            else { RA = *(const u32x4*)(src + base + 256 + (size_t)(2 * (v >> 3)) * 512 + (v & 7) * 8); RB = *(const u32x4*)(src + base + 256 + (size_t)(2 * (v >> 3) + 1) * 512 + (v & 7) * 8); } }
#define P_STASH(RA, RB, KB_, VT_) { if (ldK) { *(LAS u32x4*)(KB_ + (v >> 3) * KST + (v & 7) * 8) = RA; *(LAS u32x4*)(KB_ + ((v >> 3) + 32) * KST + (v & 7) * 8) = RB; } \
            else { _Pragma("unroll") for (int j = 0; j < 4; ++j) { const unsigned a_ = RA[j], c_ = RB[j]; \
                    *(LAS unsigned*)(VT_ + ((v & 7) * 8 + 2 * j) * VST + 2 * (v >> 3)) = (a_ & 0xffffu) | (c_ << 16); \
                    *(LAS unsigned*)(VT_ + ((v & 7) * 8 + 2 * j + 1) * VST + 2 * (v >> 3)) = (a_ >> 16) | (c_ & 0xffff0000u); } } }
#define P_NEXT(FROM) ({ int n_ = (FROM) - 1; while (n_ >= k_lo && !((tmask >> n_) & 1u)) --n_; n_; })
#define P_TILE(KT, KB_, VT_) { const bool allow = br ? true : (((mysel >> (KT)) & 1u) != 0u); \
            if (__any(allow)) { \
                if (br) { if ((KT) < qt && (KT) + 8 > qt) attn_tile64<1, true>(KB_, VT_, qf, t - 64 * (KT), slope2, allow, lane, st); else attn_tile64<1, false>(KB_, VT_, qf, t - 64 * (KT), slope2, allow, lane, st); } \
                else { if ((KT) < qt) attn_tile64<0, true>(KB_, VT_, qf, t - 64 * (KT), slope2, allow, lane, st); else attn_tile64<0, false>(KB_, VT_, qf, t - 64 * (KT), slope2, allow, lane, st); } } }
        int kA = P_NEXT(qt + 1), kB = kA >= k_lo ? P_NEXT(kA) : -1;
        if (kA >= k_lo) P_ISSUE(r0, r1, kA)
        if (kB >= k_lo) P_ISSUE(r2, r3, kB)
        int sb = 0;
        while (kA >= k_lo) {
            LAS bf16_t* Ka = (LAS bf16_t*)(lds + (2 * sb) * KVBUF); LAS bf16_t* Va = Ka + 64 * KST;
            LAS bf16_t* Kb2 = (LAS bf16_t*)(lds + (2 * sb + 1) * KVBUF); LAS bf16_t* Vb2 = Kb2 + 64 * KST;
            P_STASH(r0, r1, Ka, Va)
            if (kB >= k_lo) P_STASH(r2, r3, Kb2, Vb2)
            __syncthreads();
            const int nA = kB >= k_lo ? P_NEXT(kB) : -1, nB = nA >= k_lo ? P_NEXT(nA) : -1;
            if (nA >= k_lo) P_ISSUE(r0, r1, nA)
            if (nB >= k_lo) P_ISSUE(r2, r3, nB)
            P_TILE(kA, Ka, Va)
            if (kB >= k_lo) P_TILE(kB, Kb2, Vb2)
            kA = nA; kB = nB; sb ^= 1;
        }
#undef P_ISSUE
#undef P_STASH
#undef P_NEXT
#undef P_TILE
        const float sc = (br ? g2 : g1) / fmaxf(st.l, 1.0e-30f);
#pragma unroll
        for (int gq = 0; gq < 4; ++gq) { f32x4 a_ = *(LAS const f32x4*)(cacc + 8 * gq), c_ = *(LAS const f32x4*)(cacc + 32 + 8 * gq);
            a_ += (f32x4){st.o0[4 * gq], st.o0[4 * gq + 1], st.o0[4 * gq + 2], st.o0[4 * gq + 3]} * sc; c_ += (f32x4){st.o1[4 * gq], st.o1[4 * gq + 1], st.o1[4 * gq + 2], st.o1[4 * gq + 3]} * sc;
            *(LAS f32x4*)(cacc + 8 * gq) = a_; *(LAS f32x4*)(cacc + 32 + 8 * gq) = c_; }
        __syncthreads();
    }
    bf16_t* ocat = (bf16_t*)(p.ws + WS_OCAT) + (size_t)row * DM + head * 64;
#pragma unroll
    for (int gq = 0; gq < 4; ++gq) {
        const f32x4 a = *(LAS const f32x4*)(cacc + 8 * gq), c = *(LAS const f32x4*)(cacc + 32 + 8 * gq);
        st_bf4(ocat + 8 * gq + 4 * hh, a); st_bf4(ocat + 32 + 8 * gq + 4 * hh, c);
    }
}
DI const char* uniform_ptr(const void* p) {
    const unsigned long long v = (unsigned long long)p;
    const unsigned lo = __builtin_amdgcn_readfirstlane((unsigned)v), hi = __builtin_amdgcn_readfirstlane((unsigned)(v >> 32));
    return (const char*)(((unsigned long long)hi << 32) | lo);
}
DI void wave_load_kv(const float* base, int nvalid, LAS bf16_t* Kb, LAS bf16_t* Vt, int lane) {
    const int sub = lane >> 4, seg = lane & 15;
    const char* ub = uniform_ptr(base);
    const unsigned loffK = (unsigned)(sub * 512 + seg * 4) * 4u, loffV = (unsigned)(sub * 1024 + 256 + seg * 4) * 4u;
    f32x4 vk[16], vv[16];
#pragma unroll
    for (int ps = 0; ps < 16; ++ps) { vk[ps] = (f32x4){0.f, 0.f, 0.f, 0.f}; if (ps * 4 + sub < nvalid) vk[ps] = __builtin_nontemporal_load((const f32x4*)(ub + (size_t)ps * 8192 + loffK)); }
#define S_LOAD_V(PS) { const int kp = (PS) * 4 + sub; vv[2 * (PS)] = (f32x4){0.f, 0.f, 0.f, 0.f}; vv[2 * (PS) + 1] = (f32x4){0.f, 0.f, 0.f, 0.f}; \
        if (2 * kp < nvalid) vv[2 * (PS)] = __builtin_nontemporal_load((const f32x4*)(ub + (size_t)(PS) * 16384 + loffV)); \
        if (2 * kp + 1 < nvalid) vv[2 * (PS) + 1] = __builtin_nontemporal_load((const f32x4*)(ub + (size_t)(PS) * 16384 + 2048 + loffV)); }
#pragma unroll
    for (int ps = 0; ps < 4; ++ps) S_LOAD_V(ps)
#pragma unroll
    for (int ps = 0; ps < 16; ++ps) { u32x2 w; w[0] = pack_bf2(vk[ps][0], vk[ps][1]); w[1] = pack_bf2(vk[ps][2], vk[ps][3]);
        *(LAS u32x2*)(Kb + (ps * 4 + sub) * KST + seg * 4) = w; }
    asm volatile("" ::: "memory");
#pragma unroll
    for (int ps = 4; ps < 8; ++ps) S_LOAD_V(ps)
#undef S_LOAD_V
#pragma unroll
    for (int ps = 0; ps < 8; ++ps) { const int kp = ps * 4 + sub;
#pragma unroll
        for (int j = 0; j < 4; ++j) *(LAS unsigned*)(Vt + (seg * 4 + j) * VST + 2 * kp) = pack_bf2(vv[2 * ps][j], vv[2 * ps + 1][j]); }
}

DI void attn_unit_S(const Params& p, int b, int g, LAS unsigned char* lds) {
    const int tid = threadIdx.x, wid = tid >> 6, lane = tid & 63, l31 = lane & 31, hh = lane >> 5;
    const int r = l31 >> 3, qi = l31 & 7, head = 4 * g + r, t = PAST + qi, row = NP + b * 8 + qi;
    const float slope2 = fast_exp2(-0.5f * (float)(head + 1)) * LOG2E;
    const bf16_t* qbf = (const bf16_t*)(p.ws + WS_Q);
    bf16x8 qf[4];
#pragma unroll
    for (int s = 0; s < 4; ++s) qf[s] = *(const bf16x8*)(qbf + (size_t)row * 1024 + head * 64 + 16 * s + 8 * hh);
    LAS bf16_t* Kc = (LAS bf16_t*)lds; LAS bf16_t* Vct = (LAS bf16_t*)(lds + 128 * KST * 2);
    LAS bf16_t* Kb = (LAS bf16_t*)(lds + wid * KVBUF); LAS bf16_t* Vt = Kb + 64 * KST;
    LAS float* impS = (LAS float*)(lds + 8 * KVBUF) + (wid & 3) * 8 * 33;
    LAS float* ocb = (LAS float*)(lds + 8 * KVBUF + 8 * 8 * 33 * 4);
    LAS float* mo = (LAS float*)lds;
    LAS float* mm = mo + 8 * 2048; LAS float* ml = mm + 256;
    load_cmp((const bf16_t*)(p.ws + WS_PART_S) + (size_t)b * 131072, (const float*)(p.ws + WS_PEBIAS), p.g_knorm, g, 128, Kc, Vct);
    __syncthreads();
    unsigned mysel;
    {
        if (wid < 4) {
            float imp[16]; f32x16 oc0, oc1;
            attn_cmp(Kc, Vct, qf, t, slope2, 4, lane, oc0, oc1, imp);
#pragma unroll
            for (int j = 0; j < 16; ++j) { float v = imp[j]; v += __shfl_xor(v, 8); v += __shfl_xor(v, 16); imp[j] = v; }
            if (l31 < 8) {
#pragma unroll
                for (int j = 0; j < 16; ++j) impS[qi * 33 + 8 * (j >> 2) + 2 * (j & 3) + hh] = imp[j];
            }
            if (wid == 0) {
#pragma unroll
                for (int i = 0; i < 16; ++i) { ocb[(crow(i, hh)) * 32 + l31] = oc0[i]; ocb[(32 + crow(i, hh)) * 32 + l31] = oc1[i]; }
            }
        }
        __syncthreads();
        const int q2 = lane & 7, part = lane >> 3;
        unsigned bits = 0u;
        for (int j = 0; j < 4; ++j) { const int s = part * 4 + j;
            if (s >= 1 && s <= 30) { const float v = impS[q2 * 33 + s]; int cnt = 0;
                for (int s2 = 1; s2 <= 30; ++s2) { const float v2 = impS[q2 * 33 + s2]; cnt += (v2 > v || (v2 == v && s2 < s)) ? 1 : 0; }
                if (cnt < 13) bits |= 1u << s; } }
        bits |= __shfl_xor(bits, 8); bits |= __shfl_xor(bits, 16); bits |= __shfl_xor(bits, 32);
        bits |= 1u | (1u << 31);
        mysel = __shfl(bits, qi);
    }
    unsigned un = mysel;
    un |= __shfl_xor(un, 1); un |= __shfl_xor(un, 2); un |= __shfl_xor(un, 4);
    un = __builtin_amdgcn_readfirstlane(un);
    float res[4];
    const int mq = tid & 31, md = tid >> 5;
    const int mrow = NP + b * 8 + (mq & 7), mhead = 4 * g + (mq >> 3);
    const float* gt = (const float*)(p.ws + WS_GATES) + (size_t)mrow * 48 + mhead * 3;
    { const float g0 = gt[0]; for (int i = 0; i < 4; ++i) res[i] = g0 * ocb[(4 * md + i) * 32 + mq]; }
#pragma unroll 1
    for (int br = 0; br < 2; ++br) {
        AttnSt st; attn_init(st);
        {
            int s = -1, cnt = 0, j = wid - 8;
            for (;;) {
                const float* base; int nvalid = 64, rel; bool allow = true;
                if (br == 0) {
                    bool found = false;
                    while (++s <= 32) { if (s < 32 && !((un >> s) & 1u)) continue; if ((cnt++ & 7) == wid) { found = true; break; } }
                    if (!found) break;
                    if (s < 32) { const int page = p.page_table[b * 16 + (s >> 1)];
                        base = p.cache_slc + ((size_t)page * 128 + (s & 1) * 64) * 512 + g * 64; allow = ((mysel >> s) & 1u) != 0u; }
                    else { base = p.out + O_SLC_S + (size_t)b * 8 * 512 + g * 64; nvalid = 8; }
                    rel = t - 64 * s;
                } else {
                    j += 8; if (j >= 9) break;
                    if (j < 8) base = p.cache_win + ((size_t)b * 512 + 64 * j) * 512 + g * 64;
                    else { base = p.out + O_WIN_S + ((size_t)b * 512 + 504) * 512 + g * 64; nvalid = 8; }
                    rel = t - (1536 + 64 * j);
                }
                wave_load_kv(base, nvalid, Kb, Vt, lane);
                asm volatile("s_waitcnt lgkmcnt(0)" ::: "memory");
                if (br) { if (j >= 1 && j < 8) attn_tile64<1, true>(Kb, Vt, qf, rel, slope2, allow, lane, st); else attn_tile64<1, false>(Kb, Vt, qf, rel, slope2, allow, lane, st); }
                else { if (s < 32) attn_tile64<0, true>(Kb, Vt, qf, rel, slope2, allow, lane, st); else attn_tile64<0, false>(Kb, Vt, qf, rel, slope2, allow, lane, st); }
                asm volatile("s_waitcnt lgkmcnt(0)" ::: "memory");
            }
        }
        __syncthreads();
#pragma unroll
        for (int i = 0; i < 16; ++i) { mo[wid * 2048 + crow(i, hh) * 32 + l31] = st.o0[i]; mo[wid * 2048 + (32 + crow(i, hh)) * 32 + l31] = st.o1[i]; }
        if (hh == 0) { mm[wid * 32 + l31] = st.m; ml[wid * 32 + l31] = st.l; }
        __syncthreads();
        {
            float M = NEGBIG;
            for (int w = 0; w < 8; ++w) M = fmaxf(M, mm[w * 32 + mq]);
            float L = 0.f, acc[4] = {0.f, 0.f, 0.f, 0.f};
            for (int w = 0; w < 8; ++w) { const float f = fast_exp2(mm[w * 32 + mq] - M); L += ml[w * 32 + mq] * f;
                for (int i = 0; i < 4; ++i) acc[i] += mo[w * 2048 + (4 * md + i) * 32 + mq] * f; }
            const float sc = gt[1 + br] / fmaxf(L, 1.0e-30f);
            for (int i = 0; i < 4; ++i) res[i] += acc[i] * sc;
        }
        __syncthreads();
    }
    f32x4 o = {res[0], res[1], res[2], res[3]};
    st_bf4((bf16_t*)(p.ws + WS_OCAT) + (size_t)mrow * DM + mhead * 64 + 4 * md, o);
}
DI unsigned f2sortable(float f) { const unsigned u = __float_as_uint(f); return (u & 0x80000000u) ? ~u : (u | 0x80000000u); }
DI float sortable2f(unsigned s) { const unsigned u = (s & 0x80000000u) ? (s & 0x7fffffffu) : ~s; return __uint_as_float(u); }

#define PEER_CE(a, b) { const unsigned hi_ = (a) > (b) ? (a) : (b), lo_ = (a) > (b) ? (b) : (a); (a) = hi_; (b) = lo_; }
template <int B> DI void peer_sort16(unsigned (&x)[64]) {
#pragma unroll
    for (int k = 2; k <= 16; k <<= 1)
#pragma unroll
        for (int j = k >> 1; j > 0; j >>= 1)
#pragma unroll
            for (int i = 0; i < 16; ++i) { const int l = i ^ j; if (l > i) { if ((i & k) == 0) PEER_CE(x[B + i], x[B + l]) else PEER_CE(x[B + l], x[B + i]) } }
}
DI void peer_merge16(unsigned (&t)[16]) {
#pragma unroll
    for (int j = 8; j > 0; j >>= 1)
#pragma unroll
        for (int i = 0; i < 16; ++i) { const int l = i ^ j; if (l > i) PEER_CE(t[i], t[l]) }
}
DI void peer_scores_item(const Params& p, int tile, int hp, int lane, LAS const bf16_t* SK) {
    const int h = hp >> 1, pp = hp & 1, l31 = lane & 31, hh = lane >> 5;
    const bf16_t* pq = (const bf16_t*)(p.ws + WS_PQ) + (size_t)(tile * 32 + l31) * DM + h * 256 + pp * 128 + 8 * hh;
    bf16x8 qv[8];
#pragma unroll
    for (int s = 0; s < 8; ++s) qv[s] = *(const bf16x8*)(pq + 16 * s);
    f32x16 acc[4]; for (int i = 0; i < 4; ++i) acc[i] = zero16();
#pragma unroll
    for (int s = 0; s < 8; ++s) {
#pragma unroll
        for (int kt = 0; kt < 4; ++kt) { const bf16x8 kv = *(LAS const bf16x8*)(SK + (kt * 32 + l31) * 136 + 16 * s + 8 * hh); acc[kt] = MFMA32(kv, qv[s], acc[kt]); }
    }
    unsigned x[64];
#pragma unroll
    for (int kt = 0; kt < 4; ++kt)
#pragma unroll
        for (int i = 0; i < 16; ++i) { const int key = 32 * kt + crow(i, hh); x[kt * 16 + i] = (f2sortable(acc[kt][i]) & ~127u) | (unsigned)(127 - key); }
    unsigned win[16], w2[16];
    peer_sort16<0>(x); peer_sort16<16>(x);
#pragma unroll
    for (int i = 0; i < 16; ++i) win[i] = x[i] > x[31 - i] ? x[i] : x[31 - i];
    peer_merge16(win);
    peer_sort16<32>(x); peer_sort16<48>(x);
#pragma unroll
    for (int i = 0; i < 16; ++i) w2[i] = x[32 + i] > x[63 - i] ? x[32 + i] : x[63 - i];
    peer_merge16(w2);
#pragma unroll
    for (int i = 0; i < 8; ++i) { const unsigned a = win[i] > w2[15 - i] ? win[i] : w2[15 - i], b = win[15 - i] > w2[i] ? win[15 - i] : w2[i]; win[i] = a; win[15 - i] = b; }
    peer_merge16(win);
#pragma unroll
    for (int i = 0; i < 16; ++i) w2[i] = (unsigned)__shfl_xor((int)win[i], 32);
#pragma unroll
    for (int i = 0; i < 8; ++i) { const unsigned a = win[i] > w2[15 - i] ? win[i] : w2[15 - i], b = win[15 - i] > w2[i] ? win[15 - i] : w2[i]; win[i] = a; win[15 - i] = b; }
    peer_merge16(win);
    if (hh == 0) {
        int l31_ = l31; asm volatile("" : "+v"(l31_));
        float* tv = (float*)(p.ws + WS_TOPV) + ((size_t)(tile * 32 + l31_) * 16 + hp) * 16;
        unsigned char* ti = p.ws + WS_TOPI + ((size_t)(tile * 32 + l31_) * 16 + hp) * 16;
        u32x4 kb = {0u, 0u, 0u, 0u};
#pragma unroll
        for (int j = 0; j < 4; ++j) {
            f32x4 v;
            for (int i = 0; i < 4; ++i) { const unsigned w = win[4 * j + i]; v[i] = sortable2f(w & ~127u); kb[j] |= (127u - (w & 127u)) << (8 * i); }
            st4(tv + 4 * j, v);
        }
        *(u32x4*)ti = kb;
    }
}

DI float wave_sum(float v) {
#pragma unroll
    for (int o = 32; o >= 1; o >>= 1) v += __shfl_xor(v, o);
    return v;
}
DI float gelu_exact(float x) { return 0.5f * x * (1.0f + erff(x * 0.70710678118654752f)); }

#define PEER_DOT4(B) { const bf16v2 f = __builtin_amdgcn_cvt_scalef32_pk_bf16_fp4(ub[kk][i], 1.0f, B); acc = __builtin_amdgcn_fdot2_f32_bf16(f, __builtin_bit_cast(bf16v2, hp[4 * i + B]), acc, false); }
#define PEER_AXPY4(B) { const f32x2 f = __builtin_amdgcn_cvt_scalef32_pk_f32_fp4(vb[kk][i], 1.0f, B); ov[8 * i + 2 * B] = __builtin_fmaf(f[0], ws[kk], ov[8 * i + 2 * B]); ov[8 * i + 2 * B + 1] = __builtin_fmaf(f[1], ws[kk], ov[8 * i + 2 * B + 1]); }
constexpr int PEER_SLOTS = 9;
DI void peer_token_U(const Params& p, int tok, int lane, LAS unsigned char* lds, int slot) {
    const float* tv = (const float*)(p.ws + WS_TOPV) + (size_t)tok * 256;
    const unsigned char* ti = p.ws + WS_TOPI + (size_t)tok * 256;
    const int hd = lane >> 3, sub = lane & 7;
    unsigned x[7];
#pragma unroll
    for (int i = 0; i < 7; ++i) {
        const int j = sub + 8 * i;
        int ca, cb;
        if (j < 16) { ca = 0; cb = j; } else if (j < 24) { ca = 1; cb = j - 16; } else if (j < 29) { ca = 2; cb = j - 24; } else if (j < 33) { ca = 3; cb = j - 29; }
        else if (j < 36) { ca = 4; cb = j - 33; } else if (j < 38) { ca = 5; cb = j - 36; } else if (j < 40) { ca = 6; cb = j - 38; } else if (j < 42) { ca = 7; cb = j - 40; }
        else { ca = 8 + (j - 42); cb = 0; }
        x[i] = 0u;
        if (j < 50) { const float v = tv[hd * 32 + ca] + tv[hd * 32 + 16 + cb]; x[i] = (f2sortable(v) & ~255u) | (unsigned)(255 - (ca * 16 + cb)); }
    }
    unsigned prev = 0xffffffffu, w0 = 0u, w1 = 0u;
#pragma unroll
    for (int rnd = 0; rnd < 16; ++rnd) {
        unsigned best = 0u;
#pragma unroll
        for (int j = 0; j < 7; ++j) { const unsigned c = x[j] < prev ? x[j] : 0u; best = best > c ? best : c; }
#pragma unroll
        for (int o = 1; o <= 4; o <<= 1) { const unsigned ot = (unsigned)__shfl_xor((int)best, o); best = best > ot ? best : ot; }
        if (sub == (rnd >> 1)) { if (rnd & 1) w1 = best; else w0 = best; }
        prev = best;
    }
    const float sc0 = sortable2f(w0 & ~255u), sc1 = sortable2f(w1 & ~255u);
    const int id0 = 255 - (int)(w0 & 255u), id1 = 255 - (int)(w1 & 255u);
    const int e0 = (int)ti[hd * 32 + (id0 >> 4)] * 128 + (int)ti[hd * 32 + 16 + (id0 & 15)];
    const int e1 = (int)ti[hd * 32 + (id1 >> 4)] * 128 + (int)ti[hd * 32 + 16 + (id1 & 15)];
    float mx = fmaxf(sc0, sc1);
#pragma unroll
    for (int o = 1; o <= 4; o <<= 1) mx = fmaxf(mx, __shfl_xor(mx, o));
    float p0 = fast_exp2((sc0 - mx) * LOG2E), p1 = fast_exp2((sc1 - mx) * LOG2E);
    float sm = p0 + p1;
#pragma unroll
    for (int o = 1; o <= 4; o <<= 1) sm += __shfl_xor(sm, o);
    const float isum = 1.0f / sm; p0 *= isum; p1 *= isum;
    const bf16_t* h2 = (const bf16_t*)(p.ws + WS_H) + (size_t)tok * DM;
    unsigned hp[16];
    { LAS bf16_t* HT = (LAS bf16_t*)(lds + 81920 + (threadIdx.x >> 6) * 9216);
      u32x4 q[4];
#pragma unroll
      for (int c = 0; c < 4; ++c) q[c] = *(const u32x4*)(h2 + c * 512 + lane * 8);
#pragma unroll
      for (int c = 0; c < 4; ++c) *(LAS u32x4*)(HT + (c * 16 + (lane >> 2)) * 40 + (lane & 3) * 8) = q[c];
      asm volatile("s_waitcnt lgkmcnt(0)" ::: "memory");
#pragma unroll
      for (int c = 0; c < 4; ++c) { const u32x4 r = *(LAS const u32x4*)(HT + lane * 40 + 8 * c); for (int i = 0; i < 4; ++i) hp[4 * c + i] = r[i]; }
      asm volatile("s_waitcnt lgkmcnt(0)" ::: "memory"); }
    const unsigned char* U = p.ws + WS_U; const float* su = (const float*)(p.ws + WS_USCALE); const float* sv = (const float*)(p.ws + WS_VSCALE);
    LAS float* gl = (LAS float*)(lds + (threadIdx.x >> 6) * 1024); LAS float* gs = gl + 128; LAS float* wl = (LAS float*)(lds + 8192 + (threadIdx.x >> 6) * 9216 + slot * 1024);
    { u32x2 ee; ee[0] = (unsigned)e0; ee[1] = (unsigned)e1; *(LAS u32x2*)((LAS unsigned char*)wl + 512 + lane * 8) = ee; }
    gl[2 * lane] = p0 * sv[e0]; gl[2 * lane + 1] = p1 * sv[e1]; gs[2 * lane] = su[e0]; gs[2 * lane + 1] = su[e1];
    asm volatile("s_waitcnt lgkmcnt(0)" ::: "memory");
    const int kkl = (lane >> 2) & 15;
#pragma unroll 1
    for (int k0 = 0; k0 < 128; k0 += 16) {
        u32x4 ub[16]; float d[16];
#pragma unroll
        for (int kk = 0; kk < 16; ++kk) { const int e = __builtin_amdgcn_readlane((kk & 1) ? e1 : e0, (k0 + kk) >> 1);
            ub[kk] = *(const u32x4*)(U + (size_t)e * 1024 + lane * 16); }
#pragma unroll
        for (int kk = 0; kk < 16; ++kk) { float acc = 0.f;
            if (kk > 0) asm volatile("" : "+v"(ub[kk][0]), "+v"(ub[kk][1]), "+v"(ub[kk][2]), "+v"(ub[kk][3]), "+v"(d[kk - 1]));
#pragma unroll
            for (int i = 0; i < 4; ++i)
                { PEER_DOT4(0) PEER_DOT4(1) PEER_DOT4(2) PEER_DOT4(3) }
            d[kk] = acc; }
        float r8[8], r4[4], r2[2], r1;
        { const bool up = (lane & 32) != 0;
#pragma unroll
          for (int i = 0; i < 8; ++i) { const float keep = up ? d[8 + i] : d[i], send = up ? d[i] : d[8 + i]; r8[i] = keep + __shfl_xor(send, 32); } }
        { const bool up = (lane & 16) != 0;
#pragma unroll
          for (int i = 0; i < 4; ++i) { const float keep = up ? r8[4 + i] : r8[i], send = up ? r8[i] : r8[4 + i]; r4[i] = keep + __shfl_xor(send, 16); } }
        { const bool up = (lane & 8) != 0;
#pragma unroll
          for (int i = 0; i < 2; ++i) { const float keep = up ? r4[2 + i] : r4[i], send = up ? r4[i] : r4[2 + i]; r2[i] = keep + __shfl_xor(send, 8); } }
        { const bool up = (lane & 4) != 0; const float keep = up ? r2[1] : r2[0], send = up ? r2[0] : r2[1]; r1 = keep + __shfl_xor(send, 4); }
        r1 += __shfl_xor(r1, 2); r1 += __shfl_xor(r1, 1);
        const float wgt = gl[k0 + kkl] * gelu_exact(r1 * gs[k0 + kkl]);
        if ((lane & 3) == 0) wl[k0 + kkl] = wgt;
    }
    asm volatile("s_waitcnt lgkmcnt(0)" ::: "memory");
}

DI void peer_token_V(const Params& p, int tok, int lane, LAS unsigned char* lds, int slot, bool commit) {
    const unsigned char* V = p.ws + WS_V;
    LAS const float* wl = (LAS const float*)(lds + 8192 + (threadIdx.x >> 6) * 9216 + slot * 1024);
    int e0, e1; { const u32x2 ee = *(LAS const u32x2*)((LAS const unsigned char*)wl + 512 + lane * 8); e0 = (int)ee[0]; e1 = (int)ee[1]; }
    asm volatile("s_waitcnt lgkmcnt(0)" ::: "memory");
    float ov[32];
#pragma unroll
    for (int i = 0; i < 32; ++i) ov[i] = 0.f;
#pragma unroll 1
    for (int k0 = 0; k0 < 128; k0 += 16) {
        u32x4 vb[16]; float ws[16];
#pragma unroll
        for (int kk = 0; kk < 16; ++kk) { const int e = __builtin_amdgcn_readlane((kk & 1) ? e1 : e0, (k0 + kk) >> 1);
            vb[kk] = *(const u32x4*)(V + (size_t)e * 1024 + lane * 16);
            ws[kk] = wl[k0 + kk]; }
#pragma unroll
        for (int kk = 0; kk < 16; ++kk) {
            if (kk > 0) asm volatile("" : "+v"(vb[kk][0]), "+v"(vb[kk][1]), "+v"(vb[kk][2]), "+v"(vb[kk][3]), "+v"(ov[31]), "+v"(ov[15]));
#pragma unroll
            for (int i = 0; i < 4; ++i)
                { PEER_AXPY4(0) PEER_AXPY4(1) PEER_AXPY4(2) PEER_AXPY4(3) }
        }
    }
    asm volatile("s_waitcnt lgkmcnt(0)" ::: "memory");
    LAS float* T = (LAS float*)(lds + 81920 + (threadIdx.x >> 6) * 9216);
#pragma unroll
    for (int c = 0; c < 8; ++c) *(LAS f32x4*)(T + lane * 36 + 4 * c) = (f32x4){ov[4 * c], ov[4 * c + 1], ov[4 * c + 2], ov[4 * c + 3]};
    asm volatile("s_waitcnt lgkmcnt(0)" ::: "memory");
    const int mrow = tok < NP ? (tok >> 11) : 8 + ((tok - NP) >> 3);
    const float* gate = (const float*)(p.ws + WS_MOD) + (size_t)mrow * 12288 + 5 * DM;
    float* y = p.out + (size_t)tok * DM; const bf16_t* x1 = (const bf16_t*)(p.ws + WS_X1) + (size_t)tok * DM;
#pragma unroll
    for (int c = 0; c < 8; ++c) {
        const int col = c * 256 + lane * 4;
        const f32x4 o = *(LAS const f32x4*)(T + (c * 8 + (lane >> 3)) * 36 + (lane & 7) * 4);
        const u32x2 xb = *(const u32x2*)(x1 + col); f32x4 a = {bf_lo(xb[0]), bf_hi(xb[0]), bf_lo(xb[1]), bf_hi(xb[1])}; const f32x4 ga = ld4(gate + col);
        for (int i = 0; i < 4; ++i) a[i] += ga[i] * o[i];
        st4((commit ? y : (float*)(p.ws + WS_OCAT) + (size_t)tok * DM) + col, a);
    }
    asm volatile("s_waitcnt lgkmcnt(0)" ::: "memory");
}
constexpr int LDS_BYTES = 163840 - 64;
constexpr int N_PHASES = 11;
#ifndef MK_LAUNCHES
#define MK_LAUNCHES 1
#endif

__global__ __launch_bounds__(512, 2) void mega(Params p) {
    extern __shared__ __attribute__((aligned(16))) unsigned char shm[];
    LAS unsigned char* lds = (LAS unsigned char*)shm;
    const int tid = threadIdx.x, wid = tid >> 6, lane = tid & 63;
    volatile LAS unsigned* xbw = (volatile LAS unsigned*)(lds + LDS_BYTES - 16);
    if (tid == 0) { xbw[0] = 0u; xbw[1] = 0u; xbw[2] = 0u; xbw[3] = 0u; }
    __syncthreads();
    XcdBarrier bar = xcd_barrier_post((unsigned*)(p.ws + WS_BAR), xbw);
#ifndef PH_MASK
#define PH_MASK 0x7ff
#endif
#define IN(ph) (((PH_MASK >> (ph)) & 1) && p.ph_lo <= (ph) && (ph) < p.ph_hi)
#ifndef DUP_MASK
#define DUP_MASK 0
#endif
#define SEAM(ph) do { if (IN(ph) && IN((ph) + 1)) xcd_barrier(bar); } while (0)
    auto ph0 = [&]() __attribute__((always_inline)) { if (IN(0)) phase_A(p, lds); };
    ph0();
    if constexpr ((DUP_MASK >> 0) & 1) ph0();
    SEAM(0);
    auto ph2 = [&]() __attribute__((always_inline)) { if (IN(2)) phase_modulate(p, 0); };
    ph2();
    if constexpr ((DUP_MASK >> 2) & 1) ph2();
    SEAM(2);
    auto ph3 = [&]() __attribute__((always_inline)) { if (IN(3)) {
        pg8::Gemm g{(const bf16_t*)(p.ws + WS_H), (const bf16_t*)(p.ws + WS_WIN_T), NTOK, NIN_PAD, DM};
        pg8::StaticOrder S; S.init(NTOK, NIN_PAD, (int)gridDim.x, (int)blockIdx.x);
        EpiIn E{(bf16_t*)(p.ws + WS_Q), (bf16_t*)(p.ws + WS_KVS), (bf16_t*)(p.ws + WS_KVW), (bf16_t*)(p.ws + WS_UBF), p.out, (float*)(p.ws + WS_GATES), p.g_qnorm, p.g_knorm};
        pg8::gemm_phase<EpiIn, pg8::StaticOrder, false>(lds, g, S, E, nullptr);
    } };
    ph3();
    if constexpr ((DUP_MASK >> 3) & 1) ph3();
#ifdef DUP_GEMM3_NULL
    if (IN(3)) { pg8::Gemm g{(const bf16_t*)(p.ws + WS_H), (const bf16_t*)(p.ws + WS_WIN_T), NTOK, NIN_PAD, DM};
        pg8::StaticOrder S; S.init(NTOK, NIN_PAD, (int)gridDim.x, (int)blockIdx.x);
        EpiNull E{(float*)(p.ws + WS_PQ)};
        pg8::gemm_phase<EpiNull, pg8::StaticOrder, false>(lds, g, S, E, nullptr); }
#endif
    SEAM(3);
    auto ph4 = [&]() __attribute__((always_inline)) { if (IN(4)) {
        for (int u = blockIdx.x; u < 2176 + 544; u += gridDim.x) { const int grp = u / 5, pos = u - 5 * grp; if (pos < 4) cmp_unit(p, grp * 4 + pos, lds); else pool_unit(p, grp, lds); }
#ifdef DUP_CMP
        for (int u = blockIdx.x; u < 2176; u += gridDim.x) cmp_unit(p, u, lds);
#endif
#ifdef DUP_POOL
        for (int u = blockIdx.x; u < 544; u += gridDim.x) pool_unit(p, u, lds);
#endif
    } };
    ph4();
    if constexpr ((DUP_MASK >> 4) & 1) ph4();
    SEAM(4);
    auto ph5 = [&]() __attribute__((always_inline)) { if (IN(5)) {
        const int G = gridDim.x;
#ifndef NO_P
#pragma unroll 1
        for (int i = blockIdx.x; i < 1024; i += G) {
            const int rnd = i / 256, k = (i % 256) >> 5, bg = i & 31;
            const int qt = (rnd & 1) ? (31 - 8 * rnd - 7 + k) : (31 - 8 * rnd - k);
            attn_unit_P(p, bg >> 2, bg & 3, qt, lds);
        }
#endif
#ifndef NO_S
#pragma unroll 1
        for (int j = blockIdx.x; j < 512; j += G) attn_unit_S(p, j >> 2, j & 3, lds);
#ifdef DUP_ATT_S
#pragma unroll 1
        for (int j = blockIdx.x; j < 512; j += G) attn_unit_S(p, j >> 2, j & 3, lds);
#endif
#endif
    } };
    ph5();
    if constexpr ((DUP_MASK >> 5) & 1) ph5();
    SEAM(5);
    auto ph6 = [&]() __attribute__((always_inline)) { if (IN(6)) {
        pg8::Gemm g{(const bf16_t*)(p.ws + WS_OCAT), (const bf16_t*)(p.ws + WS_WOUT_T), NTOK, DM, DM};
        pg8::StaticOrder S; S.init(NTOK, DM, (int)gridDim.x, (int)blockIdx.x);
        EpiOut E{p.x_prompt, p.x_sample, (const float*)(p.ws + WS_MOD), (bf16_t*)(p.ws + WS_X1)};
        pg8::gemm_phase<EpiOut, pg8::StaticOrder, false>(lds, g, S, E, nullptr);
        constexpr int NTAIL = (NTOK / 256) * (DM / 256) - 2 * 256;
        if ((int)gridDim.x == 256 && (int)blockIdx.x >= NTAIL) { __syncthreads(); transpose_wq(p, NTAIL, lds); phase_B_stream(p, NTAIL, 0, lds); }
        else if ((int)gridDim.x != 256) { __syncthreads(); transpose_wq(p, 0, lds); phase_B_stream(p, 0, 0, lds); }
    } };
    ph6();
    if constexpr ((DUP_MASK >> 6) & 1) ph6();
    SEAM(6);
    auto ph7 = [&]() __attribute__((always_inline)) { if (IN(7)) phase_modulate(p, 1); };
    ph7();
    if constexpr ((DUP_MASK >> 7) & 1) ph7();
    SEAM(7);
    auto ph8 = [&]() __attribute__((always_inline)) { if (IN(8)) {
        pg8::Gemm g{(const bf16_t*)(p.ws + WS_H), (const bf16_t*)(p.ws + WS_WQ_T), NTOK, DM, DM};
        pg8::StaticOrder S; S.init(NTOK, DM, (int)gridDim.x, (int)blockIdx.x);
        EpiPq E{(bf16_t*)(p.ws + WS_PQ)};
        pg8::gemm_phase<EpiPq, pg8::StaticOrder, false>(lds, g, S, E, nullptr);
        constexpr int NTAIL = (NTOK / 256) * (DM / 256) - 2 * 256;
        if ((int)gridDim.x == 256 && (int)blockIdx.x >= NTAIL) { __syncthreads(); phase_B_stream(p, NTAIL, 1, lds); }
        else if ((int)gridDim.x != 256) { __syncthreads(); phase_B_stream(p, 0, 1, lds); }
    } };
    ph8();
    if constexpr ((DUP_MASK >> 8) & 1) ph8();
    SEAM(8);
    auto ph9 = [&]() __attribute__((always_inline)) { if (IN(9)) {
        const int hp = blockIdx.x & 15, ngrp = (gridDim.x + 15 - hp) / 16, rank = blockIdx.x >> 4;
        LAS bf16_t* SK = (LAS bf16_t*)lds;
        { const bf16_t* sk = (const bf16_t*)(p.ws + WS_SUBK) + (size_t)((hp & 1) * 8 + (hp >> 1)) * 128 * 128;
          for (int c = tid; c < 128 * 16; c += 512) { const int r = c >> 4, k8 = (c & 15) * 8; *(LAS u32x4*)(SK + r * 136 + k8) = *(const u32x4*)(sk + r * 128 + k8); } }
        __syncthreads();
        for (int tile = wid * ngrp + rank; tile < 544; tile += ngrp * 8) peer_scores_item(p, tile, hp, lane, SK);
        __syncthreads();
     } };
    ph9();
    if constexpr ((DUP_MASK >> 9) & 1) ph9();
    SEAM(9);
    auto ph10 = [&](bool commit) __attribute__((always_inline)) { if (IN(10)) {
#pragma unroll 1
        for (int tok0 = wid * gridDim.x + blockIdx.x; tok0 < NTOK; tok0 += gridDim.x * 8 * PEER_SLOTS) {
#pragma unroll 1
            for (int s = 0; s < PEER_SLOTS; ++s) { const int tok = tok0 + s * (int)gridDim.x * 8; if (tok < NTOK) peer_token_U(p, tok, lane, lds, s); }
#pragma unroll 1
            for (int s = 0; s < PEER_SLOTS; ++s) { const int tok = tok0 + s * (int)gridDim.x * 8; if (tok < NTOK) peer_token_V(p, tok, lane, lds, s, commit); }
        }
    } };
    if constexpr ((DUP_MASK >> 10) & 1) ph10(false);
    ph10(true);
#undef IN
#undef SEAM
}

extern "C" void kernel_launch(void* const* d_in, const int* in_sizes, int n_in, void* d_out, int out_size, void* d_ws, size_t ws_size, hipStream_t stream) {
    static int grid = 0;
    if (grid == 0) {
        if (n_in != 25 || ws_size < WS_END) { fprintf(stderr, "kernel_launch: unexpected inputs (n_in %d, ws %zu < %zu)\n", n_in, ws_size, (size_t)WS_END); grid = -1; return; }
        int dev = 0, cus = 0, per_cu = 0;
        if (hipGetDevice(&dev) != hipSuccess || hipDeviceGetAttribute(&cus, hipDeviceAttributeMultiprocessorCount, dev) != hipSuccess) { grid = -1; return; }
        if (hipFuncSetAttribute((const void*)mega, hipFuncAttributeMaxDynamicSharedMemorySize, LDS_BYTES) != hipSuccess) { fprintf(stderr, "kernel_launch: hipFuncSetAttribute failed\n"); grid = -1; return; }
        if (hipOccupancyMaxActiveBlocksPerMultiprocessor(&per_cu, (const void*)mega, 512, LDS_BYTES) != hipSuccess || per_cu < 1)
            fprintf(stderr, "kernel_launch: occupancy query reports %d blocks per CU\n", per_cu);
        (void)hipGetLastError();
        grid = cus;
    }
    if (grid < 0) return;
    (void)hipMemsetAsync((char*)d_ws + WS_BAR, 0, XCD_BAR_WORDS * sizeof(unsigned), stream);
    Params p{};
    p.x_prompt = (const float*)d_in[0]; p.x_sample = (const float*)d_in[1]; p.cache_cmp = (const float*)d_in[2]; p.cache_slc = (const float*)d_in[3];
    p.cache_win = (const float*)d_in[4]; p.state_pool = (const float*)d_in[5]; p.page_table = (const int*)d_in[6]; p.c_prompt = (const float*)d_in[7];
    p.c_sample = (const float*)d_in[8]; p.w_ada = (const float*)d_in[9]; p.b_ada = (const float*)d_in[10]; p.g_norm1 = (const float*)d_in[11];
    p.g_norm2 = (const float*)d_in[12]; p.w_in = (const float*)d_in[13]; p.w_out = (const float*)d_in[14]; p.g_qnorm = (const float*)d_in[15];
    p.g_knorm = (const float*)d_in[16]; p.cmp_pe = (const float*)d_in[17]; p.w_cmp = (const float*)d_in[18]; p.w_pool = (const float*)d_in[19];
    p.pool_scale = (const float*)d_in[20]; p.peer_wq = (const float*)d_in[21]; p.peer_subkeys = (const float*)d_in[22]; p.peer_u = (const float*)d_in[23];
    p.peer_v = (const float*)d_in[24];
    p.out = (float*)d_out; p.ws = (unsigned char*)d_ws;
#if MK_LAUNCHES == 1
    p.ph_lo = 0; p.ph_hi = N_PHASES;
    hipLaunchKernelGGL(mega, dim3(grid), dim3(512), LDS_BYTES, stream, p);
#else
    for (int ph = 0; ph < N_PHASES; ++ph) { p.ph_lo = ph; p.ph_hi = ph + 1; hipLaunchKernelGGL(mega, dim3(grid), dim3(512), LDS_BYTES, stream, p); }
#endif
}
```
